# Optimizing an MI355X kernel written in HIP

```python
import math
import jax
import jax.numpy as jnp
from jax import lax
import numpy as np

D_MODEL = 1024
BATCH = 8
SEQ = 2048
DEPTH = 1

PLE_DIM = 256
NSA_HEADS = 8
NSA_GROUPS = 2
NSA_HPG = NSA_HEADS // NSA_GROUPS
NSA_HEAD_DIM = 64
NSA_WIDTH = NSA_HEADS * NSA_HEAD_DIM
NSA_KV = NSA_GROUPS * NSA_HEAD_DIM
CMP_BLOCK = 32
CMP_STRIDE = 16
CMP_HIDDEN = 256
SEL_BLOCK = 64
SEL_TOPK = 8
WINDOW = 512
Q_BLOCK = 128
DN_HEADS = 4
DN_HEAD_DIM = 128
DN_WIDTH = DN_HEADS * DN_HEAD_DIM
DN_CONV = 4
DN_CHUNK = 64
NUM_BUCKETS = 32
REL_MAX_DIST = 1024
DEEPNORM_ALPHA = (2 * DEPTH) ** 0.25
DEEPNORM_BETA = (8 * DEPTH) ** -0.25
NEG = -1e30
FORCE = 1e6
IN_SPLITS = (NSA_WIDTH, 6 * NSA_KV, 3 * NSA_HEADS, NSA_WIDTH,
             3 * DN_WIDTH, DN_HEADS, DN_HEADS, DN_WIDTH, 2 * D_MODEL)
D_IN = sum(IN_SPLITS)

kernel_name = 'hybrid_nsa_gdn_deepnorm_layer'


def rel_bucket(dist):
    n = jnp.maximum(dist, 0)
    max_exact = NUM_BUCKETS // 2
    nf = jnp.maximum(n, 1).astype(jnp.float32)
    large = max_exact + (jnp.log(nf / max_exact) / math.log(REL_MAX_DIST / max_exact)
                         * (NUM_BUCKETS - max_exact)).astype(jnp.int32)
    large = jnp.minimum(large, NUM_BUCKETS - 1)
    return jnp.where(n < max_exact, n, large)


def masked_softmax(s, valid):
    s = jnp.where(valid, s.astype(jnp.float32), NEG)
    return jnp.where(valid, jax.nn.softmax(s, axis=-1), 0.0)


def layer_norm(h, g, b, eps=1e-5):
    h = h.astype(jnp.float32)
    mu = jnp.mean(h, -1, keepdims=True)
    var = jnp.mean(jnp.square(h - mu), -1, keepdims=True)
    return (h - mu) * lax.rsqrt(var + eps) * g.astype(jnp.float32) + b.astype(jnp.float32)


def l2norm(t):
    return t * lax.rsqrt(jnp.sum(jnp.square(t), -1, keepdims=True) + 1e-6)


def compress_blocks(t, pos, w1, w2):
    B, S, G, dh = t.shape
    r = CMP_BLOCK // CMP_STRIDE
    c = t.reshape(B, S // CMP_STRIDE, CMP_STRIDE, G, dh)
    n_cmp = S // CMP_STRIDE - r + 1
    blocks = jnp.concatenate([c[:, j:j + n_cmp] for j in range(r)], axis=2)
    blocks = blocks + pos[None, None, :, None, :]
    flat = blocks.transpose(0, 1, 3, 2, 4).reshape(B, n_cmp, G, CMP_BLOCK * dh)
    return jax.nn.gelu(flat @ w1) @ w2


def nsa_mixer(q, kv, gates, pos_k, pos_v, w1_k, w2_k, w1_v, w2_v, rel_bias):
    B, S, _ = q.shape
    G, Hg, dh = NSA_GROUPS, NSA_HPG, NSA_HEAD_DIM
    q = q.astype(jnp.float32).reshape(B, S, G, Hg, dh) * dh ** -0.5
    k_c, v_c, k_s, v_s, k_w, v_w = [t.reshape(B, S, G, dh) for t in jnp.split(kv, 6, axis=-1)]
    tab = rel_bias.astype(jnp.float32)
    tab_g = tab.reshape(NUM_BUCKETS, G, Hg)
    t_pos = jnp.arange(S)

    kc = compress_blocks(k_c, pos_k, w1_k, w2_k)
    vc = compress_blocks(v_c, pos_v, w1_v, w2_v)
    n_cmp = kc.shape[1]
    cmp_end = jnp.arange(n_cmp) * CMP_STRIDE + CMP_BLOCK - 1
    dist_c = t_pos[:, None] - cmp_end[None, :]
    bias_c = tab[rel_bucket(dist_c)].reshape(S, n_cmp, G, Hg).transpose(2, 3, 0, 1)
    p_c = masked_softmax(jnp.einsum('bsghd,bngd->bghsn', q, kc) + bias_c, dist_c >= 0)
    o_cmp = jnp.einsum('bghsn,bngd->bsghd', p_c, vc)

    n_sel = S // SEL_BLOCK
    ci = jnp.arange(n_cmp)[:, None]
    sj = jnp.arange(n_sel)[None, :]
    overlap = ((ci * CMP_STRIDE < (sj + 1) * SEL_BLOCK) &
               (ci * CMP_STRIDE + CMP_BLOCK > sj * SEL_BLOCK)).astype(jnp.float32)
    imp = jnp.einsum('bghsn,nj->bgsj', p_c, overlap)
    cur = (t_pos // SEL_BLOCK)[:, None]
    blk = jnp.arange(n_sel)[None, :]
    forced = (blk == 0) | (blk == cur) | (blk == cur - 1)
    imp = jnp.where(forced, FORCE, jnp.where(blk > cur, -FORCE, imp))
    n_top = min(SEL_TOPK, n_sel)
    _, sel_idx = lax.top_k(imp, n_top)

    kb_s = k_s.reshape(B, n_sel, SEL_BLOCK, G, dh).transpose(0, 3, 1, 2, 4)
    vb_s = v_s.reshape(B, n_sel, SEL_BLOCK, G, dh).transpose(0, 3, 1, 2, 4)
    pad = ((0, 0), (WINDOW, 0), (0, 0), (0, 0))
    kw_p = jnp.pad(k_w, pad)
    vw_p = jnp.pad(v_w, pad)
    bi = jnp.arange(B)[:, None, None, None]
    gi = jnp.arange(G)[None, :, None, None]
    gi5 = jnp.arange(G)[None, :, None, None, None]
    sel_off = jnp.arange(SEL_BLOCK)
    win_off = jnp.arange(WINDOW + Q_BLOCK)

    def query_block(i):
        q0 = i * Q_BLOCK
        tq = q0 + jnp.arange(Q_BLOCK)
        qb = lax.dynamic_slice_in_dim(q, q0, Q_BLOCK, axis=1)
        idx = lax.dynamic_slice_in_dim(sel_idx, q0, Q_BLOCK, axis=2)
        ks = kb_s[bi, gi, idx]
        vs = vb_s[bi, gi, idx]
        kpos = idx[..., None] * SEL_BLOCK + sel_off
        dist = tq[None, None, :, None, None] - kpos
        bias_s = jnp.moveaxis(tab_g[rel_bucket(dist), gi5], -1, 2)
        s_s = jnp.einsum('bqghd,bgqnld->bghqnl', qb, ks) + bias_s
        s_s = s_s.reshape(B, G, Hg, Q_BLOCK, n_top * SEL_BLOCK)
        valid_s = (dist >= 0).reshape(B, G, 1, Q_BLOCK, n_top * SEL_BLOCK)
        p_s = masked_softmax(s_s, valid_s).reshape(B, G, Hg, Q_BLOCK, n_top, SEL_BLOCK)
        o_s = jnp.einsum('bghqnl,bgqnld->bqghd', p_s, vs)
        kw = lax.dynamic_slice_in_dim(kw_p, q0, WINDOW + Q_BLOCK, axis=1)
        vw = lax.dynamic_slice_in_dim(vw_p, q0, WINDOW + Q_BLOCK, axis=1)
        kposw = q0 - WINDOW + win_off
        distw = tq[:, None] - kposw[None, :]
        validw = (distw >= 0) & (distw < WINDOW) & (kposw[None, :] >= 0)
        bias_w = tab[rel_bucket(distw)].reshape(Q_BLOCK, WINDOW + Q_BLOCK, G, Hg).transpose(2, 3, 0, 1)
        p_w = masked_softmax(jnp.einsum('bqghd,bkgd->bghqk', qb, kw) + bias_w, validw)
        o_w = jnp.einsum('bghqk,bkgd->bqghd', p_w, vw)
        return o_s, o_w

    o_sel, o_win = lax.map(query_block, jnp.arange(S // Q_BLOCK))
    o_sel = jnp.moveaxis(o_sel, 0, 1).reshape(B, S, G, Hg, dh)
    o_win = jnp.moveaxis(o_win, 0, 1).reshape(B, S, G, Hg, dh)

    g = jax.nn.sigmoid(gates.astype(jnp.float32)).reshape(B, S, 3, G, Hg, 1)
    o = g[:, :, 0] * o_cmp + g[:, :, 1] * o_sel + g[:, :, 2] * o_win
    return o.reshape(B, S, NSA_WIDTH)


def chunk_gated_delta_rule(q, k, v, g, beta):
    B, S, H, dk = q.shape
    dv = v.shape[-1]
    C = DN_CHUNK
    N = S // C

    def chunks(t):
        return jnp.moveaxis(t.reshape((B, N, C, H) + t.shape[3:]), 3, 1)

    qc = chunks(q * dk ** -0.5)
    kc = chunks(k)
    vc = chunks(v)
    bc = chunks(beta)
    gc = jnp.cumsum(chunks(g), axis=-1)
    pos = jnp.arange(C)
    incl = pos[:, None] >= pos[None, :]
    strict = pos[:, None] > pos[None, :]
    diff = gc[..., :, None] - gc[..., None, :]
    decay = jnp.where(incl, jnp.exp(jnp.where(incl, diff, 0.0)), 0.0)
    kb = kc * bc[..., None]
    lower = jnp.where(strict, jnp.einsum('bhncd,bhnjd->bhncj', kb, kc) * decay, 0.0)
    rhs = jnp.concatenate([vc * bc[..., None], kb * jnp.exp(gc)[..., None]], axis=-1)
    sol = lax.linalg.triangular_solve(lower, rhs, left_side=True, lower=True, unit_diagonal=True)
    u, w = sol[..., :dv], sol[..., dv:]
    a_qk = jnp.einsum('bhncd,bhnjd->bhncj', qc, kc) * decay

    def step(state, xs):
        q_i, k_i, u_i, w_i, a_i, g_i = xs
        v_new = u_i - jnp.einsum('bhck,bhkv->bhcv', w_i, state)
        o_i = (jnp.einsum('bhck,bhkv->bhcv', q_i * jnp.exp(g_i)[..., None], state)
               + jnp.einsum('bhcj,bhjv->bhcv', a_i, v_new))
        g_last = g_i[..., -1]
        k_dec = k_i * jnp.exp(g_last[..., None] - g_i)[..., None]
        state = state * jnp.exp(g_last)[..., None, None] + jnp.einsum('bhck,bhcv->bhkv', k_dec, v_new)
        return state, o_i

    xs = tuple(jnp.moveaxis(t, 2, 0) for t in (qc, kc, u, w, a_qk, gc))
    state0 = jnp.zeros((B, H, dk, dv), jnp.float32)
    _, o = lax.scan(step, state0, xs)
    return o.transpose(1, 0, 3, 2, 4).reshape(B, S, H, dv)


def deltanet_mixer(qkv, beta_in, a_in, z, conv_w, a_log, dt_bias, norm_w):
    B, S, C = qkv.shape
    H, d = DN_HEADS, DN_HEAD_DIM
    qkv = lax.conv_general_dilated(qkv, conv_w.astype(qkv.dtype)[:, None, :], window_strides=(1,),
                                   padding=((DN_CONV - 1, 0),),
                                   dimension_numbers=('NWC', 'WIO', 'NWC'), feature_group_count=C)
    qkv = jax.nn.silu(qkv.astype(jnp.float32))
    q, k, v = [t.reshape(B, S, H, d) for t in jnp.split(qkv, 3, axis=-1)]
    q, k = l2norm(q), l2norm(k)
    beta = jax.nn.sigmoid(beta_in.astype(jnp.float32))
    g = -jnp.exp(a_log.astype(jnp.float32)) * jax.nn.softplus(a_in.astype(jnp.float32) + dt_bias.astype(jnp.float32))
    o = chunk_gated_delta_rule(q, k, v, g, beta)
    o = o * lax.rsqrt(jnp.mean(jnp.square(o), -1, keepdims=True) + 1e-6) * norm_w.astype(jnp.float32)
    o = o * jax.nn.silu(z.astype(jnp.float32)).reshape(B, S, H, d)
    return o.reshape(B, S, DN_WIDTH)


def setup_inputs(seed: int = 0) -> dict:
    key = jax.random.key(seed)
    ks = jax.random.split(key, 24)
    L = DEPTH

    def nrm(k, shape, scale):
        return jax.random.normal(k, shape, jnp.float32) * scale

    dt = jnp.exp(jax.random.uniform(ks[12], (L, DN_HEADS), jnp.float32, math.log(1e-3), math.log(1e-1)))
    return {
        'x': nrm(ks[0], (BATCH, SEQ, D_MODEL), 1.0),
        'p': nrm(ks[1], (L, BATCH, SEQ, PLE_DIM), 1.0),
        'w_in': nrm(ks[2], (L, D_MODEL, D_IN), D_MODEL ** -0.5),
        'cmp_pos_k': nrm(ks[3], (L, CMP_BLOCK, NSA_HEAD_DIM), 0.1),
        'cmp_pos_v': nrm(ks[4], (L, CMP_BLOCK, NSA_HEAD_DIM), 0.1),
        'cmp_w1_k': nrm(ks[5], (L, CMP_BLOCK * NSA_HEAD_DIM, CMP_HIDDEN), (CMP_BLOCK * NSA_HEAD_DIM) ** -0.5),
        'cmp_w2_k': nrm(ks[6], (L, CMP_HIDDEN, NSA_HEAD_DIM), CMP_HIDDEN ** -0.5),
        'cmp_w1_v': nrm(ks[7], (L, CMP_BLOCK * NSA_HEAD_DIM, CMP_HIDDEN), (CMP_BLOCK * NSA_HEAD_DIM) ** -0.5),
        'cmp_w2_v': nrm(ks[8], (L, CMP_HIDDEN, NSA_HEAD_DIM), CMP_HIDDEN ** -0.5),
        'rel_bias': nrm(ks[9], (NUM_BUCKETS, NSA_HEADS), 0.2),
        'dn_conv_w': nrm(ks[10], (L, DN_CONV, 3 * DN_WIDTH), DN_CONV ** -0.5),
        'dn_a_log': jnp.log(jax.random.uniform(ks[11], (L, DN_HEADS), jnp.float32, 1.0, 16.0)),
        'dn_dt_bias': dt + jnp.log(-jnp.expm1(-dt)),
        'dn_norm_w': 1.0 + nrm(ks[13], (L, DN_HEAD_DIM), 0.05),
        'w_branch_a': nrm(ks[14], (L, NSA_WIDTH, D_MODEL), NSA_WIDTH ** -0.5),
        'w_branch_b': nrm(ks[15], (L, DN_WIDTH, D_MODEL), DN_WIDTH ** -0.5),
        'w_out': nrm(ks[16], (L, D_MODEL, D_MODEL), DEEPNORM_BETA * D_MODEL ** -0.5),
        'w_ple': nrm(ks[17], (L, PLE_DIM, D_MODEL), PLE_DIM ** -0.5),
        'w_ple_gate': nrm(ks[18], (L, D_MODEL, D_MODEL), D_MODEL ** -0.5),
        'ln_g': 1.0 + nrm(ks[19], (L, D_MODEL), 0.05),
        'ln_b': nrm(ks[20], (L, D_MODEL), 0.02),
    }


def reference(x, p, w_in, cmp_pos_k, cmp_pos_v, cmp_w1_k, cmp_w2_k, cmp_w1_v, cmp_w2_v, rel_bias,
              dn_conv_w, dn_a_log, dn_dt_bias, dn_norm_w, w_branch_a, w_branch_b, w_out,
              w_ple, w_ple_gate, ln_g, ln_b):
    out_dtype = x.dtype
    cuts = []
    acc = 0
    for s in IN_SPLITS[:-1]:
        acc += s
        cuts.append(acc)
    for i in range(DEPTH):
        proj = x @ w_in[i]
        q_a, kv_a, g_a, z_a, qkv_b, beta_b, a_b, z_b, g_merge = jnp.split(proj, cuts, axis=-1)
        o_a = nsa_mixer(q_a, kv_a, g_a, cmp_pos_k[i], cmp_pos_v[i], cmp_w1_k[i], cmp_w2_k[i],
                        cmp_w1_v[i], cmp_w2_v[i], rel_bias)
        o_a = o_a * jax.nn.silu(z_a.astype(jnp.float32))
        o_b = deltanet_mixer(qkv_b, beta_b, a_b, z_b, dn_conv_w[i], dn_a_log[i], dn_dt_bias[i], dn_norm_w[i])
        y_a = o_a @ w_branch_a[i]
        y_b = o_b @ w_branch_b[i]
        gm_a, gm_b = jnp.split(jax.nn.sigmoid(g_merge.astype(jnp.float32)), 2, axis=-1)
        mixed = (gm_a * y_a + gm_b * y_b) @ w_out[i]
        h = DEEPNORM_ALPHA * x.astype(jnp.float32) + mixed
        h = h + jax.nn.sigmoid(h @ w_ple_gate[i]) * (p[i] @ w_ple[i])
        x = layer_norm(h, ln_g[i], ln_b[i]).astype(out_dtype)
    return x
```

```cpp
#include <hip/hip_runtime.h>
#include <cstdio>
#include <cstdint>
#include <cmath>

constexpr int D_MODEL = 1024, BATCH = 8, SEQ = 2048, PLE = 256;
constexpr int D_IN = 5920;
constexpr int C_Q = 0, C_KV = 512, C_GA = 1280, C_ZA = 1304, C_QKVB = 1816, C_BETA = 3352, C_AB = 3356, C_ZB = 3360, C_GM = 3872;
constexpr int NCMP = 127;
constexpr float ALPHA = 1.189207115002721f;

__device__ __forceinline__ float sigmoidf_(float x) { return 1.f / (1.f + expf(-x)); }
__device__ __forceinline__ float siluf_(float x) { return x / (1.f + expf(-x)); }
__device__ __forceinline__ int rel_bucket(int n) {
    if (n < 16) return n < 0 ? 0 : n;
    int b = 16;
    b += (n >= 21) + (n >= 27) + (n >= 35) + (n >= 46) + (n >= 59) + (n >= 77) + (n >= 99) + (n >= 128) + (n >= 166) + (n >= 216) + (n >= 280) + (n >= 363) + (n >= 470) + (n >= 609) + (n >= 790);
    return b;
}

__global__ __launch_bounds__(256) void gemm_f32(const float* __restrict__ A, int lda, const float* __restrict__ B, int ldb, float* __restrict__ C, int ldc, int M, int N, int K) {
    __shared__ float As[16][68];
    __shared__ float Bs[16][68];
    const int tid = threadIdx.x, tx = tid & 15, ty = tid >> 4;
    const int m0 = blockIdx.y * 64, n0 = blockIdx.x * 64;
    float acc[4][4];
#pragma unroll
    for (int i = 0; i < 4; ++i)
#pragma unroll
        for (int j = 0; j < 4; ++j) acc[i][j] = 0.f;
    const int arow = tid >> 2, akq = (tid & 3) * 4;
    const int bk = tid >> 4, bnq = (tid & 15) * 4;
    for (int k0 = 0; k0 < K; k0 += 16) {
        float4 av = make_float4(0.f, 0.f, 0.f, 0.f), bv = make_float4(0.f, 0.f, 0.f, 0.f);
        if (m0 + arow < M) av = *(const float4*)(A + (size_t)(m0 + arow) * lda + k0 + akq);
        if (n0 + bnq < N) bv = *(const float4*)(B + (size_t)(k0 + bk) * ldb + n0 + bnq);
        As[akq + 0][arow] = av.x; As[akq + 1][arow] = av.y; As[akq + 2][arow] = av.z; As[akq + 3][arow] = av.w;
        *(float4*)&Bs[bk][bnq] = bv;
        __syncthreads();
#pragma unroll
        for (int k = 0; k < 16; ++k) {
            const float4 a = *(const float4*)&As[k][ty * 4];
            const float4 b = *(const float4*)&Bs[k][tx * 4];
            const float aa[4] = {a.x, a.y, a.z, a.w}, bb[4] = {b.x, b.y, b.z, b.w};
#pragma unroll
            for (int i = 0; i < 4; ++i)
#pragma unroll
                for (int j = 0; j < 4; ++j) acc[i][j] = fmaf(aa[i], bb[j], acc[i][j]);
        }
        __syncthreads();
    }
#pragma unroll
    for (int i = 0; i < 4; ++i) {
        const int r = m0 + ty * 4 + i, c = n0 + tx * 4;
        if (r < M && c < N) *(float4*)(C + (size_t)r * ldc + c) = make_float4(acc[i][0], acc[i][1], acc[i][2], acc[i][3]);
    }
}

__global__ void build_flat(const float* __restrict__ proj, int col0, const float* __restrict__ pos, float* __restrict__ flat) {
    const int row = blockIdx.x;
    const int n = row >> 1, g = row & 1;
    for (int e = threadIdx.x; e < 2048; e += blockDim.x) {
        const int j = e >> 6, d = e & 63;
        flat[(size_t)row * 2048 + e] = proj[(size_t)(16 * n + j) * D_IN + col0 + g * 64 + d] + pos[j * 64 + d];
    }
}
__global__ void gelu_tanh_inplace(float* __restrict__ v, int n) {
    const int i = blockIdx.x * blockDim.x + threadIdx.x;
    if (i < n) { const float x = v[i]; v[i] = 0.5f * x * (1.f + tanhf(0.7978845608028654f * (x + 0.044715f * x * x * x))); }
}

template <int MODE>
__global__ __launch_bounds__(256) void attn_simple(const float* __restrict__ proj, const float* __restrict__ kc, const float* __restrict__ vc, const float* __restrict__ rel_bias,
                                                    float* __restrict__ out, int* __restrict__ sel) {
    constexpr int NK = (MODE == 0) ? NCMP : 512;
    __shared__ float qs[4][64];
    __shared__ float sc[4][512];
    __shared__ int blk[8];
    __shared__ float imp[32];
    const int t = blockIdx.x, g = blockIdx.y, tid = threadIdx.x;
    qs[tid >> 6][tid & 63] = proj[(size_t)t * D_IN + C_Q + (g * 4 + (tid >> 6)) * 64 + (tid & 63)] * 0.125f;
    if (MODE == 1 && tid < 8) blk[tid] = sel[(t * 2 + g) * 8 + tid];
    __syncthreads();
    for (int i = tid; i < NK; i += 256) {
        int dist, kpos; const float* krow;
        if (MODE == 0) { kpos = i; dist = t - (16 * i + 31); krow = kc + (size_t)(i * 2 + g) * 64; }
        else if (MODE == 1) { kpos = blk[i >> 6] * 64 + (i & 63); dist = t - kpos; krow = proj + (size_t)kpos * D_IN + C_KV + 256 + g * 64; }
        else { kpos = t - 511 + i; dist = 511 - i; krow = proj + (size_t)(kpos < 0 ? 0 : kpos) * D_IN + C_KV + 512 + g * 64; }
        const bool valid = (dist >= 0) && (MODE != 2 || kpos >= 0);
        float s0 = 0.f, s1 = 0.f, s2 = 0.f, s3 = 0.f;
        if (valid) {
#pragma unroll 4
            for (int d = 0; d < 64; d += 4) {
                const float4 kk = *(const float4*)(krow + d);
                s0 += kk.x * qs[0][d] + kk.y * qs[0][d + 1] + kk.z * qs[0][d + 2] + kk.w * qs[0][d + 3];
                s1 += kk.x * qs[1][d] + kk.y * qs[1][d + 1] + kk.z * qs[1][d + 2] + kk.w * qs[1][d + 3];
                s2 += kk.x * qs[2][d] + kk.y * qs[2][d + 1] + kk.z * qs[2][d + 2] + kk.w * qs[2][d + 3];
                s3 += kk.x * qs[3][d] + kk.y * qs[3][d + 1] + kk.z * qs[3][d + 2] + kk.w * qs[3][d + 3];
            }
            const float* rb = rel_bias + rel_bucket(dist) * 8 + g * 4;
            s0 += rb[0]; s1 += rb[1]; s2 += rb[2]; s3 += rb[3];
        } else { s0 = s1 = s2 = s3 = -1e30f; }
        sc[0][i] = s0; sc[1][i] = s1; sc[2][i] = s2; sc[3][i] = s3;
    }
    __syncthreads();
    {
        const int w = tid >> 6, lane = tid & 63;
        float mx = -1e30f;
        for (int i = lane; i < NK; i += 64) mx = fmaxf(mx, sc[w][i]);
#pragma unroll
        for (int o = 32; o > 0; o >>= 1) mx = fmaxf(mx, __shfl_xor(mx, o));
        float sum = 0.f;
        for (int i = lane; i < NK; i += 64) { const float s = sc[w][i]; const float e = (s > -1e29f) ? expf(s - mx) : 0.f; sc[w][i] = e; sum += e; }
#pragma unroll
        for (int o = 32; o > 0; o >>= 1) sum += __shfl_xor(sum, o);
        const float inv = (sum > 0.f) ? 1.f / sum : 0.f;
        for (int i = lane; i < NK; i += 64) sc[w][i] *= inv;
    }
    __syncthreads();
    {
        const int hg = tid >> 6, d = tid & 63;
        float acc = 0.f;
        for (int i = 0; i < NK; ++i) {
            const float p = sc[hg][i];
            if (p != 0.f) {
                const float* vrow;
                if (MODE == 0) vrow = vc + (size_t)(i * 2 + g) * 64;
                else if (MODE == 1) vrow = proj + (size_t)(blk[i >> 6] * 64 + (i & 63)) * D_IN + C_KV + 384 + g * 64;
                else vrow = proj + (size_t)(t - 511 + i) * D_IN + C_KV + 640 + g * 64;
                acc = fmaf(p, vrow[d], acc);
            }
        }
        out[(size_t)t * 512 + (g * 4 + hg) * 64 + d] = acc;
    }
    if (MODE == 0) {
        if (tid < 32) {
            const int j = tid; float s = 0.f;
            for (int n = 4 * j - 1; n <= 4 * j + 3; ++n) if (n >= 0 && n < NCMP) s += (sc[0][n] + sc[1][n]) + (sc[2][n] + sc[3][n]);
            const int cur = t >> 6;
            if (j == 0 || j == cur || j == cur - 1) s = 1e6f; else if (j > cur) s = -1e6f;
            imp[j] = s;
        }
        __syncthreads();
        if (tid == 0) {
            unsigned taken = 0u;
            for (int k = 0; k < 8; ++k) {
                int best = -1; float bv = 0.f;
                for (int j = 0; j < 32; ++j) if (!((taken >> j) & 1u)) { if (best < 0 || imp[j] > bv) { best = j; bv = imp[j]; } }
                taken |= 1u << best;
                sel[(t * 2 + g) * 8 + k] = best;
            }
        }
    }
}

__global__ void nsa_combine(const float* __restrict__ proj, const float* __restrict__ oc, const float* __restrict__ os, const float* __restrict__ ow, float* __restrict__ oa) {
    const int i = blockIdx.x * blockDim.x + threadIdx.x;
    if (i >= SEQ * 512) return;
    const int t = i >> 9, c = i & 511, h = c >> 6;
    const float* pr = proj + (size_t)t * D_IN;
    const float g0 = sigmoidf_(pr[C_GA + h]), g1 = sigmoidf_(pr[C_GA + 8 + h]), g2 = sigmoidf_(pr[C_GA + 16 + h]);
    const float o = g0 * oc[i] + g1 * os[i] + g2 * ow[i];
    oa[i] = o * siluf_(pr[C_ZA + c]);
}

__global__ __launch_bounds__(128) void dn_prep(const float* __restrict__ proj, const float* __restrict__ conv_w, const float* __restrict__ a_log, const float* __restrict__ dt_bias,
                                               float* __restrict__ qn, float* __restrict__ kn, float* __restrict__ vv, float* __restrict__ gg, float* __restrict__ bb) {
    __shared__ float red[2][2];
    const int t = blockIdx.x, h = blockIdx.y, d = threadIdx.x;
    float val[3];
#pragma unroll
    for (int part = 0; part < 3; ++part) {
        const int c = part * 512 + h * 128 + d;
        float a = 0.f;
#pragma unroll
        for (int w = 0; w < 4; ++w) { const int tt = t + w - 3; if (tt >= 0) a = fmaf(conv_w[w * 1536 + c], proj[(size_t)tt * D_IN + C_QKVB + c], a); }
        val[part] = siluf_(a);
    }
    float sq = val[0] * val[0], sk = val[1] * val[1];
#pragma unroll
    for (int o = 32; o > 0; o >>= 1) { sq += __shfl_xor(sq, o); sk += __shfl_xor(sk, o); }
    if ((d & 63) == 0) { red[d >> 6][0] = sq; red[d >> 6][1] = sk; }
    __syncthreads();
    sq = red[0][0] + red[1][0]; sk = red[0][1] + red[1][1];
    const size_t o = (size_t)t * 512 + h * 128 + d;
    qn[o] = val[0] * (1.0f / sqrtf(sq + 1e-6f));
    kn[o] = val[1] * (1.0f / sqrtf(sk + 1e-6f));
    vv[o] = val[2];
    if (d == 0) {
        const float* pr = proj + (size_t)t * D_IN;
        bb[t * 4 + h] = sigmoidf_(pr[C_BETA + h]);
        const float xx = pr[C_AB + h] + dt_bias[h];
        const float sp = (xx > 20.f) ? xx : log1pf(expf(xx));
        gg[t * 4 + h] = -expf(a_log[h]) * sp;
    }
}

__global__ __launch_bounds__(128) void dn_scan(const float* __restrict__ qn, const float* __restrict__ kn, const float* __restrict__ vv, const float* __restrict__ gg, const float* __restrict__ bb,
                                               float* __restrict__ od) {
    __shared__ float ks[2][128];
    __shared__ float qsh[2][128];
    const int h = blockIdx.x, c = threadIdx.x;
    float S[128];
#pragma unroll
    for (int k = 0; k < 128; ++k) S[k] = 0.f;
    const float qscale = 0.08838834764831845f;
    ks[0][c] = kn[(size_t)0 * 512 + h * 128 + c]; qsh[0][c] = qn[(size_t)0 * 512 + h * 128 + c];
    __syncthreads();
    for (int t = 0; t < SEQ; ++t) {
        const int cur = t & 1;
        if (t + 1 < SEQ) { ks[cur ^ 1][c] = kn[(size_t)(t + 1) * 512 + h * 128 + c]; qsh[cur ^ 1][c] = qn[(size_t)(t + 1) * 512 + h * 128 + c]; }
        const float alpha = expf(gg[t * 4 + h]), beta = bb[t * 4 + h];
        const float v = vv[(size_t)t * 512 + h * 128 + c];
        float kS = 0.f;
#pragma unroll
        for (int k = 0; k < 128; ++k) { S[k] *= alpha; kS = fmaf(ks[cur][k], S[k], kS); }
        const float vn = beta * (v - kS);
        float o = 0.f;
#pragma unroll
        for (int k = 0; k < 128; ++k) { S[k] = fmaf(ks[cur][k], vn, S[k]); o = fmaf(qsh[cur][k], S[k], o); }
        od[(size_t)t * 512 + h * 128 + c] = o * qscale;
        __syncthreads();
    }
}

__global__ __launch_bounds__(128) void dn_out(const float* __restrict__ proj, const float* __restrict__ od, const float* __restrict__ norm_w, float* __restrict__ ob) {
    __shared__ float red[2];
    const int t = blockIdx.x, h = blockIdx.y, d = threadIdx.x;
    const size_t o = (size_t)t * 512 + h * 128 + d;
    const float v = od[o];
    float s = v * v;
#pragma unroll
    for (int off = 32; off > 0; off >>= 1) s += __shfl_xor(s, off);
    if ((d & 63) == 0) red[d >> 6] = s;
    __syncthreads();
    s = (red[0] + red[1]) * (1.f / 128.f);
    ob[o] = v * (1.0f / sqrtf(s + 1e-6f)) * norm_w[d] * siluf_(proj[(size_t)t * D_IN + C_ZB + h * 128 + d]);
}

__global__ void merge_gate(const float* __restrict__ proj, const float* __restrict__ ya, const float* __restrict__ yb, float* __restrict__ m) {
    const int i = blockIdx.x * blockDim.x + threadIdx.x;
    if (i >= SEQ * 1024) return;
    const int t = i >> 10, c = i & 1023;
    const float* pr = proj + (size_t)t * D_IN + C_GM;
    m[i] = sigmoidf_(pr[c]) * ya[i] + sigmoidf_(pr[1024 + c]) * yb[i];
}
__global__ void resid_h(const float* __restrict__ x, const float* __restrict__ mixed, float* __restrict__ h) {
    const int i = blockIdx.x * blockDim.x + threadIdx.x;
    if (i < SEQ * 1024) h[i] = ALPHA * x[i] + mixed[i];
}
__global__ __launch_bounds__(256) void final_ln(const float* __restrict__ h, const float* __restrict__ hg, const float* __restrict__ pe, const float* __restrict__ ln_g, const float* __restrict__ ln_b, float* __restrict__ out) {
    __shared__ float red[4];
    const int t = blockIdx.x, tid = threadIdx.x;
    float v[4]; float s = 0.f;
#pragma unroll
    for (int j = 0; j < 4; ++j) { const size_t i = (size_t)t * 1024 + j * 256 + tid; v[j] = h[i] + sigmoidf_(hg[i]) * pe[i]; s += v[j]; }
#pragma unroll
    for (int o = 32; o > 0; o >>= 1) s += __shfl_xor(s, o);
    if ((tid & 63) == 0) red[tid >> 6] = s;
    __syncthreads();
    const float mean = (red[0] + red[1] + red[2] + red[3]) * (1.f / 1024.f);
    __syncthreads();
    float q = 0.f;
#pragma unroll
    for (int j = 0; j < 4; ++j) { v[j] -= mean; q += v[j] * v[j]; }
#pragma unroll
    for (int o = 32; o > 0; o >>= 1) q += __shfl_xor(q, o);
    if ((tid & 63) == 0) red[tid >> 6] = q;
    __syncthreads();
    const float rstd = 1.0f / sqrtf((red[0] + red[1] + red[2] + red[3]) * (1.f / 1024.f) + 1e-5f);
#pragma unroll
    for (int j = 0; j < 4; ++j) { const int c = j * 256 + tid; out[(size_t)t * 1024 + c] = v[j] * rstd * ln_g[c] + ln_b[c]; }
}

static void gemm(const float* A, int lda, const float* B, int ldb, float* C, int ldc, int M, int N, int K, hipStream_t s) {
    dim3 grid((N + 63) / 64, (M + 63) / 64);
    hipLaunchKernelGGL(gemm_f32, grid, dim3(256), 0, s, A, lda, B, ldb, C, ldc, M, N, K);
}

extern "C" void kernel_launch(void* const* d_in, const int* in_sizes, int n_in, void* d_out, int out_size, void* d_ws, size_t ws_size, hipStream_t stream) {
    const float* x = (const float*)d_in[0];
    const float* p = (const float*)d_in[1];
    const float* w_in = (const float*)d_in[2];
    const float* pos_k = (const float*)d_in[3];
    const float* pos_v = (const float*)d_in[4];
    const float* w1k = (const float*)d_in[5];
    const float* w2k = (const float*)d_in[6];
    const float* w1v = (const float*)d_in[7];
    const float* w2v = (const float*)d_in[8];
    const float* rel_bias = (const float*)d_in[9];
    const float* conv_w = (const float*)d_in[10];
    const float* a_log = (const float*)d_in[11];
    const float* dt_bias = (const float*)d_in[12];
    const float* norm_w = (const float*)d_in[13];
    const float* w_a = (const float*)d_in[14];
    const float* w_b = (const float*)d_in[15];
    const float* w_out = (const float*)d_in[16];
    const float* w_ple = (const float*)d_in[17];
    const float* w_pg = (const float*)d_in[18];
    const float* ln_g = (const float*)d_in[19];
    const float* ln_b = (const float*)d_in[20];
    float* out = (float*)d_out;
    float* ws = (float*)d_ws;
    size_t off = 0;
    auto take = [&](size_t n) { float* r = ws + off; off += (n + 63) & ~(size_t)63; return r; };
    float* proj = take((size_t)SEQ * D_IN);
    float* flat = take((size_t)256 * 2048);
    float* hid = take((size_t)256 * 256);
    float* kc = take((size_t)256 * 64);
    float* vc = take((size_t)256 * 64);
    float* oc = take((size_t)SEQ * 512);
    float* os = take((size_t)SEQ * 512);
    float* ow = take((size_t)SEQ * 512);
    int* sel = (int*)take((size_t)SEQ * 16);
    float* oa = take((size_t)SEQ * 512);
    float* qn = take((size_t)SEQ * 512);
    float* kn = take((size_t)SEQ * 512);
    float* vv = take((size_t)SEQ * 512);
    float* gg = take((size_t)SEQ * 4);
    float* bb = take((size_t)SEQ * 4);
    float* od = take((size_t)SEQ * 512);
    float* ob = take((size_t)SEQ * 512);
    float* ya = take((size_t)SEQ * 1024);
    float* yb = take((size_t)SEQ * 1024);
    float* mm = take((size_t)SEQ * 1024);
    float* mixed = take((size_t)SEQ * 1024);
    float* hh = take((size_t)SEQ * 1024);
    float* hg = take((size_t)SEQ * 1024);
    float* pe = take((size_t)SEQ * 1024);
    if (off * 4 > ws_size) { fprintf(stderr, "ws too small\n"); return; }

    for (int b = 0; b < BATCH; ++b) {
        const float* xb = x + (size_t)b * SEQ * D_MODEL;
        const float* pb = p + (size_t)b * SEQ * PLE;
        float* outb = out + (size_t)b * SEQ * D_MODEL;
        gemm(xb, D_MODEL, w_in, D_IN, proj, D_IN, SEQ, D_IN, D_MODEL, stream);
        hipLaunchKernelGGL(build_flat, dim3(254), dim3(256), 0, stream, proj, C_KV + 0, pos_k, flat);
        gemm(flat, 2048, w1k, 256, hid, 256, 254, 256, 2048, stream);
        hipLaunchKernelGGL(gelu_tanh_inplace, dim3(254), dim3(256), 0, stream, hid, 254 * 256);
        gemm(hid, 256, w2k, 64, kc, 64, 254, 64, 256, stream);
        hipLaunchKernelGGL(build_flat, dim3(254), dim3(256), 0, stream, proj, C_KV + 128, pos_v, flat);
        gemm(flat, 2048, w1v, 256, hid, 256, 254, 256, 2048, stream);
        hipLaunchKernelGGL(gelu_tanh_inplace, dim3(254), dim3(256), 0, stream, hid, 254 * 256);
        gemm(hid, 256, w2v, 64, vc, 64, 254, 64, 256, stream);
        hipLaunchKernelGGL(attn_simple<0>, dim3(SEQ, 2), dim3(256), 0, stream, proj, kc, vc, rel_bias, oc, sel);
        hipLaunchKernelGGL(attn_simple<1>, dim3(SEQ, 2), dim3(256), 0, stream, proj, kc, vc, rel_bias, os, sel);
        hipLaunchKernelGGL(attn_simple<2>, dim3(SEQ, 2), dim3(256), 0, stream, proj, kc, vc, rel_bias, ow, sel);
        hipLaunchKernelGGL(nsa_combine, dim3(SEQ * 512 / 256), dim3(256), 0, stream, proj, oc, os, ow, oa);
        hipLaunchKernelGGL(dn_prep, dim3(SEQ, 4), dim3(128), 0, stream, proj, conv_w, a_log, dt_bias, qn, kn, vv, gg, bb);
        hipLaunchKernelGGL(dn_scan, dim3(4), dim3(128), 0, stream, qn, kn, vv, gg, bb, od);
        hipLaunchKernelGGL(dn_out, dim3(SEQ, 4), dim3(128), 0, stream, proj, od, norm_w, ob);
        gemm(oa, 512, w_a, 1024, ya, 1024, SEQ, 1024, 512, stream);
        gemm(ob, 512, w_b, 1024, yb, 1024, SEQ, 1024, 512, stream);
        hipLaunchKernelGGL(merge_gate, dim3(SEQ * 1024 / 256), dim3(256), 0, stream, proj, ya, yb, mm);
        gemm(mm, 1024, w_out, 1024, mixed, 1024, SEQ, 1024, 1024, stream);
        hipLaunchKernelGGL(resid_h, dim3(SEQ * 1024 / 256), dim3(256), 0, stream, xb, mixed, hh);
        gemm(hh, 1024, w_pg, 1024, hg, 1024, SEQ, 1024, 1024, stream);
        gemm(pb, PLE, w_ple, 1024, pe, 1024, SEQ, 1024, PLE, stream);
        hipLaunchKernelGGL(final_ln, dim3(SEQ), dim3(256), 0, stream, hh, hg, pe, ln_g, ln_b, outb);
    }
}
```

```cpp
#include <hip/hip_runtime.h>
#include <hip/hip_cooperative_groups.h>
#include <cstdio>
#include <cstdint>
#include <cmath>
namespace cg = cooperative_groups;
namespace pg8 {
#define PG8_LAS __attribute__((address_space(3)))
typedef unsigned short bf16_t;
typedef short bf16x8 __attribute__((ext_vector_type(8)));
typedef float f32x4 __attribute__((ext_vector_type(4)));
typedef unsigned u32x4 __attribute__((ext_vector_type(4)));
constexpr int BM = 256, BK = 64, HALF = 128, HTB = HALF * BK * 2  , STAGE_BYTES = 8 * HTB, NXCD = 8, WGM = 8;

__host__ __device__ __forceinline__ int lds_byte(int r, int c) { const int st = (r >> 4) * 2 + (c >> 5), rr = r & 15, cc = c & 31, ob = rr * 64 + cc * 2; return st * 1024 + (ob ^ (((ob >> 9) & 1) << 5)); }
__host__ __device__ __forceinline__ void stage_rc(int b, int& R, int& C) { const int st = b / 1024, sb = b % 1024, swz = sb ^ (((sb >> 9) & 1) << 5); R = (st >> 1) * 16 + swz / 64; C = (st & 1) * 32 + (swz % 64) / 2; }
__host__ __device__ __forceinline__ int perm32(int rho) { const int n = rho >> 4, i = rho & 15; return 8 * (i >> 2) + 4 * n + (i & 3); }

struct Unit { int pm, pn; };
struct Gemm { const bf16_t* A; const bf16_t* Bt; int M, N, K; };

struct StaticOrder {
    int nM, nN, nwg, G, c;
    __host__ __device__ void init(int M, int N, int G_, int c_) { nM = M / BM; nN = N / BM; nwg = nM * nN; G = G_; c = c_; }
    __host__ __device__ bool next(int i, Unit& u) const {
        const long L = (long)i * G + c; if (L >= nwg) return false;
        int wgid = (int)L; { const int q = nwg / NXCD, r = nwg % NXCD, xcd = wgid % NXCD, off = wgid / NXCD; wgid = (xcd < r ? xcd * (q + 1) : r * (q + 1) + (xcd - r) * q) + off; }
        const int nig = WGM * nN, gid = wgid / nig, fm = gid * WGM, gsz = (nM - fm) < WGM ? (nM - fm) : WGM;
        u.pm = fm + ((wgid % nig) % gsz); u.pn = (wgid % nig) / gsz; return true;
    }
    __device__ __forceinline__ void a_ready(const Unit&) const {}
    __device__ __forceinline__ void done(const Unit&) const {}
};

__device__ __forceinline__ unsigned cvt_pk_bf16(float lo, float hi) { unsigned r; asm volatile("v_cvt_pk_bf16_f32 %0, %1, %2" : "=v"(r) : "v"(lo), "v"(hi)); return r; }
typedef float f32x2 __attribute__((ext_vector_type(2)));
template <class Epi, class Sched, bool ALIGN_EPI = false, bool SP2 = false>
__device__ __forceinline__ void gemm_phase(PG8_LAS unsigned char* lds, const Gemm g, const Sched& S, const Epi& E) {
    int tid_ = threadIdx.x; asm volatile("" : "+v"(tid_)); const int tid = tid_, wid = __builtin_amdgcn_readfirstlane(tid >> 6), lane = tid & 63, wr = wid >> 2, wc = wid & 3, fr = lane & 15, fq = lane >> 4;
    const int K = g.K, nt = K / BK;
    unsigned voffA[2], voffB[2];
#pragma unroll
    for (int i = 0; i < 2; ++i) { int R, C; stage_rc(tid * 16 + i * 8192, R, C); const int Rb = Epi::PERM ? ((R & ~31) + perm32(R & 31)) : R;
        voffA[i] = (unsigned)(R * K + C) * 2u; voffB[i] = (unsigned)(Rb * K + C) * 2u; }
    const size_t kstep = (size_t)(BK * 2);
    const size_t hstep = (size_t)HALF * K * 2;
    const size_t tstep = 2 * hstep;
    const unsigned ldsw = (unsigned)wid * 1024u;
    const int aoff = lds_byte(wr * 64 + fr, fq * 8), boff = lds_byte(wc * 32 + fr, fq * 8);
#define PG8_SA(b, h) (((b) * 2 + (h)) * HTB)
#define PG8_SB(b, h) ((4 + (b) * 2 + (h)) * HTB)
#define PG8_STAGE(bufoff, gbase, voff) do { _Pragma("unroll") for (int _i = 0; _i < 2; ++_i) \
        __builtin_amdgcn_global_load_lds((const unsigned*)((const char*)(gbase) + (voff)[_i]), (PG8_LAS unsigned*)(lds + (bufoff) + ldsw + _i * 8192), 16, 0, 0); } while (0)
#define PG8_LDA(dst, b, h) do { _Pragma("unroll") for (int m = 0; m < 4; ++m) _Pragma("unroll") for (int k = 0; k < 2; ++k) dst[m][k] = *(const PG8_LAS bf16x8*)(lds + PG8_SA(b, h) + aoff + m * 2048 + k * 1024); } while (0)
#define PG8_LDB(dst, b, h) do { _Pragma("unroll") for (int n = 0; n < 2; ++n) _Pragma("unroll") for (int k = 0; k < 2; ++k) dst[n][k] = *(const PG8_LAS bf16x8*)(lds + PG8_SB(b, h) + boff + n * 2048 + k * 1024); } while (0)
#define PG8_MMA(ai, bj, At, Bt) do { __builtin_amdgcn_s_setprio(1); _Pragma("unroll") for (int m = 0; m < 4; ++m) _Pragma("unroll") for (int n = 0; n < 2; ++n) _Pragma("unroll") for (int k = 0; k < 2; ++k) \
        acc[ai][bj][m][n] = __builtin_amdgcn_mfma_f32_16x16x32_bf16(Bt[n][k], At[m][k], acc[ai][bj][m][n], 0, 0, 0); __builtin_amdgcn_s_setprio(0); } while (0)
#define PG8_WAIT_V(n) asm volatile("s_waitcnt vmcnt(" #n ")" ::: "memory")
#define PG8_WAIT_L(n) asm volatile("s_waitcnt lgkmcnt(" #n ")" ::: "memory")
#define PG8_BAR __builtin_amdgcn_s_barrier()
#define PG8_SCHED __builtin_amdgcn_sched_barrier(0)
    Unit cur, nxt; int ui = 0;
    if (!S.next(0, cur)) return;
    f32x4 acc[2][2][4][2];
#pragma unroll
    for (int a = 0; a < 2; ++a)
#pragma unroll
        for (int b = 0; b < 2; ++b)
#pragma unroll
            for (int m = 0; m < 4; ++m)
#pragma unroll
                for (int n = 0; n < 2; ++n) acc[a][b][m][n] = (f32x4){0.f, 0.f, 0.f, 0.f};
    bf16x8 At[4][2], B0[2][2], B1[2][2];
    const char* cA = (const char*)g.A + (size_t)cur.pm * tstep; const char* cB = (const char*)g.Bt + (size_t)cur.pn * tstep;
    S.a_ready(cur);
    if constexpr (SP2) {
        PG8_STAGE(PG8_SB(0, 0), cB, voffB); PG8_STAGE(PG8_SB(0, 1), cB + hstep, voffB); PG8_STAGE(PG8_SA(0, 0), cA, voffA); PG8_STAGE(PG8_SA(0, 1), cA + hstep, voffA);
        if (wr == 1) PG8_BAR;
        PG8_WAIT_V(2); PG8_BAR;
        PG8_STAGE(PG8_SB(1, 0), cB + kstep, voffB); PG8_STAGE(PG8_SA(1, 0), cA + kstep, voffA); PG8_STAGE(PG8_SB(1, 1), cB + hstep + kstep, voffB);
        PG8_WAIT_V(6); PG8_BAR;
    } else {
        PG8_STAGE(PG8_SB(0, 0), cB, voffB); PG8_STAGE(PG8_SA(0, 0), cA, voffA); PG8_STAGE(PG8_SB(0, 1), cB + hstep, voffB); PG8_STAGE(PG8_SA(0, 1), cA + hstep, voffA);
        if (wr == 1) PG8_BAR;
        PG8_WAIT_V(4); PG8_BAR;
        PG8_STAGE(PG8_SB(1, 0), cB + kstep, voffB); PG8_STAGE(PG8_SA(1, 0), cA + kstep, voffA); PG8_STAGE(PG8_SB(1, 1), cB + hstep + kstep, voffB);
        PG8_WAIT_V(6); PG8_BAR;
    }
    for (;;) {
        const bool has_next = S.next(ui + 1, nxt);
        const char* nA = has_next ? (const char*)g.A + (size_t)nxt.pm * tstep : cA; const char* nB = has_next ? (const char*)g.Bt + (size_t)nxt.pn * tstep : cB;
        for (int t = 0; t < nt; t += 2) {
            const bool last = (t == nt - 2);
            const char* a1 = cA + (size_t)(t + 1) * kstep;
            const char* a2 = last ? nA : cA + (size_t)(t + 2) * kstep; const char* b2 = last ? nB : cB + (size_t)(t + 2) * kstep;
            const char* a3 = a2 + kstep; const char* b3 = b2 + kstep;
            if (last && has_next) S.a_ready(nxt);
            if constexpr (SP2) {
            PG8_LDB(B0, 0, 0); PG8_LDB(B1, 0, 1); PG8_SCHED; PG8_LDA(At, 0, 0); PG8_STAGE(PG8_SA(1, 1), a1 + hstep, voffA);
            PG8_WAIT_V(8); PG8_WAIT_L(0); PG8_BAR; PG8_MMA(0, 0, At, B0); PG8_MMA(0, 1, At, B1); PG8_BAR; PG8_SCHED;
            PG8_LDA(At, 0, 1); PG8_STAGE(PG8_SB(0, 0), b2, voffB); PG8_STAGE(PG8_SB(0, 1), b2 + hstep, voffB); PG8_STAGE(PG8_SA(0, 0), a2, voffA);
            PG8_WAIT_V(8); PG8_WAIT_L(0); PG8_BAR; PG8_MMA(1, 0, At, B0); PG8_MMA(1, 1, At, B1); PG8_BAR; PG8_SCHED;
            PG8_LDB(B0, 1, 0); PG8_LDB(B1, 1, 1); PG8_SCHED; PG8_LDA(At, 1, 0); PG8_STAGE(PG8_SA(0, 1), a2 + hstep, voffA);
            PG8_WAIT_V(8); PG8_WAIT_L(0); PG8_BAR; PG8_MMA(0, 0, At, B0); PG8_MMA(0, 1, At, B1); PG8_BAR; PG8_SCHED;
            PG8_LDA(At, 1, 1); PG8_STAGE(PG8_SB(1, 0), b3, voffB); PG8_STAGE(PG8_SB(1, 1), b3 + hstep, voffB); PG8_STAGE(PG8_SA(1, 0), a3, voffA);
            PG8_WAIT_V(8); PG8_WAIT_L(0); PG8_BAR; PG8_MMA(1, 0, At, B0); PG8_MMA(1, 1, At, B1); PG8_BAR; PG8_SCHED;
            } else {
            PG8_LDB(B0, 0, 0); PG8_SCHED; PG8_LDA(At, 0, 0); PG8_STAGE(PG8_SA(1, 1), a1 + hstep, voffA);
            PG8_WAIT_L(8); PG8_BAR; PG8_WAIT_L(0); PG8_MMA(0, 0, At, B0); PG8_BAR; PG8_SCHED;
            PG8_LDB(B1, 0, 1); PG8_STAGE(PG8_SB(0, 0), b2, voffB);
            PG8_BAR; PG8_WAIT_L(0); PG8_MMA(0, 1, At, B1); PG8_BAR;
            PG8_LDA(At, 0, 1); PG8_STAGE(PG8_SA(0, 0), a2, voffA);
            PG8_BAR; PG8_WAIT_L(0); PG8_MMA(1, 0, At, B0); PG8_BAR; PG8_SCHED;
            PG8_STAGE(PG8_SB(0, 1), b2 + hstep, voffB);
            PG8_WAIT_V(6); PG8_BAR; PG8_MMA(1, 1, At, B1); PG8_BAR;
            PG8_LDB(B0, 1, 0); PG8_SCHED; PG8_LDA(At, 1, 0); PG8_STAGE(PG8_SA(0, 1), a2 + hstep, voffA);
            PG8_WAIT_L(8); PG8_BAR; PG8_WAIT_L(0); PG8_MMA(0, 0, At, B0); PG8_BAR; PG8_SCHED;
            PG8_LDB(B1, 1, 1); PG8_STAGE(PG8_SB(1, 0), b3, voffB);
            PG8_BAR; PG8_WAIT_L(0); PG8_MMA(0, 1, At, B1); PG8_BAR;
            PG8_LDA(At, 1, 1); PG8_STAGE(PG8_SA(1, 0), a3, voffA);
            PG8_BAR; PG8_WAIT_L(0); PG8_MMA(1, 0, At, B0); PG8_BAR; PG8_SCHED;
            PG8_STAGE(PG8_SB(1, 1), b3 + hstep, voffB);
            PG8_WAIT_V(6); PG8_BAR; PG8_MMA(1, 1, At, B1); PG8_BAR;
            }
        }
        if constexpr (ALIGN_EPI) { if (wr == 0) PG8_BAR; }
        if constexpr (!Epi::AFTER_DRAIN) { E(acc, cur, wr, wc, fr, fq); S.done(cur); }
        if (!has_next) break;
#pragma unroll
        for (int a = 0; a < 2; ++a)
#pragma unroll
            for (int b = 0; b < 2; ++b)
#pragma unroll
                for (int m = 0; m < 4; ++m)
#pragma unroll
                    for (int n = 0; n < 2; ++n) acc[a][b][m][n] = (f32x4){0.f, 0.f, 0.f, 0.f};
        cur = nxt; cA = nA; cB = nB; ++ui;
        if constexpr (ALIGN_EPI) { if (wr == 1) PG8_BAR; }
    }
    PG8_WAIT_V(0);
    if constexpr (!ALIGN_EPI) { if (wr == 0) PG8_BAR; }
    PG8_BAR;
    if constexpr (Epi::AFTER_DRAIN) { E.fused(acc, cur, wr, wc, fr, fq, lds, wid, lane); S.done(cur); }
#undef PG8_SA
#undef PG8_SB
#undef PG8_STAGE
#undef PG8_LDA
#undef PG8_LDB
#undef PG8_MMA
#undef PG8_WAIT_V
#undef PG8_WAIT_L
#undef PG8_BAR
#undef PG8_SCHED
}
}

constexpr int T = 16384, SEQ = 2048, DM = 1024;
constexpr float ALPHA = 1.189207115002721f;
typedef unsigned short bf16;
typedef unsigned u32;
typedef unsigned u32x4 __attribute__((ext_vector_type(4)));
typedef unsigned u32x2 __attribute__((ext_vector_type(2)));
typedef float f32x4 __attribute__((ext_vector_type(4)));
typedef short bf16x8 __attribute__((ext_vector_type(8)));
#define LAS __attribute__((address_space(3)))
constexpr size_t MiB = (size_t)1 << 20;
constexpr size_t WS_WIN = 1 * MiB, WS_W1K = 13 * MiB, WS_W1V = 14 * MiB, WS_WA = 15 * MiB, WS_WB = 16 * MiB, WS_WOUT = 17 * MiB, WS_WPG = 19 * MiB, WS_WPLE = 21 * MiB;
constexpr size_t WS_PB = 22 * MiB, WS_SM = 30 * MiB, WS_XB = 32 * MiB, WS_Q = 64 * MiB, WS_KV = 80 * MiB, WS_ZA = 104 * MiB, WS_QKVB = 120 * MiB, WS_ZB = 168 * MiB, WS_GM = 184 * MiB;
constexpr size_t WS_HID = 248 * MiB, WS_KC = 250 * MiB, WS_VC = 250 * MiB + 512 * 1024, WS_SEL = 251 * MiB, WS_GG = 251 * MiB + 256 * 1024, WS_BB = 251 * MiB + 512 * 1024, WS_END = 252 * MiB;
constexpr size_t WS_OACC = WS_XB, WS_OD = WS_QKVB, WS_OA = WS_QKVB + 32 * MiB, WS_PARTA = 32 * MiB, WS_M = 96 * MiB, WS_H = 32 * MiB, WS_HB = 128 * MiB, WS_PE = 184 * MiB;
constexpr int LDS_BYTES = 147456;

__device__ __forceinline__ float bf2f(unsigned v) { return __uint_as_float(v << 16); }
__device__ __forceinline__ unsigned f2bf(float f) { unsigned u = __float_as_uint(f); return (u + 0x7fffu + ((u >> 16) & 1u)) >> 16; }
__device__ __forceinline__ unsigned pk2(float lo, float hi) { return f2bf(lo) | (f2bf(hi) << 16); }
__device__ __forceinline__ float fexp(float x) { return __builtin_amdgcn_exp2f(x * 1.4426950408889634f); }
__device__ __forceinline__ float sigm(float x) { return __builtin_amdgcn_rcpf(1.f + fexp(-x)); }
__device__ __forceinline__ float siluf_(float x) { return x * sigm(x); }
__device__ __forceinline__ int rel_bucket(int n) {
    if (n < 16) return n < 0 ? 0 : n;
    return 16 + (n >= 21) + (n >= 27) + (n >= 35) + (n >= 46) + (n >= 59) + (n >= 77) + (n >= 99) + (n >= 128) + (n >= 166) + (n >= 216) + (n >= 280) + (n >= 363) + (n >= 470) + (n >= 609) + (n >= 790);
}
#define LDS_WAIT() asm volatile("s_waitcnt lgkmcnt(0)" ::: "memory")
__device__ __forceinline__ float wshfl_xor(float v, int o, int tid) { return __int_as_float(__builtin_amdgcn_ds_bpermute(((tid ^ o) & 63) << 2, __float_as_int(v))); }

struct Args { const float* in[21]; float* out; unsigned char* ws; };

__device__ __forceinline__ int win_srccol(int r) {
    if (r < 1280) return r;
    if (r < 3328) return r + 24;
    if (r < 5888) return r + 32;
    if (r < 5912) return 1280 + (r - 5888);
    if (r < 5916) return 3352 + (r - 5912);
    if (r < 5920) return 3356 + (r - 5916);
    return -1;
}
template <bool REMAP>
__device__ __forceinline__ void transpose_item(const float* __restrict__ W, int K, int N, bf16* __restrict__ WT, LAS float* scr, int k0, int n0, int lane) {
    const int sc = REMAP ? win_srccol(n0 + (lane & 31)) : n0 + (lane & 31);
#pragma unroll 8
    for (int i = 0; i < 32; ++i) { const int kk = 2 * i + (lane >> 5); scr[kk * 33 + (lane & 31)] = (sc >= 0) ? W[(size_t)(k0 + kk) * N + sc] : 0.f; }
    LDS_WAIT();
    const int c = lane & 7;
#pragma unroll
    for (int j = 0; j < 4; ++j) { const int n = (lane >> 3) + 8 * j; const LAS float* s = scr + (8 * c) * 33 + n;
        u32x4 o; o.x = pk2(s[0 * 33], s[1 * 33]); o.y = pk2(s[2 * 33], s[3 * 33]); o.z = pk2(s[4 * 33], s[5 * 33]); o.w = pk2(s[6 * 33], s[7 * 33]);
        *(u32x4*)(WT + (size_t)(n0 + n) * K + k0 + 8 * c) = o; }
    LDS_WAIT();
}
__device__ __forceinline__ void p0_prologue(const Args& a, LAS unsigned char* lds, int tid) {
    const int lane = tid & 63, wave = tid >> 6;
    LAS float* scr = (LAS float*)(lds + wave * 8704);
    const int gw = blockIdx.x * 8 + wave, NGW = gridDim.x * 8;
    unsigned char* ws = a.ws;
    constexpr int I_WIN = 16 * 192, I_W1 = 32 * 8, I_WAB = 8 * 32, I_WSQ = 16 * 32, I_WPLE = 4 * 32;
    constexpr int NITEMS = I_WIN + 2 * I_W1 + 2 * I_WAB + 2 * I_WSQ + I_WPLE;
    for (int it = gw; it < NITEMS; it += NGW) {
        int r = it;
        if (r < I_WIN) { transpose_item<true>(a.in[2], 1024, 5920, (bf16*)(ws + WS_WIN), scr, (r / 192) * 64, (r % 192) * 32, lane); continue; } r -= I_WIN;
        if (r < I_W1) { transpose_item<false>(a.in[5], 2048, 256, (bf16*)(ws + WS_W1K), scr, (r / 8) * 64, (r % 8) * 32, lane); continue; } r -= I_W1;
        if (r < I_W1) { transpose_item<false>(a.in[7], 2048, 256, (bf16*)(ws + WS_W1V), scr, (r / 8) * 64, (r % 8) * 32, lane); continue; } r -= I_W1;
        if (r < I_WAB) { transpose_item<false>(a.in[14], 512, 1024, (bf16*)(ws + WS_WA), scr, (r / 32) * 64, (r % 32) * 32, lane); continue; } r -= I_WAB;
        if (r < I_WAB) { transpose_item<false>(a.in[15], 512, 1024, (bf16*)(ws + WS_WB), scr, (r / 32) * 64, (r % 32) * 32, lane); continue; } r -= I_WAB;
        if (r < I_WSQ) { transpose_item<false>(a.in[16], 1024, 1024, (bf16*)(ws + WS_WOUT), scr, (r / 32) * 64, (r % 32) * 32, lane); continue; } r -= I_WSQ;
        if (r < I_WSQ) { transpose_item<false>(a.in[18], 1024, 1024, (bf16*)(ws + WS_WPG), scr, (r / 32) * 64, (r % 32) * 32, lane); continue; } r -= I_WSQ;
        transpose_item<false>(a.in[17], 256, 1024, (bf16*)(ws + WS_WPLE), scr, (r / 32) * 64, (r % 32) * 32, lane);
    }
    const float* x = a.in[0]; bf16* xb = (bf16*)(ws + WS_XB);
    for (int m = gw; m < T; m += NGW) {
        const f32x4* xr = (const f32x4*)(x + (size_t)m * 1024) + lane; u32x2* o = (u32x2*)(xb + (size_t)m * 1024) + lane;
#pragma unroll
        for (int j = 0; j < 4; ++j) { const f32x4 v = xr[64 * j]; u32x2 w; w.x = pk2(v.x, v.y); w.y = pk2(v.z, v.w); o[64 * j] = w; }
    }
    const float* p = a.in[1]; bf16* pb = (bf16*)(ws + WS_PB);
    for (int m = gw; m < T; m += NGW) {
        const f32x4 v = ((const f32x4*)(p + (size_t)m * 256))[lane]; u32x2 w; w.x = pk2(v.x, v.y); w.y = pk2(v.z, v.w); ((u32x2*)(pb + (size_t)m * 256))[lane] = w;
    }
}

struct EpiProj {
    static constexpr bool PERM = true, AFTER_DRAIN = false;
    unsigned char* ws;
    __device__ __forceinline__ void operator()(const pg8::f32x4 (&acc)[2][2][4][2], const pg8::Unit& u, int wr, int wc, int fr, int fq) const {
        const int pn = u.pn; const int row0 = u.pm * 256 + wr * 64 + fr;
        if (pn == 23) {
            if (wc == 0) { float* sm = (float*)(ws + WS_SM);
#pragma unroll
                for (int ai = 0; ai < 2; ++ai)
#pragma unroll
                    for (int m = 0; m < 4; ++m) { float* o = sm + (size_t)(row0 + ai * 128 + m * 16) * 32 + 8 * fq; *(f32x4*)o = acc[ai][0][m][0]; *(f32x4*)(o + 4) = acc[ai][0][m][1]; } }
            return;
        }
        int kind, ldc, colt; size_t boff;
        if (pn < 2) { kind = 1; boff = WS_Q; ldc = 512; colt = pn * 256; }
        else if (pn < 5) { kind = 0; boff = WS_KV; ldc = 768; colt = (pn - 2) * 256; }
        else if (pn < 7) { kind = 2; boff = WS_ZA; ldc = 512; colt = (pn - 5) * 256; }
        else if (pn < 13) { kind = 0; boff = WS_QKVB; ldc = 1536; colt = (pn - 7) * 256; }
        else if (pn < 15) { kind = 2; boff = WS_ZB; ldc = 512; colt = (pn - 13) * 256; }
        else { kind = 3; boff = WS_GM; ldc = 2048; colt = (pn - 15) * 256; }
        bf16* base = (bf16*)(ws + boff); const int col0 = colt + wc * 32 + 8 * fq;
#pragma unroll
        for (int ai = 0; ai < 2; ++ai)
#pragma unroll
            for (int m = 0; m < 4; ++m) { bf16* rowp = base + (size_t)(row0 + ai * 128 + m * 16) * ldc + col0;
#pragma unroll
                for (int bj = 0; bj < 2; ++bj) { float v[8];
#pragma unroll
                    for (int e = 0; e < 4; ++e) { v[e] = acc[ai][bj][m][0][e]; v[4 + e] = acc[ai][bj][m][1][e]; }
                    if (kind == 1) {
#pragma unroll
                        for (int e = 0; e < 8; ++e) v[e] *= 0.125f;
                    } else if (kind == 2) {
#pragma unroll
                        for (int e = 0; e < 8; ++e) v[e] = siluf_(v[e]);
                    } else if (kind == 3) {
#pragma unroll
                        for (int e = 0; e < 8; ++e) v[e] = sigm(v[e]);
                    }
                    u32x4 w; w.x = pk2(v[0], v[1]); w.y = pk2(v[2], v[3]); w.z = pk2(v[4], v[5]); w.w = pk2(v[6], v[7]);
                    *(u32x4*)(rowp + bj * 128) = w; } }
    }
};
struct EpiYA {
    static constexpr bool PERM = true, AFTER_DRAIN = false;
    const bf16* gm; float* part;
    __device__ __forceinline__ void operator()(const pg8::f32x4 (&acc)[2][2][4][2], const pg8::Unit& u, int wr, int wc, int fr, int fq) const {
        const int row0 = u.pm * 256 + wr * 64 + fr, col0 = u.pn * 256 + wc * 32 + 8 * fq;
#pragma unroll
        for (int ai = 0; ai < 2; ++ai)
#pragma unroll
            for (int m = 0; m < 4; ++m)
#pragma unroll
                for (int bj = 0; bj < 2; ++bj) { const size_t r = row0 + ai * 128 + m * 16; const int c = col0 + bj * 128;
                    const u32x4 g = *(const u32x4*)(gm + r * 2048 + c);
                    f32x4 o0, o1;
                    o0.x = acc[ai][bj][m][0].x * bf2f(g.x & 0xffffu); o0.y = acc[ai][bj][m][0].y * bf2f(g.x >> 16); o0.z = acc[ai][bj][m][0].z * bf2f(g.y & 0xffffu); o0.w = acc[ai][bj][m][0].w * bf2f(g.y >> 16);
                    o1.x = acc[ai][bj][m][1].x * bf2f(g.z & 0xffffu); o1.y = acc[ai][bj][m][1].y * bf2f(g.z >> 16); o1.z = acc[ai][bj][m][1].z * bf2f(g.w & 0xffffu); o1.w = acc[ai][bj][m][1].w * bf2f(g.w >> 16);
                    float* o = part + r * 1024 + c; *(f32x4*)o = o0; *(f32x4*)(o + 4) = o1; }
    }
};
struct EpiYB {
    static constexpr bool PERM = true, AFTER_DRAIN = false;
    const bf16* gm; const float* part; bf16* mo;
    __device__ __forceinline__ void operator()(const pg8::f32x4 (&acc)[2][2][4][2], const pg8::Unit& u, int wr, int wc, int fr, int fq) const {
        const int row0 = u.pm * 256 + wr * 64 + fr, col0 = u.pn * 256 + wc * 32 + 8 * fq;
#pragma unroll
        for (int ai = 0; ai < 2; ++ai)
#pragma unroll
            for (int m = 0; m < 4; ++m)
#pragma unroll
                for (int bj = 0; bj < 2; ++bj) { const size_t r = row0 + ai * 128 + m * 16; const int c = col0 + bj * 128;
                    const u32x4 g = *(const u32x4*)(gm + r * 2048 + 1024 + c);
                    const float* pp = part + r * 1024 + c; const f32x4 p0 = *(const f32x4*)pp, p1 = *(const f32x4*)(pp + 4);
                    f32x4 o0, o1;
                    o0.x = p0.x + acc[ai][bj][m][0].x * bf2f(g.x & 0xffffu); o0.y = p0.y + acc[ai][bj][m][0].y * bf2f(g.x >> 16); o0.z = p0.z + acc[ai][bj][m][0].z * bf2f(g.y & 0xffffu); o0.w = p0.w + acc[ai][bj][m][0].w * bf2f(g.y >> 16);
                    o1.x = p1.x + acc[ai][bj][m][1].x * bf2f(g.z & 0xffffu); o1.y = p1.y + acc[ai][bj][m][1].y * bf2f(g.z >> 16); o1.z = p1.z + acc[ai][bj][m][1].z * bf2f(g.w & 0xffffu); o1.w = p1.w + acc[ai][bj][m][1].w * bf2f(g.w >> 16);
                    u32x4 w; w.x = pk2(o0.x, o0.y); w.y = pk2(o0.z, o0.w); w.z = pk2(o1.x, o1.y); w.w = pk2(o1.z, o1.w);
                    *(u32x4*)(mo + r * 1024 + c) = w; }
    }
};
struct EpiH {
    static constexpr bool PERM = true, AFTER_DRAIN = false;
    const float* x; float* h; bf16* hb;
    __device__ __forceinline__ void operator()(const pg8::f32x4 (&acc)[2][2][4][2], const pg8::Unit& u, int wr, int wc, int fr, int fq) const {
        const int row0 = u.pm * 256 + wr * 64 + fr, col0 = u.pn * 256 + wc * 32 + 8 * fq;
#pragma unroll
        for (int ai = 0; ai < 2; ++ai)
#pragma unroll
            for (int m = 0; m < 4; ++m)
#pragma unroll
                for (int bj = 0; bj < 2; ++bj) { const size_t off = (size_t)(row0 + ai * 128 + m * 16) * 1024 + col0 + bj * 128;
                    const f32x4 x0 = *(const f32x4*)(x + off), x1 = *(const f32x4*)(x + off + 4);
                    const f32x4 o0 = x0 * ALPHA + acc[ai][bj][m][0], o1 = x1 * ALPHA + acc[ai][bj][m][1];
                    *(f32x4*)(h + off) = o0; *(f32x4*)(h + off + 4) = o1;
                    u32x4 w; w.x = pk2(o0.x, o0.y); w.y = pk2(o0.z, o0.w); w.z = pk2(o1.x, o1.y); w.w = pk2(o1.z, o1.w);
                    *(u32x4*)(hb + off) = w; }
    }
};
struct EpiPE {
    static constexpr bool PERM = true, AFTER_DRAIN = false;
    float* pe;
    __device__ __forceinline__ void operator()(const pg8::f32x4 (&acc)[2][2][4][2], const pg8::Unit& u, int wr, int wc, int fr, int fq) const {
        const int row0 = u.pm * 256 + wr * 64 + fr, col0 = u.pn * 256 + wc * 32 + 8 * fq;
#pragma unroll
        for (int ai = 0; ai < 2; ++ai)
#pragma unroll
            for (int m = 0; m < 4; ++m)
#pragma unroll
                for (int bj = 0; bj < 2; ++bj) { const size_t off = (size_t)(row0 + ai * 128 + m * 16) * 1024 + col0 + bj * 128;
                    *(f32x4*)(pe + off) = acc[ai][bj][m][0]; *(f32x4*)(pe + off + 4) = acc[ai][bj][m][1]; }
    }
};
struct EpiGate {
    static constexpr bool PERM = true, AFTER_DRAIN = false;
    const float* h; const float* pe; float* out;
    __device__ __forceinline__ void operator()(const pg8::f32x4 (&acc)[2][2][4][2], const pg8::Unit& u, int wr, int wc, int fr, int fq) const {
        const int row0 = u.pm * 256 + wr * 64 + fr, col0 = u.pn * 256 + wc * 32 + 8 * fq;
#pragma unroll
        for (int ai = 0; ai < 2; ++ai)
#pragma unroll
            for (int m = 0; m < 4; ++m)
#pragma unroll
                for (int bj = 0; bj < 2; ++bj) { const size_t off = (size_t)(row0 + ai * 128 + m * 16) * 1024 + col0 + bj * 128;
                    const f32x4 h0 = *(const f32x4*)(h + off), h1 = *(const f32x4*)(h + off + 4), p0 = *(const f32x4*)(pe + off), p1 = *(const f32x4*)(pe + off + 4);
                    f32x4 o0, o1;
                    o0.x = h0.x + sigm(acc[ai][bj][m][0].x) * p0.x; o0.y = h0.y + sigm(acc[ai][bj][m][0].y) * p0.y; o0.z = h0.z + sigm(acc[ai][bj][m][0].z) * p0.z; o0.w = h0.w + sigm(acc[ai][bj][m][0].w) * p0.w;
                    o1.x = h1.x + sigm(acc[ai][bj][m][1].x) * p1.x; o1.y = h1.y + sigm(acc[ai][bj][m][1].y) * p1.y; o1.z = h1.z + sigm(acc[ai][bj][m][1].z) * p1.z; o1.w = h1.w + sigm(acc[ai][bj][m][1].w) * p1.w;
                    *(f32x4*)(out + off) = o0; *(f32x4*)(out + off + 4) = o1; }
    }
};

template <class LA, class LB, class ST>
__device__ __forceinline__ void sgemm_tile64(LAS float* As, LAS float* Bs, int K, int tid, LA loadA4, LB loadB4, ST store4) {
    const int tx = tid & 15, ty = (tid >> 4) & 15;
    float acc[4][4];
#pragma unroll
    for (int i = 0; i < 4; ++i)
#pragma unroll
        for (int j = 0; j < 4; ++j) acc[i][j] = 0.f;
    const int arow = (tid >> 2) & 63, akq = (tid & 3) * 4, bk = (tid >> 4) & 15, bnq = (tid & 15) * 4;
    for (int k0 = 0; k0 < K; k0 += 16) {
        if (tid < 256) {
            const f32x4 av = loadA4(arow, k0 + akq), bv = loadB4(k0 + bk, bnq);
            As[(akq + 0) * 68 + arow] = av.x; As[(akq + 1) * 68 + arow] = av.y; As[(akq + 2) * 68 + arow] = av.z; As[(akq + 3) * 68 + arow] = av.w;
            *(LAS f32x4*)&Bs[bk * 68 + bnq] = bv;
        }
        __syncthreads();
        if (tid < 256) {
#pragma unroll
            for (int k = 0; k < 16; ++k) {
                const f32x4 av = *(const LAS f32x4*)&As[k * 68 + ty * 4], bv = *(const LAS f32x4*)&Bs[k * 68 + tx * 4];
#pragma unroll
                for (int i = 0; i < 4; ++i)
#pragma unroll
                    for (int j = 0; j < 4; ++j) acc[i][j] = fmaf(av[i], bv[j], acc[i][j]);
            }
        }
        __syncthreads();
    }
    if (tid < 256) {
#pragma unroll
        for (int i = 0; i < 4; ++i) store4(ty * 4 + i, tx * 4, (f32x4){acc[i][0], acc[i][1], acc[i][2], acc[i][3]});
    }
}

__device__ __forceinline__ void dn_prep_phase(const Args& a, LAS unsigned char* lds, int tid) {
    unsigned char* ws = a.ws;
    const bf16* qkvb = (const bf16*)(ws + WS_QKVB); const float* sm = (const float*)(ws + WS_SM);
    const float* conv_w = a.in[10]; const float* a_log = a.in[11]; const float* dt_bias = a.in[12];
    bf16* qn = (bf16*)a.out; bf16* kn = qn + (size_t)T * 512; bf16* vv = kn + (size_t)T * 512;
    float* gg = (float*)(ws + WS_GG); float* bb = (float*)(ws + WS_BB);
    LAS float* red = (LAS float*)lds;
    const int h = tid >> 7, d = tid & 127, wave = tid >> 6;
    float cw[3][4];
#pragma unroll
    for (int part = 0; part < 3; ++part)
#pragma unroll
        for (int w = 0; w < 4; ++w) cw[part][w] = conv_w[w * 1536 + part * 512 + h * 128 + d];
    for (int t = blockIdx.x; t < T; t += gridDim.x) {
        const int ts = t & (SEQ - 1);
        float val[3];
#pragma unroll
        for (int part = 0; part < 3; ++part) { const int c = part * 512 + h * 128 + d; float acc = 0.f;
#pragma unroll
            for (int w = 0; w < 4; ++w) if (ts + w - 3 >= 0) acc = fmaf(cw[part][w], bf2f(qkvb[(size_t)(t + w - 3) * 1536 + c]), acc);
            val[part] = siluf_(acc); }
        float sq = val[0] * val[0], sk = val[1] * val[1];
#pragma unroll
        for (int o = 32; o > 0; o >>= 1) { sq += wshfl_xor(sq, o, tid); sk += wshfl_xor(sk, o, tid); }
        if ((tid & 63) == 0) { red[wave * 2] = sq; red[wave * 2 + 1] = sk; }
        __syncthreads();
        sq = red[(h * 2) * 2] + red[(h * 2 + 1) * 2]; sk = red[(h * 2) * 2 + 1] + red[(h * 2 + 1) * 2 + 1];
        const size_t o = (size_t)t * 512 + h * 128 + d;
        qn[o] = (bf16)f2bf(val[0] * (1.0f / sqrtf(sq + 1e-6f)));
        kn[o] = (bf16)f2bf(val[1] * (1.0f / sqrtf(sk + 1e-6f)));
        vv[o] = (bf16)f2bf(val[2]);
        if (d == 0) {
            bb[t * 4 + h] = 1.f / (1.f + expf(-sm[(size_t)t * 32 + 24 + h]));
            const float xx = sm[(size_t)t * 32 + 28 + h] + dt_bias[h];
            const float sp = (xx > 20.f) ? xx : log1pf(expf(xx));
            gg[t * 4 + h] = -expf(a_log[h]) * sp;
        }
        __syncthreads();
    }
}

__device__ __forceinline__ void cmp_gemm1_phase(const Args& a, LAS unsigned char* lds, int tid) {
    unsigned char* ws = a.ws; const bf16* kv = (const bf16*)(ws + WS_KV); bf16* hid = (bf16*)(ws + WS_HID);
    LAS float* As = (LAS float*)lds; LAS float* Bs = As + 16 * 68;
    for (int u = blockIdx.x; u < 256; u += gridDim.x) {
        const int which = u >> 7, mt = (u >> 2) & 31, nt = u & 3;
        const float* pos = a.in[3 + which]; const float* w1 = a.in[which ? 7 : 5];
        const int col0 = which * 128;
        auto la = [&](int r, int k) -> f32x4 {
            const int row = mt * 64 + r, g = row & 1, bn = row >> 1, b = bn >> 7, n = bn & 127, j = k >> 6, d = k & 63;
            const u32x2 w = *(const u32x2*)(kv + (size_t)(b * SEQ + 16 * n + j) * 768 + col0 + g * 64 + d);
            const f32x4 pv = *(const f32x4*)(pos + j * 64 + d);
            return (f32x4){bf2f(w.x & 0xffffu) + pv.x, bf2f(w.x >> 16) + pv.y, bf2f(w.y & 0xffffu) + pv.z, bf2f(w.y >> 16) + pv.w};
        };
        auto lb = [&](int k, int c) -> f32x4 { return *(const f32x4*)(w1 + (size_t)k * 256 + nt * 64 + c); };
        auto st = [&](int r, int c, f32x4 v) {
            float o[4];
#pragma unroll
            for (int e = 0; e < 4; ++e) { const float x = v[e]; o[e] = 0.5f * x * (1.f + tanhf(0.7978845608028654f * (x + 0.044715f * x * x * x))); }
            u32x2 w; w.x = pk2(o[0], o[1]); w.y = pk2(o[2], o[3]);
            *(u32x2*)(hid + ((size_t)which * 2048 + mt * 64 + r) * 256 + nt * 64 + c) = w;
        };
        sgemm_tile64(As, Bs, 2048, tid, la, lb, st);
    }
}
__device__ __forceinline__ void cmp_gemm2_phase(const Args& a, LAS unsigned char* lds, int tid) {
    unsigned char* ws = a.ws; const bf16* hid = (const bf16*)(ws + WS_HID);
    LAS float* As = (LAS float*)lds; LAS float* Bs = As + 16 * 68;
    for (int u = blockIdx.x; u < 64; u += gridDim.x) {
        const int which = u >> 5, mt = u & 31;
        const float* w2 = a.in[which ? 8 : 6]; float* outp = (float*)(ws + (which ? WS_VC : WS_KC));
        auto la = [&](int r, int k) -> f32x4 { const u32x2 w = *(const u32x2*)(hid + ((size_t)which * 2048 + mt * 64 + r) * 256 + k);
            return (f32x4){bf2f(w.x & 0xffffu), bf2f(w.x >> 16), bf2f(w.y & 0xffffu), bf2f(w.y >> 16)}; };
        auto lb = [&](int k, int c) -> f32x4 { return *(const f32x4*)(w2 + (size_t)k * 64 + c); };
        auto st = [&](int r, int c, f32x4 v) { *(f32x4*)(outp + (size_t)(mt * 64 + r) * 64 + c) = v; };
        sgemm_tile64(As, Bs, 256, tid, la, lb, st);
    }
}

template <int MODE>
__device__ __forceinline__ void attn_simple_phase(const Args& a, LAS unsigned char* lds, int tid) {
    constexpr int NK = (MODE == 0) ? 127 : 512;
    unsigned char* ws = a.ws;
    const bf16* Q = (const bf16*)(ws + WS_Q); const bf16* KV = (const bf16*)(ws + WS_KV); const float* sm = (const float*)(ws + WS_SM);
    const float* kc = (const float*)(ws + WS_KC); const float* vc = (const float*)(ws + WS_VC);
    const float* rel_bias = a.in[9];
    float* oacc = (float*)(ws + WS_OACC); u32* sel = (u32*)(ws + WS_SEL);
    const bf16* za = (const bf16*)(ws + WS_ZA); bf16* oa = (bf16*)(ws + WS_OA);
    const int sb = tid >> 8, stid = tid & 255;
    LAS float* qs = (LAS float*)(lds + sb * 12288);
    LAS float* sc = qs + 256;
    LAS int* blk = (LAS int*)(sc + 2048);
    LAS float* imp = (LAS float*)(blk + 8);
    const int NU = T * 2, G2 = gridDim.x * 2;
    for (int u0 = 0; u0 < NU; u0 += G2) {
        const int u = u0 + blockIdx.x * 2 + sb; const bool act = u < NU;
        const int t = act ? (u >> 1) : 0, g = u & 1, ts = t & (SEQ - 1), tb = t - ts;
        qs[stid] = bf2f(Q[(size_t)t * 512 + (g * 4 + (stid >> 6)) * 64 + (stid & 63)]);
        if (MODE == 1 && stid == 0) { u32 mk = sel[t * 2 + g]; int k = 0; for (int j = 0; j < 32; ++j) if ((mk >> j) & 1u) { if (k < 8) blk[k] = j; ++k; } for (; k < 8; ++k) blk[k] = 0; }
        __syncthreads();
        for (int i = stid; i < NK; i += 256) {
            int dist, kpos; bool valid; const bf16* kb = nullptr; const float* kf = nullptr;
            if (MODE == 0) { dist = ts - (16 * i + 31); valid = dist >= 0; kf = kc + (size_t)((((tb >> 11) * 128) + i) * 2 + g) * 64; }
            else if (MODE == 1) { kpos = blk[i >> 6] * 64 + (i & 63); dist = ts - kpos; valid = dist >= 0; kb = KV + (size_t)(tb + kpos) * 768 + 256 + g * 64; }
            else { kpos = ts - 511 + i; dist = 511 - i; valid = kpos >= 0; kb = KV + (size_t)(tb + (kpos < 0 ? 0 : kpos)) * 768 + 512 + g * 64; }
            float s0 = 0.f, s1 = 0.f, s2 = 0.f, s3 = 0.f;
            if (valid) {
#pragma unroll 2
                for (int d = 0; d < 64; d += 8) {
                    float kk[8];
                    if (MODE == 0) { const f32x4 k0 = *(const f32x4*)(kf + d), k1 = *(const f32x4*)(kf + d + 4); kk[0] = k0.x; kk[1] = k0.y; kk[2] = k0.z; kk[3] = k0.w; kk[4] = k1.x; kk[5] = k1.y; kk[6] = k1.z; kk[7] = k1.w; }
                    else { const u32x4 w = *(const u32x4*)(kb + d); kk[0] = bf2f(w.x & 0xffffu); kk[1] = bf2f(w.x >> 16); kk[2] = bf2f(w.y & 0xffffu); kk[3] = bf2f(w.y >> 16); kk[4] = bf2f(w.z & 0xffffu); kk[5] = bf2f(w.z >> 16); kk[6] = bf2f(w.w & 0xffffu); kk[7] = bf2f(w.w >> 16); }
#pragma unroll
                    for (int e = 0; e < 8; ++e) { s0 = fmaf(kk[e], qs[d + e], s0); s1 = fmaf(kk[e], qs[64 + d + e], s1); s2 = fmaf(kk[e], qs[128 + d + e], s2); s3 = fmaf(kk[e], qs[192 + d + e], s3); }
                }
                const float* rb = rel_bias + rel_bucket(dist) * 8 + g * 4;
                s0 += rb[0]; s1 += rb[1]; s2 += rb[2]; s3 += rb[3];
            } else { s0 = s1 = s2 = s3 = -1e30f; }
            sc[i] = s0; sc[512 + i] = s1; sc[1024 + i] = s2; sc[1536 + i] = s3;
        }
        __syncthreads();
        {
            const int w = stid >> 6, lane = stid & 63; LAS float* row = sc + w * 512;
            float mx = -1e30f;
            for (int i = lane; i < NK; i += 64) mx = fmaxf(mx, row[i]);
#pragma unroll
            for (int o = 32; o > 0; o >>= 1) mx = fmaxf(mx, wshfl_xor(mx, o, tid));
            float sum = 0.f;
            for (int i = lane; i < NK; i += 64) { const float s = row[i]; const float e = (s > -1e29f) ? expf(s - mx) : 0.f; row[i] = e; sum += e; }
#pragma unroll
            for (int o = 32; o > 0; o >>= 1) sum += wshfl_xor(sum, o, tid);
            const float inv = (sum > 0.f) ? 1.f / sum : 0.f;
            for (int i = lane; i < NK; i += 64) row[i] *= inv;
        }
        __syncthreads();
        {
            const int hg = stid >> 6, d = stid & 63; const LAS float* row = sc + hg * 512;
            float acc = 0.f;
            for (int i = 0; i < NK; ++i) {
                const float p = row[i];
                if (p != 0.f) {
                    float v;
                    if (MODE == 0) v = vc[(size_t)((((tb >> 11) * 128) + i) * 2 + g) * 64 + d];
                    else if (MODE == 1) v = bf2f(KV[(size_t)(tb + blk[i >> 6] * 64 + (i & 63)) * 768 + 384 + g * 64 + d]);
                    else v = bf2f(KV[(size_t)(tb + ts - 511 + i) * 768 + 640 + g * 64 + d]);
                    acc = fmaf(p, v, acc);
                }
            }
            if (act) {
                const int h = g * 4 + hg; const size_t o = (size_t)t * 512 + h * 64 + d;
                const float gate = 1.f / (1.f + expf(-sm[(size_t)t * 32 + (MODE == 0 ? 0 : MODE == 1 ? 8 : 16) + h]));
                if (MODE == 2) oacc[o] = gate * acc;
                else if (MODE == 0) oacc[o] += gate * acc;
                else oa[o] = (bf16)f2bf((oacc[o] + gate * acc) * bf2f(za[o]));
            }
        }
        if (MODE == 0) {
            if (stid < 32) {
                const int j = stid; float s = 0.f;
                for (int n = 4 * j - 1; n <= 4 * j + 3; ++n) if (n >= 0 && n < 127) s += (sc[n] + sc[512 + n]) + (sc[1024 + n] + sc[1536 + n]);
                const int cur = ts >> 6;
                if (j == 0 || j == cur || j == cur - 1) s = 1e6f; else if (j > cur) s = -1e6f;
                imp[j] = s;
            }
            __syncthreads();
            if (stid == 0 && act) {
                u32 taken = 0u;
                for (int k = 0; k < 8; ++k) { int best = -1; float bv = 0.f;
                    for (int j = 0; j < 32; ++j) if (!((taken >> j) & 1u)) { const float x = imp[j]; if (best < 0 || x > bv) { best = j; bv = x; } }
                    taken |= 1u << best; }
                sel[t * 2 + g] = taken;
            }
        }
        __syncthreads();
    }
}

__device__ __forceinline__ void dn_scan_phase(const Args& a, LAS unsigned char* lds, int tid) {
    if (tid >= 64) return;
    unsigned char* ws = a.ws; const int lane = tid, kq = lane >> 4, vc = lane & 15;
    const bf16* qn = (const bf16*)a.out; const bf16* kn = qn + (size_t)T * 512; const bf16* vv = kn + (size_t)T * 512;
    const float* gg = (const float*)(ws + WS_GG); const float* bb = (const float*)(ws + WS_BB);
    float* od = (float*)(ws + WS_OD);
    LAS unsigned char* kbuf = lds; LAS unsigned char* qbuf = lds + 16384; LAS unsigned char* vbuf = lds + 32768;
    for (int u = blockIdx.x; u < 256; u += gridDim.x) {
        const int b = u >> 5, h = (u >> 3) & 3, vb = u & 7;
        float S[32];
#pragma unroll
        for (int k = 0; k < 32; ++k) S[k] = 0.f;
        for (int c = 0; c < 32; ++c) {
            const int t0 = b * SEQ + c * 64;
#pragma unroll 4
            for (int i = 0; i < 16; ++i) { const int p = i * 64 + lane, row = p >> 4, ch = p & 15;
                *(LAS u32x4*)(kbuf + row * 256 + ch * 16) = *(const u32x4*)(kn + (size_t)(t0 + row) * 512 + h * 128 + ch * 8);
                *(LAS u32x4*)(qbuf + row * 256 + ch * 16) = *(const u32x4*)(qn + (size_t)(t0 + row) * 512 + h * 128 + ch * 8); }
#pragma unroll
            for (int i = 0; i < 2; ++i) { const int p = i * 64 + lane, row = p >> 1, ch = p & 1;
                *(LAS u32x4*)(vbuf + row * 32 + ch * 16) = *(const u32x4*)(vv + (size_t)(t0 + row) * 512 + h * 128 + vb * 16 + ch * 8); }
            const float gl = gg[(t0 + lane) * 4 + h], bl = bb[(t0 + lane) * 4 + h];
            LDS_WAIT();
            for (int s = 0; s < 64; ++s) {
                const float alpha = expf(__int_as_float(__builtin_amdgcn_readlane(__float_as_int(gl), s)));
                const float beta = __int_as_float(__builtin_amdgcn_readlane(__float_as_int(bl), s));
                const float v = bf2f(*(const LAS bf16*)(vbuf + s * 32 + vc * 2));
                float kk[32];
#pragma unroll
                for (int k8 = 0; k8 < 4; ++k8) { const u32x4 w = *(const LAS u32x4*)(kbuf + s * 256 + kq * 64 + k8 * 16);
                    kk[k8 * 8 + 0] = bf2f(w.x & 0xffffu); kk[k8 * 8 + 1] = bf2f(w.x >> 16); kk[k8 * 8 + 2] = bf2f(w.y & 0xffffu); kk[k8 * 8 + 3] = bf2f(w.y >> 16);
                    kk[k8 * 8 + 4] = bf2f(w.z & 0xffffu); kk[k8 * 8 + 5] = bf2f(w.z >> 16); kk[k8 * 8 + 6] = bf2f(w.w & 0xffffu); kk[k8 * 8 + 7] = bf2f(w.w >> 16); }
                float kS = 0.f;
#pragma unroll
                for (int k = 0; k < 32; ++k) { S[k] *= alpha; kS = fmaf(kk[k], S[k], kS); }
                kS += wshfl_xor(kS, 16, tid); kS += wshfl_xor(kS, 32, tid);
                const float vn = beta * (v - kS);
                float o = 0.f;
#pragma unroll
                for (int k8 = 0; k8 < 4; ++k8) { const u32x4 wq = *(const LAS u32x4*)(qbuf + s * 256 + kq * 64 + k8 * 16);
                    const float qq[8] = {bf2f(wq.x & 0xffffu), bf2f(wq.x >> 16), bf2f(wq.y & 0xffffu), bf2f(wq.y >> 16), bf2f(wq.z & 0xffffu), bf2f(wq.z >> 16), bf2f(wq.w & 0xffffu), bf2f(wq.w >> 16)};
#pragma unroll
                    for (int e = 0; e < 8; ++e) { S[k8 * 8 + e] = fmaf(kk[k8 * 8 + e], vn, S[k8 * 8 + e]); o = fmaf(qq[e], S[k8 * 8 + e], o); } }
                o += wshfl_xor(o, 16, tid); o += wshfl_xor(o, 32, tid);
                if (kq == 0) od[(size_t)(t0 + s) * 512 + h * 128 + vb * 16 + vc] = o * 0.08838834764831845f;
            }
            LDS_WAIT();
        }
    }
}

__device__ __forceinline__ void dn_out_phase(const Args& a, LAS unsigned char* lds, int tid) {
    unsigned char* ws = a.ws; const float* od = (const float*)(ws + WS_OD); const bf16* zb = (const bf16*)(ws + WS_ZB); const float* norm_w = a.in[13];
    bf16* ob = (bf16*)a.out;
    LAS float* red = (LAS float*)lds;
    const int h = tid >> 7, d = tid & 127, wave = tid >> 6; const float nw = norm_w[d];
    for (int t = blockIdx.x; t < T; t += gridDim.x) {
        const size_t o = (size_t)t * 512 + h * 128 + d;
        const float v = od[o]; float s = v * v;
#pragma unroll
        for (int off = 32; off > 0; off >>= 1) s += wshfl_xor(s, off, tid);
        if ((tid & 63) == 0) red[wave] = s;
        __syncthreads();
        s = (red[h * 2] + red[h * 2 + 1]) * (1.f / 128.f);
        ob[o] = (bf16)f2bf(v * (1.0f / sqrtf(s + 1e-6f)) * nw * bf2f(zb[o]));
        __syncthreads();
    }
}

__device__ __forceinline__ void final_ln_phase(const Args& a, int tid) {
    const int lane = tid & 63, wave = tid >> 6; const int gw = blockIdx.x * 8 + wave, NGW = gridDim.x * 8;
    const float* ln_g = a.in[19]; const float* ln_b = a.in[20];
    f32x4 gv[4], bv[4];
#pragma unroll
    for (int j = 0; j < 4; ++j) { gv[j] = ((const f32x4*)ln_g)[lane + 64 * j]; bv[j] = ((const f32x4*)ln_b)[lane + 64 * j]; }
    for (int m = gw; m < T; m += NGW) {
        f32x4* xr = (f32x4*)(a.out + (size_t)m * 1024) + lane;
        f32x4 v[4]; float s = 0.f;
#pragma unroll
        for (int j = 0; j < 4; ++j) { v[j] = xr[64 * j]; s += (v[j].x + v[j].y) + (v[j].z + v[j].w); }
#pragma unroll
        for (int o = 1; o < 64; o <<= 1) s += wshfl_xor(s, o, tid);
        const float mean = s * (1.f / 1024.f); float s2 = 0.f;
#pragma unroll
        for (int j = 0; j < 4; ++j) { v[j] = v[j] - mean; s2 += (v[j].x * v[j].x + v[j].y * v[j].y) + (v[j].z * v[j].z + v[j].w * v[j].w); }
#pragma unroll
        for (int o = 1; o < 64; o <<= 1) s2 += wshfl_xor(s2, o, tid);
        const float rstd = 1.0f / sqrtf(s2 * (1.f / 1024.f) + 1e-5f);
#pragma unroll
        for (int j = 0; j < 4; ++j) xr[64 * j] = v[j] * rstd * gv[j] + bv[j];
    }
}

__global__ void __launch_bounds__(512, 2) mega_fwd(Args a) {
    extern __shared__ __attribute__((aligned(16))) unsigned char lds_raw[];
    LAS unsigned char* lds = (LAS unsigned char*)lds_raw;
    cg::grid_group grid = cg::this_grid();
    int tid = threadIdx.x; const int G = gridDim.x;
    unsigned char* ws = a.ws;
#define FRESH_TID() do { tid = threadIdx.x; asm volatile("" : "+v"(tid)); } while (0)

    FRESH_TID();
    p0_prologue(a, lds, tid);
    grid.sync();
    { pg8::Gemm g{(const pg8::bf16_t*)(ws + WS_XB), (const pg8::bf16_t*)(ws + WS_WIN), T, 6144, 1024}; pg8::StaticOrder S; S.init(T, 6144, G, (int)blockIdx.x);
      EpiProj E{ws}; pg8::gemm_phase<EpiProj, pg8::StaticOrder, true, true>(lds, g, S, E); }
    grid.sync();
    FRESH_TID(); dn_prep_phase(a, lds, tid);
    __syncthreads();
    FRESH_TID(); cmp_gemm1_phase(a, lds, tid);
    __syncthreads();
    FRESH_TID(); attn_simple_phase<2>(a, lds, tid);
    grid.sync();
    FRESH_TID(); cmp_gemm2_phase(a, lds, tid);
    __syncthreads();
    FRESH_TID(); dn_scan_phase(a, lds, tid);
    grid.sync();
    FRESH_TID(); attn_simple_phase<0>(a, lds, tid);
    grid.sync();
    FRESH_TID(); attn_simple_phase<1>(a, lds, tid);
    __syncthreads();
    FRESH_TID(); dn_out_phase(a, lds, tid);
    grid.sync();
    { pg8::Gemm g{(const pg8::bf16_t*)(ws + WS_OA), (const pg8::bf16_t*)(ws + WS_WA), T, 1024, 512}; pg8::StaticOrder S; S.init(T, 1024, G, (int)blockIdx.x);
      EpiYA E{(const bf16*)(ws + WS_GM), (float*)(ws + WS_PARTA)}; pg8::gemm_phase<EpiYA, pg8::StaticOrder, true, true>(lds, g, S, E); }
    { pg8::Gemm g{(const pg8::bf16_t*)a.out, (const pg8::bf16_t*)(ws + WS_WB), T, 1024, 512}; pg8::StaticOrder S; S.init(T, 1024, G, (int)blockIdx.x);
      EpiYB E{(const bf16*)(ws + WS_GM), (const float*)(ws + WS_PARTA), (bf16*)(ws + WS_M)}; pg8::gemm_phase<EpiYB, pg8::StaticOrder, true, true>(lds, g, S, E); }
    grid.sync();
    { pg8::Gemm g{(const pg8::bf16_t*)(ws + WS_M), (const pg8::bf16_t*)(ws + WS_WOUT), T, 1024, 1024}; pg8::StaticOrder S; S.init(T, 1024, G, (int)blockIdx.x);
      EpiH E{a.in[0], (float*)(ws + WS_H), (bf16*)(ws + WS_HB)}; pg8::gemm_phase<EpiH, pg8::StaticOrder, true, true>(lds, g, S, E); }
    { pg8::Gemm g{(const pg8::bf16_t*)(ws + WS_PB), (const pg8::bf16_t*)(ws + WS_WPLE), T, 1024, 256}; pg8::StaticOrder S; S.init(T, 1024, G, (int)blockIdx.x);
      EpiPE E{(float*)(ws + WS_PE)}; pg8::gemm_phase<EpiPE, pg8::StaticOrder, true, true>(lds, g, S, E); }
    grid.sync();
    { pg8::Gemm g{(const pg8::bf16_t*)(ws + WS_HB), (const pg8::bf16_t*)(ws + WS_WPG), T, 1024, 1024}; pg8::StaticOrder S; S.init(T, 1024, G, (int)blockIdx.x);
      EpiGate E{(const float*)(ws + WS_H), (const float*)(ws + WS_PE), a.out}; pg8::gemm_phase<EpiGate, pg8::StaticOrder, true, true>(lds, g, S, E); }
    grid.sync();
    FRESH_TID(); final_ln_phase(a, tid);
}

extern "C" void kernel_launch(void* const* d_in, const int* in_sizes, int n_in, void* d_out, int out_size, void* d_ws, size_t ws_size, hipStream_t stream) {
    static int grid = 0;
    if (grid == 0) {
        if (n_in != 21 || out_size != T * DM || ws_size < WS_END) { fprintf(stderr, "kernel_launch: unexpected shapes (n_in %d out %d ws %zu)\n", n_in, out_size, ws_size); grid = -1; return; }
        int dev = 0, cus = 0, per_cu = 0;
        hipGetDevice(&dev); hipDeviceGetAttribute(&cus, hipDeviceAttributeMultiprocessorCount, dev);
        hipFuncSetAttribute((const void*)mega_fwd, hipFuncAttributeMaxDynamicSharedMemorySize, LDS_BYTES);
        hipOccupancyMaxActiveBlocksPerMultiprocessor(&per_cu, (const void*)mega_fwd, 512, LDS_BYTES);
        if (per_cu < 1) { fprintf(stderr, "kernel_launch: occupancy query says %d blocks/CU\n", per_cu); per_cu = 1; }
        grid = cus;
        (void)hipGetLastError();
    }
    if (grid < 0) return;
    Args a{};
    for (int i = 0; i < 21; ++i) a.in[i] = (const float*)d_in[i];
    a.out = (float*)d_out; a.ws = (unsigned char*)d_ws;
    void* args[] = {&a};
    hipError_t e = hipLaunchCooperativeKernel((const void*)mega_fwd, dim3(grid), dim3(512), args, LDS_BYTES, stream);
    if (e != hipSuccess) fprintf(stderr, "cooperative launch failed: %s (grid %d)\n", hipGetErrorString(e), grid);
}
```

```cpp
#include <hip/hip_runtime.h>
#include <hip/hip_cooperative_groups.h>
#include <cstdio>
#include <cstdint>
#include <cmath>
namespace cg = cooperative_groups;
namespace pg8 {
#define PG8_LAS __attribute__((address_space(3)))
typedef unsigned short bf16_t;
typedef short bf16x8 __attribute__((ext_vector_type(8)));
typedef float f32x4 __attribute__((ext_vector_type(4)));
typedef unsigned u32x4 __attribute__((ext_vector_type(4)));
constexpr int BM = 256, BK = 64, HALF = 128, HTB = HALF * BK * 2  , STAGE_BYTES = 8 * HTB, NXCD = 8, WGM = 8;

__host__ __device__ __forceinline__ int lds_byte(int r, int c) { const int st = (r >> 4) * 2 + (c >> 5), rr = r & 15, cc = c & 31, ob = rr * 64 + cc * 2; return st * 1024 + (ob ^ (((ob >> 9) & 1) << 5)); }
__host__ __device__ __forceinline__ void stage_rc(int b, int& R, int& C) { const int st = b / 1024, sb = b % 1024, swz = sb ^ (((sb >> 9) & 1) << 5); R = (st >> 1) * 16 + swz / 64; C = (st & 1) * 32 + (swz % 64) / 2; }
__host__ __device__ __forceinline__ int perm32(int rho) { const int n = rho >> 4, i = rho & 15; return 8 * (i >> 2) + 4 * n + (i & 3); }

struct Unit { int pm, pn; };
struct Gemm { const bf16_t* A; const bf16_t* Bt; int M, N, K; };

struct StaticOrder {
    int nM, nN, nwg, G, c;
    __host__ __device__ void init(int M, int N, int G_, int c_) { nM = M / BM; nN = N / BM; nwg = nM * nN; G = G_; c = c_; }
    __host__ __device__ bool next(int i, Unit& u) const {
        const long L = (long)i * G + c; if (L >= nwg) return false;
        int wgid = (int)L; { const int q = nwg / NXCD, r = nwg % NXCD, xcd = wgid % NXCD, off = wgid / NXCD; wgid = (xcd < r ? xcd * (q + 1) : r * (q + 1) + (xcd - r) * q) + off; }
        const int nig = WGM * nN, gid = wgid / nig, fm = gid * WGM, gsz = (nM - fm) < WGM ? (nM - fm) : WGM;
        u.pm = fm + ((wgid % nig) % gsz); u.pn = (wgid % nig) / gsz; return true;
    }
    __device__ __forceinline__ void a_ready(const Unit&) const {}
    __device__ __forceinline__ void done(const Unit&) const {}
};

__device__ __forceinline__ unsigned cvt_pk_bf16(float lo, float hi) { unsigned r; asm volatile("v_cvt_pk_bf16_f32 %0, %1, %2" : "=v"(r) : "v"(lo), "v"(hi)); return r; }
typedef float f32x2 __attribute__((ext_vector_type(2)));
template <class Epi, class Sched, bool ALIGN_EPI = false, bool SP2 = false>
__device__ __forceinline__ void gemm_phase(PG8_LAS unsigned char* lds, const Gemm g, const Sched& S, const Epi& E) {
    int tid_ = threadIdx.x; asm volatile("" : "+v"(tid_)); const int tid = tid_, wid = __builtin_amdgcn_readfirstlane(tid >> 6), lane = tid & 63, wr = wid >> 2, wc = wid & 3, fr = lane & 15, fq = lane >> 4;
    const int K = g.K, nt = K / BK;
    unsigned voffA[2], voffB[2];
#pragma unroll
    for (int i = 0; i < 2; ++i) { int R, C; stage_rc(tid * 16 + i * 8192, R, C); const int Rb = Epi::PERM ? ((R & ~31) + perm32(R & 31)) : R;
        voffA[i] = (unsigned)(R * K + C) * 2u; voffB[i] = (unsigned)(Rb * K + C) * 2u; }
    const size_t kstep = (size_t)(BK * 2);
    const size_t hstep = (size_t)HALF * K * 2;
    const size_t tstep = 2 * hstep;
    const unsigned ldsw = (unsigned)wid * 1024u;
    const int aoff = lds_byte(wr * 64 + fr, fq * 8), boff = lds_byte(wc * 32 + fr, fq * 8);
#define PG8_SA(b, h) (((b) * 2 + (h)) * HTB)
#define PG8_SB(b, h) ((4 + (b) * 2 + (h)) * HTB)
#define PG8_STAGE(bufoff, gbase, voff) do { _Pragma("unroll") for (int _i = 0; _i < 2; ++_i) \
        __builtin_amdgcn_global_load_lds((const unsigned*)((const char*)(gbase) + (voff)[_i]), (PG8_LAS unsigned*)(lds + (bufoff) + ldsw + _i * 8192), 16, 0, 0); } while (0)
#define PG8_LDA(dst, b, h) do { _Pragma("unroll") for (int m = 0; m < 4; ++m) _Pragma("unroll") for (int k = 0; k < 2; ++k) dst[m][k] = *(const PG8_LAS bf16x8*)(lds + PG8_SA(b, h) + aoff + m * 2048 + k * 1024); } while (0)
#define PG8_LDB(dst, b, h) do { _Pragma("unroll") for (int n = 0; n < 2; ++n) _Pragma("unroll") for (int k = 0; k < 2; ++k) dst[n][k] = *(const PG8_LAS bf16x8*)(lds + PG8_SB(b, h) + boff + n * 2048 + k * 1024); } while (0)
#define PG8_MMA(ai, bj, At, Bt) do { __builtin_amdgcn_s_setprio(1); _Pragma("unroll") for (int m = 0; m < 4; ++m) _Pragma("unroll") for (int n = 0; n < 2; ++n) _Pragma("unroll") for (int k = 0; k < 2; ++k) \
        acc[ai][bj][m][n] = __builtin_amdgcn_mfma_f32_16x16x32_bf16(Bt[n][k], At[m][k], acc[ai][bj][m][n], 0, 0, 0); __builtin_amdgcn_s_setprio(0); } while (0)
#define PG8_WAIT_V(n) asm volatile("s_waitcnt vmcnt(" #n ")" ::: "memory")
#define PG8_WAIT_L(n) asm volatile("s_waitcnt lgkmcnt(" #n ")" ::: "memory")
#define PG8_BAR __builtin_amdgcn_s_barrier()
#define PG8_SCHED __builtin_amdgcn_sched_barrier(0)
    Unit cur, nxt; int ui = 0;
    if (!S.next(0, cur)) return;
    f32x4 acc[2][2][4][2];
#pragma unroll
    for (int a = 0; a < 2; ++a)
#pragma unroll
        for (int b = 0; b < 2; ++b)
#pragma unroll
            for (int m = 0; m < 4; ++m)
#pragma unroll
                for (int n = 0; n < 2; ++n) acc[a][b][m][n] = (f32x4){0.f, 0.f, 0.f, 0.f};
    bf16x8 At[4][2], B0[2][2], B1[2][2];
    const char* cA = (const char*)g.A + (size_t)cur.pm * tstep; const char* cB = (const char*)g.Bt + (size_t)cur.pn * tstep;
    S.a_ready(cur);
    if constexpr (SP2) {
        PG8_STAGE(PG8_SB(0, 0), cB, voffB); PG8_STAGE(PG8_SB(0, 1), cB + hstep, voffB); PG8_STAGE(PG8_SA(0, 0), cA, voffA); PG8_STAGE(PG8_SA(0, 1), cA + hstep, voffA);
        if (wr == 1) PG8_BAR;
        PG8_WAIT_V(2); PG8_BAR;
        PG8_STAGE(PG8_SB(1, 0), cB + kstep, voffB); PG8_STAGE(PG8_SA(1, 0), cA + kstep, voffA); PG8_STAGE(PG8_SB(1, 1), cB + hstep + kstep, voffB);
        PG8_WAIT_V(6); PG8_BAR;
    } else {
        PG8_STAGE(PG8_SB(0, 0), cB, voffB); PG8_STAGE(PG8_SA(0, 0), cA, voffA); PG8_STAGE(PG8_SB(0, 1), cB + hstep, voffB); PG8_STAGE(PG8_SA(0, 1), cA + hstep, voffA);
        if (wr == 1) PG8_BAR;
        PG8_WAIT_V(4); PG8_BAR;
        PG8_STAGE(PG8_SB(1, 0), cB + kstep, voffB); PG8_STAGE(PG8_SA(1, 0), cA + kstep, voffA); PG8_STAGE(PG8_SB(1, 1), cB + hstep + kstep, voffB);
        PG8_WAIT_V(6); PG8_BAR;
    }
    for (;;) {
        const bool has_next = S.next(ui + 1, nxt);
        const char* nA = has_next ? (const char*)g.A + (size_t)nxt.pm * tstep : cA; const char* nB = has_next ? (const char*)g.Bt + (size_t)nxt.pn * tstep : cB;
        for (int t = 0; t < nt; t += 2) {
            const bool last = (t == nt - 2);
            const char* a1 = cA + (size_t)(t + 1) * kstep;
            const char* a2 = last ? nA : cA + (size_t)(t + 2) * kstep; const char* b2 = last ? nB : cB + (size_t)(t + 2) * kstep;
            const char* a3 = a2 + kstep; const char* b3 = b2 + kstep;
            if (last && has_next) S.a_ready(nxt);
            if constexpr (SP2) {
            PG8_LDB(B0, 0, 0); PG8_LDB(B1, 0, 1); PG8_SCHED; PG8_LDA(At, 0, 0); PG8_STAGE(PG8_SA(1, 1), a1 + hstep, voffA);
            PG8_WAIT_V(8); PG8_WAIT_L(0); PG8_BAR; PG8_MMA(0, 0, At, B0); PG8_MMA(0, 1, At, B1); PG8_BAR; PG8_SCHED;
            PG8_LDA(At, 0, 1); PG8_STAGE(PG8_SB(0, 0), b2, voffB); PG8_STAGE(PG8_SB(0, 1), b2 + hstep, voffB); PG8_STAGE(PG8_SA(0, 0), a2, voffA);
            PG8_WAIT_V(8); PG8_WAIT_L(0); PG8_BAR; PG8_MMA(1, 0, At, B0); PG8_MMA(1, 1, At, B1); PG8_BAR; PG8_SCHED;
            PG8_LDB(B0, 1, 0); PG8_LDB(B1, 1, 1); PG8_SCHED; PG8_LDA(At, 1, 0); PG8_STAGE(PG8_SA(0, 1), a2 + hstep, voffA);
            PG8_WAIT_V(8); PG8_WAIT_L(0); PG8_BAR; PG8_MMA(0, 0, At, B0); PG8_MMA(0, 1, At, B1); PG8_BAR; PG8_SCHED;
            PG8_LDA(At, 1, 1); PG8_STAGE(PG8_SB(1, 0), b3, voffB); PG8_STAGE(PG8_SB(1, 1), b3 + hstep, voffB); PG8_STAGE(PG8_SA(1, 0), a3, voffA);
            PG8_WAIT_V(8); PG8_WAIT_L(0); PG8_BAR; PG8_MMA(1, 0, At, B0); PG8_MMA(1, 1, At, B1); PG8_BAR; PG8_SCHED;
            } else {
            PG8_LDB(B0, 0, 0); PG8_SCHED; PG8_LDA(At, 0, 0); PG8_STAGE(PG8_SA(1, 1), a1 + hstep, voffA);
            PG8_WAIT_L(8); PG8_BAR; PG8_WAIT_L(0); PG8_MMA(0, 0, At, B0); PG8_BAR; PG8_SCHED;
            PG8_LDB(B1, 0, 1); PG8_STAGE(PG8_SB(0, 0), b2, voffB);
            PG8_BAR; PG8_WAIT_L(0); PG8_MMA(0, 1, At, B1); PG8_BAR;
            PG8_LDA(At, 0, 1); PG8_STAGE(PG8_SA(0, 0), a2, voffA);
            PG8_BAR; PG8_WAIT_L(0); PG8_MMA(1, 0, At, B0); PG8_BAR; PG8_SCHED;
            PG8_STAGE(PG8_SB(0, 1), b2 + hstep, voffB);
            PG8_WAIT_V(6); PG8_BAR; PG8_MMA(1, 1, At, B1); PG8_BAR;
            PG8_LDB(B0, 1, 0); PG8_SCHED; PG8_LDA(At, 1, 0); PG8_STAGE(PG8_SA(0, 1), a2 + hstep, voffA);
            PG8_WAIT_L(8); PG8_BAR; PG8_WAIT_L(0); PG8_MMA(0, 0, At, B0); PG8_BAR; PG8_SCHED;
            PG8_LDB(B1, 1, 1); PG8_STAGE(PG8_SB(1, 0), b3, voffB);
            PG8_BAR; PG8_WAIT_L(0); PG8_MMA(0, 1, At, B1); PG8_BAR;
            PG8_LDA(At, 1, 1); PG8_STAGE(PG8_SA(1, 0), a3, voffA);
            PG8_BAR; PG8_WAIT_L(0); PG8_MMA(1, 0, At, B0); PG8_BAR; PG8_SCHED;
            PG8_STAGE(PG8_SB(1, 1), b3 + hstep, voffB);
            PG8_WAIT_V(6); PG8_BAR; PG8_MMA(1, 1, At, B1); PG8_BAR;
            }
        }
        if constexpr (ALIGN_EPI) { if (wr == 0) PG8_BAR; }
        if constexpr (!Epi::AFTER_DRAIN) { E(acc, cur, wr, wc, fr, fq); S.done(cur); }
        if (!has_next) break;
#pragma unroll
        for (int a = 0; a < 2; ++a)
#pragma unroll
            for (int b = 0; b < 2; ++b)
#pragma unroll
                for (int m = 0; m < 4; ++m)
#pragma unroll
                    for (int n = 0; n < 2; ++n) acc[a][b][m][n] = (f32x4){0.f, 0.f, 0.f, 0.f};
        cur = nxt; cA = nA; cB = nB; ++ui;
        if constexpr (ALIGN_EPI) { if (wr == 1) PG8_BAR; }
    }
    PG8_WAIT_V(0);
    if constexpr (!ALIGN_EPI) { if (wr == 0) PG8_BAR; }
    PG8_BAR;
    if constexpr (Epi::AFTER_DRAIN) { E.fused(acc, cur, wr, wc, fr, fq, lds, wid, lane); S.done(cur); }
#undef PG8_SA
#undef PG8_SB
#undef PG8_STAGE
#undef PG8_LDA
#undef PG8_LDB
#undef PG8_MMA
#undef PG8_WAIT_V
#undef PG8_WAIT_L
#undef PG8_BAR
#undef PG8_SCHED
}
}

constexpr int T = 16384, SEQ = 2048, DM = 1024;
constexpr float ALPHA = 1.189207115002721f;
typedef unsigned short bf16;
typedef unsigned u32;
typedef unsigned u32x4 __attribute__((ext_vector_type(4)));
typedef unsigned u32x2 __attribute__((ext_vector_type(2)));
typedef float f32x4 __attribute__((ext_vector_type(4)));
typedef short bf16x8 __attribute__((ext_vector_type(8)));
#define LAS __attribute__((address_space(3)))
constexpr size_t MiB = (size_t)1 << 20;
constexpr size_t WS_WIN = 1 * MiB, WS_W1K = 13 * MiB, WS_W1V = 14 * MiB, WS_WA = 15 * MiB, WS_WB = 16 * MiB, WS_WOUT = 17 * MiB, WS_WPG = 19 * MiB, WS_WPLE = 21 * MiB;
constexpr size_t WS_PB = 22 * MiB, WS_SM = 30 * MiB, WS_XB = 32 * MiB, WS_Q = 64 * MiB, WS_KV = 80 * MiB, WS_ZA = 104 * MiB, WS_QKVB = 120 * MiB, WS_ZB = 168 * MiB, WS_GM = 184 * MiB;
constexpr size_t WS_HID = 248 * MiB, WS_KC = 250 * MiB, WS_VC = 250 * MiB + 512 * 1024, WS_SEL = 251 * MiB, WS_GG = 251 * MiB + 256 * 1024, WS_BB = 251 * MiB + 512 * 1024, WS_TBL = 252 * MiB, WS_DBG = 254 * MiB, WS_END = 254 * MiB + 4096;
constexpr size_t WS_OACC = WS_XB, WS_OD = WS_QKVB, WS_OA = WS_QKVB + 32 * MiB, WS_PARTA = 32 * MiB, WS_M = 96 * MiB, WS_H = 32 * MiB, WS_HB = 128 * MiB, WS_PE = 184 * MiB;
constexpr int LDS_BYTES = 147456;
constexpr int NDI = 28;

__device__ __forceinline__ float bf2f(unsigned v) { return __uint_as_float(v << 16); }
__device__ __forceinline__ unsigned f2bf(float f) { unsigned u = __float_as_uint(f); return (u + 0x7fffu + ((u >> 16) & 1u)) >> 16; }
__device__ __forceinline__ unsigned pk2(float lo, float hi) { return f2bf(lo) | (f2bf(hi) << 16); }
__device__ __forceinline__ float fexp(float x) { return __builtin_amdgcn_exp2f(x * 1.4426950408889634f); }
__device__ __forceinline__ float sigm(float x) { return __builtin_amdgcn_rcpf(1.f + fexp(-x)); }
__device__ __forceinline__ float siluf_(float x) { return x * sigm(x); }
__device__ __forceinline__ int rel_bucket(int n) {
    if (n < 16) return n < 0 ? 0 : n;
    return 16 + (n >= 21) + (n >= 27) + (n >= 35) + (n >= 46) + (n >= 59) + (n >= 77) + (n >= 99) + (n >= 128) + (n >= 166) + (n >= 216) + (n >= 280) + (n >= 363) + (n >= 470) + (n >= 609) + (n >= 790);
}
#define LDS_WAIT() asm volatile("s_waitcnt lgkmcnt(0)" ::: "memory")
__device__ __forceinline__ float wshfl_xor(float v, int o, int tid) { return __int_as_float(__builtin_amdgcn_ds_bpermute(((tid ^ o) & 63) << 2, __float_as_int(v))); }

struct Args { const float* in[21]; float* out; unsigned char* ws; };

__device__ __forceinline__ int win_srccol(int r) {
    if (r < 1280) return r;
    if (r < 3328) return r + 24;
    if (r < 5888) return r + 32;
    if (r < 5912) return 1280 + (r - 5888);
    if (r < 5916) return 3352 + (r - 5912);
    if (r < 5920) return 3356 + (r - 5916);
    return -1;
}
template <bool REMAP>
__device__ __forceinline__ void transpose_item(const float* __restrict__ W, int K, int N, bf16* __restrict__ WT, LAS float* scr, int k0, int n0, int lane) {
    const int sc = REMAP ? win_srccol(n0 + (lane & 31)) : n0 + (lane & 31);
#pragma unroll 8
    for (int i = 0; i < 32; ++i) { const int kk = 2 * i + (lane >> 5); scr[kk * 33 + (lane & 31)] = (sc >= 0) ? W[(size_t)(k0 + kk) * N + sc] : 0.f; }
    LDS_WAIT();
    const int c = lane & 7;
#pragma unroll
    for (int j = 0; j < 4; ++j) { const int n = (lane >> 3) + 8 * j; const LAS float* s = scr + (8 * c) * 33 + n;
        u32x4 o; o.x = pk2(s[0 * 33], s[1 * 33]); o.y = pk2(s[2 * 33], s[3 * 33]); o.z = pk2(s[4 * 33], s[5 * 33]); o.w = pk2(s[6 * 33], s[7 * 33]);
        *(u32x4*)(WT + (size_t)(n0 + n) * K + k0 + 8 * c) = o; }
    LDS_WAIT();
}
__device__ __forceinline__ void p0_prologue(const Args& a, LAS unsigned char* lds, int tid) {
    const int lane = tid & 63, wave = tid >> 6;
    LAS float* scr = (LAS float*)(lds + wave * 8704);
    const int gw = blockIdx.x * 8 + wave, NGW = gridDim.x * 8;
    unsigned char* ws = a.ws;
    constexpr int I_WIN = 16 * 192, I_W1 = 32 * 8, I_WAB = 8 * 32, I_WSQ = 16 * 32, I_WPLE = 4 * 32;
    constexpr int NITEMS = I_WIN + 2 * I_W1 + 2 * I_WAB + 2 * I_WSQ + I_WPLE;
    for (int it = gw; it < NITEMS; it += NGW) {
        int r = it;
        if (r < I_WIN) { transpose_item<true>(a.in[2], 1024, 5920, (bf16*)(ws + WS_WIN), scr, (r / 192) * 64, (r % 192) * 32, lane); continue; } r -= I_WIN;
        if (r < I_W1) { transpose_item<false>(a.in[5], 2048, 256, (bf16*)(ws + WS_W1K), scr, (r / 8) * 64, (r % 8) * 32, lane); continue; } r -= I_W1;
        if (r < I_W1) { transpose_item<false>(a.in[7], 2048, 256, (bf16*)(ws + WS_W1V), scr, (r / 8) * 64, (r % 8) * 32, lane); continue; } r -= I_W1;
        if (r < I_WAB) { transpose_item<false>(a.in[14], 512, 1024, (bf16*)(ws + WS_WA), scr, (r / 32) * 64, (r % 32) * 32, lane); continue; } r -= I_WAB;
        if (r < I_WAB) { transpose_item<false>(a.in[15], 512, 1024, (bf16*)(ws + WS_WB), scr, (r / 32) * 64, (r % 32) * 32, lane); continue; } r -= I_WAB;
        if (r < I_WSQ) { transpose_item<false>(a.in[16], 1024, 1024, (bf16*)(ws + WS_WOUT), scr, (r / 32) * 64, (r % 32) * 32, lane); continue; } r -= I_WSQ;
        if (r < I_WSQ) { transpose_item<false>(a.in[18], 1024, 1024, (bf16*)(ws + WS_WPG), scr, (r / 32) * 64, (r % 32) * 32, lane); continue; } r -= I_WSQ;
        transpose_item<false>(a.in[17], 256, 1024, (bf16*)(ws + WS_WPLE), scr, (r / 32) * 64, (r % 32) * 32, lane);
    }
    const float* x = a.in[0]; bf16* xb = (bf16*)(ws + WS_XB);
    for (int m = gw; m < T; m += NGW) {
        const f32x4* xr = (const f32x4*)(x + (size_t)m * 1024) + lane; u32x2* o = (u32x2*)(xb + (size_t)m * 1024) + lane;
#pragma unroll
        for (int j = 0; j < 4; ++j) { const f32x4 v = xr[64 * j]; u32x2 w; w.x = pk2(v.x, v.y); w.y = pk2(v.z, v.w); o[64 * j] = w; }
    }
    const float* p = a.in[1]; bf16* pb = (bf16*)(ws + WS_PB);
    for (int m = gw; m < T; m += NGW) {
        const f32x4 v = ((const f32x4*)(p + (size_t)m * 256))[lane]; u32x2 w; w.x = pk2(v.x, v.y); w.y = pk2(v.z, v.w); ((u32x2*)(pb + (size_t)m * 256))[lane] = w;
    }
    { const float* rel_bias = a.in[9]; bf16* tbl = (bf16*)(ws + WS_TBL);
      for (int idx = blockIdx.x * 512 + tid; idx < 2 * NDI * 8 * 2 * 2 * 64 * 8; idx += gridDim.x * 512) {
          const int j = idx & 7, ln = (idx >> 3) & 63, half = (idx >> 9) & 1, sx = (idx >> 10) & 1, h = (idx >> 11) & 7, rest = idx >> 14, di = rest % NDI, type = rest / NDI;
          const int kj = 32 * half + (ln & 31), qi = 16 * sx + 8 * (ln >> 5) + j, dist = 32 * di + qi - kj;
          const float v = (dist < 0 || (type == 1 && dist >= 512)) ? -30000.f : rel_bias[rel_bucket(dist) * 8 + h] * 1.4426950408889634f;
          tbl[idx] = (bf16)f2bf(v); } }
    if (blockIdx.x == 0 && tid == 0) *(float*)(ws + WS_DBG) = 0.f;
}

struct EpiProj {
    static constexpr bool PERM = true, AFTER_DRAIN = false;
    unsigned char* ws;
    __device__ __forceinline__ void operator()(const pg8::f32x4 (&acc)[2][2][4][2], const pg8::Unit& u, int wr, int wc, int fr, int fq) const {
        const int pn = u.pn; const int row0 = u.pm * 256 + wr * 64 + fr;
        if (pn == 23) {
            if (wc == 0) { float* sm = (float*)(ws + WS_SM);
#pragma unroll
                for (int ai = 0; ai < 2; ++ai)
#pragma unroll
                    for (int m = 0; m < 4; ++m) { float* o = sm + (size_t)(row0 + ai * 128 + m * 16) * 32 + 8 * fq; *(f32x4*)o = acc[ai][0][m][0]; *(f32x4*)(o + 4) = acc[ai][0][m][1]; } }
            return;
        }
        int kind, ldc, colt; size_t boff;
        if (pn < 2) { kind = 1; boff = WS_Q; ldc = 512; colt = pn * 256; }
        else if (pn < 5) { kind = 0; boff = WS_KV; ldc = 768; colt = (pn - 2) * 256; }
        else if (pn < 7) { kind = 2; boff = WS_ZA; ldc = 512; colt = (pn - 5) * 256; }
        else if (pn < 13) { kind = 0; boff = WS_QKVB; ldc = 1536; colt = (pn - 7) * 256; }
        else if (pn < 15) { kind = 2; boff = WS_ZB; ldc = 512; colt = (pn - 13) * 256; }
        else { kind = 3; boff = WS_GM; ldc = 2048; colt = (pn - 15) * 256; }
        bf16* base = (bf16*)(ws + boff); const int col0 = colt + wc * 32 + 8 * fq;
#pragma unroll
        for (int ai = 0; ai < 2; ++ai)
#pragma unroll
            for (int m = 0; m < 4; ++m) { bf16* rowp = base + (size_t)(row0 + ai * 128 + m * 16) * ldc + col0;
#pragma unroll
                for (int bj = 0; bj < 2; ++bj) { float v[8];
#pragma unroll
                    for (int e = 0; e < 4; ++e) { v[e] = acc[ai][bj][m][0][e]; v[4 + e] = acc[ai][bj][m][1][e]; }
                    if (kind == 1) {
#pragma unroll
                        for (int e = 0; e < 8; ++e) v[e] *= 0.18033688011112042f;
                    } else if (kind == 2) {
#pragma unroll
                        for (int e = 0; e < 8; ++e) v[e] = siluf_(v[e]);
                    } else if (kind == 3) {
#pragma unroll
                        for (int e = 0; e < 8; ++e) v[e] = sigm(v[e]);
                    }
                    u32x4 w; w.x = pk2(v[0], v[1]); w.y = pk2(v[2], v[3]); w.z = pk2(v[4], v[5]); w.w = pk2(v[6], v[7]);
                    *(u32x4*)(rowp + bj * 128) = w; } }
    }
};
struct EpiYA {
    static constexpr bool PERM = true, AFTER_DRAIN = false;
    const bf16* gm; float* part;
    __device__ __forceinline__ void operator()(const pg8::f32x4 (&acc)[2][2][4][2], const pg8::Unit& u, int wr, int wc, int fr, int fq) const {
        const int row0 = u.pm * 256 + wr * 64 + fr, col0 = u.pn * 256 + wc * 32 + 8 * fq;
#pragma unroll
        for (int ai = 0; ai < 2; ++ai)
#pragma unroll
            for (int m = 0; m < 4; ++m)
#pragma unroll
                for (int bj = 0; bj < 2; ++bj) { const size_t r = row0 + ai * 128 + m * 16; const int c = col0 + bj * 128;
                    const u32x4 g = *(const u32x4*)(gm + r * 2048 + c);
                    f32x4 o0, o1;
                    o0.x = acc[ai][bj][m][0].x * bf2f(g.x & 0xffffu); o0.y = acc[ai][bj][m][0].y * bf2f(g.x >> 16); o0.z = acc[ai][bj][m][0].z * bf2f(g.y & 0xffffu); o0.w = acc[ai][bj][m][0].w * bf2f(g.y >> 16);
                    o1.x = acc[ai][bj][m][1].x * bf2f(g.z & 0xffffu); o1.y = acc[ai][bj][m][1].y * bf2f(g.z >> 16); o1.z = acc[ai][bj][m][1].z * bf2f(g.w & 0xffffu); o1.w = acc[ai][bj][m][1].w * bf2f(g.w >> 16);
                    float* o = part + r * 1024 + c; *(f32x4*)o = o0; *(f32x4*)(o + 4) = o1; }
    }
};
struct EpiYB {
    static constexpr bool PERM = true, AFTER_DRAIN = false;
    const bf16* gm; const float* part; bf16* mo;
    __device__ __forceinline__ void operator()(const pg8::f32x4 (&acc)[2][2][4][2], const pg8::Unit& u, int wr, int wc, int fr, int fq) const {
        const int row0 = u.pm * 256 + wr * 64 + fr, col0 = u.pn * 256 + wc * 32 + 8 * fq;
#pragma unroll
        for (int ai = 0; ai < 2; ++ai)
#pragma unroll
            for (int m = 0; m < 4; ++m)
#pragma unroll
                for (int bj = 0; bj < 2; ++bj) { const size_t r = row0 + ai * 128 + m * 16; const int c = col0 + bj * 128;
                    const u32x4 g = *(const u32x4*)(gm + r * 2048 + 1024 + c);
                    const float* pp = part + r * 1024 + c; const f32x4 p0 = *(const f32x4*)pp, p1 = *(const f32x4*)(pp + 4);
                    f32x4 o0, o1;
                    o0.x = p0.x + acc[ai][bj][m][0].x * bf2f(g.x & 0xffffu); o0.y = p0.y + acc[ai][bj][m][0].y * bf2f(g.x >> 16); o0.z = p0.z + acc[ai][bj][m][0].z * bf2f(g.y & 0xffffu); o0.w = p0.w + acc[ai][bj][m][0].w * bf2f(g.y >> 16);
                    o1.x = p1.x + acc[ai][bj][m][1].x * bf2f(g.z & 0xffffu); o1.y = p1.y + acc[ai][bj][m][1].y * bf2f(g.z >> 16); o1.z = p1.z + acc[ai][bj][m][1].z * bf2f(g.w & 0xffffu); o1.w = p1.w + acc[ai][bj][m][1].w * bf2f(g.w >> 16);
                    u32x4 w; w.x = pk2(o0.x, o0.y); w.y = pk2(o0.z, o0.w); w.z = pk2(o1.x, o1.y); w.w = pk2(o1.z, o1.w);
                    *(u32x4*)(mo + r * 1024 + c) = w; }
    }
};
struct EpiH {
    static constexpr bool PERM = true, AFTER_DRAIN = false;
    const float* x; float* h; bf16* hb;
    __device__ __forceinline__ void operator()(const pg8::f32x4 (&acc)[2][2][4][2], const pg8::Unit& u, int wr, int wc, int fr, int fq) const {
        const int row0 = u.pm * 256 + wr * 64 + fr, col0 = u.pn * 256 + wc * 32 + 8 * fq;
#pragma unroll
        for (int ai = 0; ai < 2; ++ai)
#pragma unroll
            for (int m = 0; m < 4; ++m)
#pragma unroll
                for (int bj = 0; bj < 2; ++bj) { const size_t off = (size_t)(row0 + ai * 128 + m * 16) * 1024 + col0 + bj * 128;
                    const f32x4 x0 = *(const f32x4*)(x + off), x1 = *(const f32x4*)(x + off + 4);
                    const f32x4 o0 = x0 * ALPHA + acc[ai][bj][m][0], o1 = x1 * ALPHA + acc[ai][bj][m][1];
                    *(f32x4*)(h + off) = o0; *(f32x4*)(h + off + 4) = o1;
                    u32x4 w; w.x = pk2(o0.x, o0.y); w.y = pk2(o0.z, o0.w); w.z = pk2(o1.x, o1.y); w.w = pk2(o1.z, o1.w);
                    *(u32x4*)(hb + off) = w; }
    }
};
struct EpiPE {
    static constexpr bool PERM = true, AFTER_DRAIN = false;
    float* pe;
    __device__ __forceinline__ void operator()(const pg8::f32x4 (&acc)[2][2][4][2], const pg8::Unit& u, int wr, int wc, int fr, int fq) const {
        const int row0 = u.pm * 256 + wr * 64 + fr, col0 = u.pn * 256 + wc * 32 + 8 * fq;
#pragma unroll
        for (int ai = 0; ai < 2; ++ai)
#pragma unroll
            for (int m = 0; m < 4; ++m)
#pragma unroll
                for (int bj = 0; bj < 2; ++bj) { const size_t off = (size_t)(row0 + ai * 128 + m * 16) * 1024 + col0 + bj * 128;
                    *(f32x4*)(pe + off) = acc[ai][bj][m][0]; *(f32x4*)(pe + off + 4) = acc[ai][bj][m][1]; }
    }
};
struct EpiGate {
    static constexpr bool PERM = true, AFTER_DRAIN = false;
    const float* h; const float* pe; float* out;
    __device__ __forceinline__ void operator()(const pg8::f32x4 (&acc)[2][2][4][2], const pg8::Unit& u, int wr, int wc, int fr, int fq) const {
        const int row0 = u.pm * 256 + wr * 64 + fr, col0 = u.pn * 256 + wc * 32 + 8 * fq;
#pragma unroll
        for (int ai = 0; ai < 2; ++ai)
#pragma unroll
            for (int m = 0; m < 4; ++m)
#pragma unroll
                for (int bj = 0; bj < 2; ++bj) { const size_t off = (size_t)(row0 + ai * 128 + m * 16) * 1024 + col0 + bj * 128;
                    const f32x4 h0 = *(const f32x4*)(h + off), h1 = *(const f32x4*)(h + off + 4), p0 = *(const f32x4*)(pe + off), p1 = *(const f32x4*)(pe + off + 4);
                    f32x4 o0, o1;
                    o0.x = h0.x + sigm(acc[ai][bj][m][0].x) * p0.x; o0.y = h0.y + sigm(acc[ai][bj][m][0].y) * p0.y; o0.z = h0.z + sigm(acc[ai][bj][m][0].z) * p0.z; o0.w = h0.w + sigm(acc[ai][bj][m][0].w) * p0.w;
                    o1.x = h1.x + sigm(acc[ai][bj][m][1].x) * p1.x; o1.y = h1.y + sigm(acc[ai][bj][m][1].y) * p1.y; o1.z = h1.z + sigm(acc[ai][bj][m][1].z) * p1.z; o1.w = h1.w + sigm(acc[ai][bj][m][1].w) * p1.w;
                    *(f32x4*)(out + off) = o0; *(f32x4*)(out + off + 4) = o1; }
    }
};

template <class LA, class LB, class ST>
__device__ __forceinline__ void sgemm_tile64(LAS float* As, LAS float* Bs, int K, int tid, LA loadA4, LB loadB4, ST store4) {
    const int tx = tid & 15, ty = (tid >> 4) & 15;
    float acc[4][4];
#pragma unroll
    for (int i = 0; i < 4; ++i)
#pragma unroll
        for (int j = 0; j < 4; ++j) acc[i][j] = 0.f;
    const int arow = (tid >> 2) & 63, akq = (tid & 3) * 4, bk = (tid >> 4) & 15, bnq = (tid & 15) * 4;
    for (int k0 = 0; k0 < K; k0 += 16) {
        if (tid < 256) {
            const f32x4 av = loadA4(arow, k0 + akq), bv = loadB4(k0 + bk, bnq);
            As[(akq + 0) * 68 + arow] = av.x; As[(akq + 1) * 68 + arow] = av.y; As[(akq + 2) * 68 + arow] = av.z; As[(akq + 3) * 68 + arow] = av.w;
            *(LAS f32x4*)&Bs[bk * 68 + bnq] = bv;
        }
        __syncthreads();
        if (tid < 256) {
#pragma unroll
            for (int k = 0; k < 16; ++k) {
                const f32x4 av = *(const LAS f32x4*)&As[k * 68 + ty * 4], bv = *(const LAS f32x4*)&Bs[k * 68 + tx * 4];
#pragma unroll
                for (int i = 0; i < 4; ++i)
#pragma unroll
                    for (int j = 0; j < 4; ++j) acc[i][j] = fmaf(av[i], bv[j], acc[i][j]);
            }
        }
        __syncthreads();
    }
    if (tid < 256) {
#pragma unroll
        for (int i = 0; i < 4; ++i) store4(ty * 4 + i, tx * 4, (f32x4){acc[i][0], acc[i][1], acc[i][2], acc[i][3]});
    }
}

__device__ __forceinline__ void dn_prep_phase(const Args& a, LAS unsigned char* lds, int tid) {
    unsigned char* ws = a.ws;
    const bf16* qkvb = (const bf16*)(ws + WS_QKVB); const float* sm = (const float*)(ws + WS_SM);
    const float* conv_w = a.in[10]; const float* a_log = a.in[11]; const float* dt_bias = a.in[12];
    bf16* qn = (bf16*)a.out; bf16* kn = qn + (size_t)T * 512; bf16* vv = kn + (size_t)T * 512;
    float* gg = (float*)(ws + WS_GG); float* bb = (float*)(ws + WS_BB);
    LAS float* red = (LAS float*)lds;
    const int h = tid >> 7, d = tid & 127, wave = tid >> 6;
    float cw[3][4];
#pragma unroll
    for (int part = 0; part < 3; ++part)
#pragma unroll
        for (int w = 0; w < 4; ++w) cw[part][w] = conv_w[w * 1536 + part * 512 + h * 128 + d];
    for (int t = blockIdx.x; t < T; t += gridDim.x) {
        const int ts = t & (SEQ - 1);
        float val[3];
#pragma unroll
        for (int part = 0; part < 3; ++part) { const int c = part * 512 + h * 128 + d; float acc = 0.f;
#pragma unroll
            for (int w = 0; w < 4; ++w) if (ts + w - 3 >= 0) acc = fmaf(cw[part][w], bf2f(qkvb[(size_t)(t + w - 3) * 1536 + c]), acc);
            val[part] = siluf_(acc); }
        float sq = val[0] * val[0], sk = val[1] * val[1];
#pragma unroll
        for (int o = 32; o > 0; o >>= 1) { sq += wshfl_xor(sq, o, tid); sk += wshfl_xor(sk, o, tid); }
        if ((tid & 63) == 0) { red[wave * 2] = sq; red[wave * 2 + 1] = sk; }
        __syncthreads();
        sq = red[(h * 2) * 2] + red[(h * 2 + 1) * 2]; sk = red[(h * 2) * 2 + 1] + red[(h * 2 + 1) * 2 + 1];
        const size_t o = (size_t)t * 512 + h * 128 + d;
        qn[o] = (bf16)f2bf(val[0] * (1.0f / sqrtf(sq + 1e-6f)));
        kn[o] = (bf16)f2bf(val[1] * (1.0f / sqrtf(sk + 1e-6f)));
        vv[o] = (bf16)f2bf(val[2]);
        if (d == 0) {
            bb[t * 4 + h] = 1.f / (1.f + expf(-sm[(size_t)t * 32 + 24 + h]));
            const float xx = sm[(size_t)t * 32 + 28 + h] + dt_bias[h];
            const float sp = (xx > 20.f) ? xx : log1pf(expf(xx));
            gg[t * 4 + h] = -expf(a_log[h]) * sp;
        }
        __syncthreads();
    }
}

__device__ __forceinline__ void cmp_gemm1_phase(const Args& a, LAS unsigned char* lds, int tid) {
    unsigned char* ws = a.ws; const bf16* kv = (const bf16*)(ws + WS_KV); bf16* hid = (bf16*)(ws + WS_HID);
    LAS float* As = (LAS float*)lds; LAS float* Bs = As + 16 * 68;
    for (int u = blockIdx.x; u < 256; u += gridDim.x) {
        const int which = u >> 7, mt = (u >> 2) & 31, nt = u & 3;
        const float* pos = a.in[3 + which]; const float* w1 = a.in[which ? 7 : 5];
        const int col0 = which * 128;
        auto la = [&](int r, int k) -> f32x4 {
            const int row = mt * 64 + r, g = row & 1, bn = row >> 1, b = bn >> 7, n = bn & 127, j = k >> 6, d = k & 63;
            const u32x2 w = *(const u32x2*)(kv + (size_t)(b * SEQ + 16 * n + j) * 768 + col0 + g * 64 + d);
            const f32x4 pv = *(const f32x4*)(pos + j * 64 + d);
            return (f32x4){bf2f(w.x & 0xffffu) + pv.x, bf2f(w.x >> 16) + pv.y, bf2f(w.y & 0xffffu) + pv.z, bf2f(w.y >> 16) + pv.w};
        };
        auto lb = [&](int k, int c) -> f32x4 { return *(const f32x4*)(w1 + (size_t)k * 256 + nt * 64 + c); };
        auto st = [&](int r, int c, f32x4 v) {
            float o[4];
#pragma unroll
            for (int e = 0; e < 4; ++e) { const float x = v[e]; o[e] = 0.5f * x * (1.f + tanhf(0.7978845608028654f * (x + 0.044715f * x * x * x))); }
            u32x2 w; w.x = pk2(o[0], o[1]); w.y = pk2(o[2], o[3]);
            *(u32x2*)(hid + ((size_t)which * 2048 + mt * 64 + r) * 256 + nt * 64 + c) = w;
        };
        sgemm_tile64(As, Bs, 2048, tid, la, lb, st);
    }
}
__device__ __forceinline__ void cmp_gemm2_phase(const Args& a, LAS unsigned char* lds, int tid) {
    unsigned char* ws = a.ws; const bf16* hid = (const bf16*)(ws + WS_HID);
    LAS float* As = (LAS float*)lds; LAS float* Bs = As + 16 * 68;
    for (int u = blockIdx.x; u < 64; u += gridDim.x) {
        const int which = u >> 5, mt = u & 31;
        const float* w2 = a.in[which ? 8 : 6]; float* outp = (float*)(ws + (which ? WS_VC : WS_KC));
        auto la = [&](int r, int k) -> f32x4 { const u32x2 w = *(const u32x2*)(hid + ((size_t)which * 2048 + mt * 64 + r) * 256 + k);
            return (f32x4){bf2f(w.x & 0xffffu), bf2f(w.x >> 16), bf2f(w.y & 0xffffu), bf2f(w.y >> 16)}; };
        auto lb = [&](int k, int c) -> f32x4 { return *(const f32x4*)(w2 + (size_t)k * 64 + c); };
        auto st = [&](int r, int c, f32x4 v) { *(f32x4*)(outp + (size_t)(mt * 64 + r) * 64 + c) = v; };
        sgemm_tile64(As, Bs, 256, tid, la, lb, st);
    }
}

template <int MODE>
__device__ __forceinline__ void attn_simple_phase(const Args& a, LAS unsigned char* lds, int tid) {
    constexpr int NK = (MODE == 0) ? 127 : 512;
    unsigned char* ws = a.ws;
    const bf16* Q = (const bf16*)(ws + WS_Q); const bf16* KV = (const bf16*)(ws + WS_KV); const float* sm = (const float*)(ws + WS_SM);
    const float* kc = (const float*)(ws + WS_KC); const float* vc = (const float*)(ws + WS_VC);
    const float* rel_bias = a.in[9];
    float* oacc = (float*)(ws + WS_OACC); u32* sel = (u32*)(ws + WS_SEL);
    const bf16* za = (const bf16*)(ws + WS_ZA); bf16* oa = (bf16*)(ws + WS_OA);
    const int sb = tid >> 8, stid = tid & 255;
    LAS float* qs = (LAS float*)(lds + sb * 12288);
    LAS float* sc = qs + 256;
    LAS int* blk = (LAS int*)(sc + 2048);
    LAS float* imp = (LAS float*)(blk + 8);
    const int NU = T * 2, G2 = gridDim.x * 2;
    for (int u0 = 0; u0 < NU; u0 += G2) {
        const int u = u0 + blockIdx.x * 2 + sb; const bool act = u < NU;
        const int t = act ? (u >> 1) : 0, g = u & 1, ts = t & (SEQ - 1), tb = t - ts;
        qs[stid] = bf2f(Q[(size_t)t * 512 + (g * 4 + (stid >> 6)) * 64 + (stid & 63)]);
        if (MODE == 1 && stid == 0) { u32 mk = sel[t * 2 + g]; int k = 0; for (int j = 0; j < 32; ++j) if ((mk >> j) & 1u) { if (k < 8) blk[k] = j; ++k; } for (; k < 8; ++k) blk[k] = 0; }
        __syncthreads();
        for (int i = stid; i < NK; i += 256) {
            int dist, kpos; bool valid; const bf16* kb = nullptr; const float* kf = nullptr;
            if (MODE == 0) { dist = ts - (16 * i + 31); valid = dist >= 0; kf = kc + (size_t)((((tb >> 11) * 128) + i) * 2 + g) * 64; }
            else if (MODE == 1) { kpos = blk[i >> 6] * 64 + (i & 63); dist = ts - kpos; valid = dist >= 0; kb = KV + (size_t)(tb + kpos) * 768 + 256 + g * 64; }
            else { kpos = ts - 511 + i; dist = 511 - i; valid = kpos >= 0; kb = KV + (size_t)(tb + (kpos < 0 ? 0 : kpos)) * 768 + 512 + g * 64; }
            float s0 = 0.f, s1 = 0.f, s2 = 0.f, s3 = 0.f;
            if (valid) {
#pragma unroll 2
                for (int d = 0; d < 64; d += 8) {
                    float kk[8];
                    if (MODE == 0) { const f32x4 k0 = *(const f32x4*)(kf + d), k1 = *(const f32x4*)(kf + d + 4); kk[0] = k0.x; kk[1] = k0.y; kk[2] = k0.z; kk[3] = k0.w; kk[4] = k1.x; kk[5] = k1.y; kk[6] = k1.z; kk[7] = k1.w; }
                    else { const u32x4 w = *(const u32x4*)(kb + d); kk[0] = bf2f(w.x & 0xffffu); kk[1] = bf2f(w.x >> 16); kk[2] = bf2f(w.y & 0xffffu); kk[3] = bf2f(w.y >> 16); kk[4] = bf2f(w.z & 0xffffu); kk[5] = bf2f(w.z >> 16); kk[6] = bf2f(w.w & 0xffffu); kk[7] = bf2f(w.w >> 16); }
#pragma unroll
                    for (int e = 0; e < 8; ++e) { s0 = fmaf(kk[e], qs[d + e], s0); s1 = fmaf(kk[e], qs[64 + d + e], s1); s2 = fmaf(kk[e], qs[128 + d + e], s2); s3 = fmaf(kk[e], qs[192 + d + e], s3); }
                }
                const float* rb = rel_bias + rel_bucket(dist) * 8 + g * 4;
                s0 += rb[0] * 1.4426950408889634f; s1 += rb[1] * 1.4426950408889634f; s2 += rb[2] * 1.4426950408889634f; s3 += rb[3] * 1.4426950408889634f;
            } else { s0 = s1 = s2 = s3 = -1e30f; }
            sc[i] = s0; sc[512 + i] = s1; sc[1024 + i] = s2; sc[1536 + i] = s3;
        }
        __syncthreads();
        {
            const int w = stid >> 6, lane = stid & 63; LAS float* row = sc + w * 512;
            float mx = -1e30f;
            for (int i = lane; i < NK; i += 64) mx = fmaxf(mx, row[i]);
#pragma unroll
            for (int o = 32; o > 0; o >>= 1) mx = fmaxf(mx, wshfl_xor(mx, o, tid));
            float sum = 0.f;
            for (int i = lane; i < NK; i += 64) { const float s = row[i]; const float e = (s > -1e29f) ? exp2f(s - mx) : 0.f; row[i] = e; sum += e; }
#pragma unroll
            for (int o = 32; o > 0; o >>= 1) sum += wshfl_xor(sum, o, tid);
            const float inv = (sum > 0.f) ? 1.f / sum : 0.f;
            for (int i = lane; i < NK; i += 64) row[i] *= inv;
        }
        __syncthreads();
        {
            const int hg = stid >> 6, d = stid & 63; const LAS float* row = sc + hg * 512;
            float acc = 0.f;
            for (int i = 0; i < NK; ++i) {
                const float p = row[i];
                if (p != 0.f) {
                    float v;
                    if (MODE == 0) v = vc[(size_t)((((tb >> 11) * 128) + i) * 2 + g) * 64 + d];
                    else if (MODE == 1) v = bf2f(KV[(size_t)(tb + blk[i >> 6] * 64 + (i & 63)) * 768 + 384 + g * 64 + d]);
                    else v = bf2f(KV[(size_t)(tb + ts - 511 + i) * 768 + 640 + g * 64 + d]);
                    acc = fmaf(p, v, acc);
                }
            }
            if (act) {
                const int h = g * 4 + hg; const size_t o = (size_t)t * 512 + h * 64 + d;
                const float gate = 1.f / (1.f + expf(-sm[(size_t)t * 32 + (MODE == 0 ? 0 : MODE == 1 ? 8 : 16) + h]));
                if (MODE == 2) oacc[o] = gate * acc;
                else if (MODE == 0) oacc[o] += gate * acc;
                else oa[o] = (bf16)f2bf((oacc[o] + gate * acc) * bf2f(za[o]));
            }
        }
        if (MODE == 0) {
            if (stid < 32) {
                const int j = stid; float s = 0.f;
                for (int n = 4 * j - 1; n <= 4 * j + 3; ++n) if (n >= 0 && n < 127) s += (sc[n] + sc[512 + n]) + (sc[1024 + n] + sc[1536 + n]);
                const int cur = ts >> 6;
                if (j == 0 || j == cur || j == cur - 1) s = 1e6f; else if (j > cur) s = -1e6f;
                imp[j] = s;
            }
            __syncthreads();
            if (stid == 0 && act) {
                u32 taken = 0u;
                for (int k = 0; k < 8; ++k) { int best = -1; float bv = 0.f;
                    for (int j = 0; j < 32; ++j) if (!((taken >> j) & 1u)) { const float x = imp[j]; if (best < 0 || x > bv) { best = j; bv = x; } }
                    taken |= 1u << best; }
                sel[t * 2 + g] = taken;
            }
        }
        __syncthreads();
    }
}

typedef float f32x16 __attribute__((ext_vector_type(16)));
typedef short s16x4 __attribute__((ext_vector_type(4)));
__device__ __forceinline__ int crow(int r, int hi) { return (r & 3) + 8 * (r >> 2) + 4 * hi; }
__device__ __forceinline__ unsigned cvtpk(float lo, float hi) { typedef float f2 __attribute__((ext_vector_type(2))); typedef __bf16 b2 __attribute__((ext_vector_type(2))); f2 v = {lo, hi}; b2 b = __builtin_convertvector(v, b2); return __builtin_bit_cast(unsigned, b); }
__device__ __forceinline__ float hswap_max(float v) { auto rr = __builtin_amdgcn_permlane32_swap(__float_as_uint(v), __float_as_uint(v), false, false); return fmaxf(__uint_as_float(rr[0]), __uint_as_float(rr[1])); }
__device__ __forceinline__ float hswap_sum(float v) { auto rr = __builtin_amdgcn_permlane32_swap(__float_as_uint(v), __float_as_uint(v), false, false); return __uint_as_float(rr[0]) + __uint_as_float(rr[1]); }
template <int MODE, bool PROBE>
__device__ __forceinline__ void attn_mfma_unit(const Args& a, LAS unsigned char* lds, int tid, int b, int g, int qt) {
    typedef short v4i16_t __attribute__((ext_vector_type(4)));
    unsigned char* ws = a.ws;
    const int lane = tid & 63, w = __builtin_amdgcn_readfirstlane(tid >> 6), r32 = lane & 31, hi = lane >> 5;
    const int hg = w >> 1, tsub = w & 1, h = g * 4 + hg;
    const int tb = b * SEQ, t0 = qt * 64, tq = t0 + tsub * 32 + r32;
    const bf16* Q = (const bf16*)(ws + WS_Q); const bf16* KV = (const bf16*)(ws + WS_KV);
    const int kcol = (MODE == 1 ? 256 : 512) + g * 64, vcol = kcol + 128;
    bf16x8 qr[4];
#pragma unroll
    for (int d0 = 0; d0 < 4; ++d0) qr[d0] = *(const bf16x8*)(Q + (size_t)(tb + tq) * 512 + h * 64 + d0 * 16 + hi * 8);
    bf16x8 oh[2];
#pragma unroll
    for (int sx = 0; sx < 2; ++sx)
#pragma unroll
        for (int j = 0; j < 8; ++j) oh[sx][j] = (16 * sx + 8 * hi + j == r32) ? (short)0x3F80 : (short)0;
    const int j0 = (MODE == 2) ? (qt > 8 ? qt - 8 : 0) : 0, j1 = qt;
    const bf16* ksrc = KV + (size_t)(tb + lane) * 768 + kcol + w * 8;
    const bf16* vsrc = KV + (size_t)(tb + 16 * (w & 3) + (lane >> 2)) * 768 + vcol + (w >> 2) * 32 + (lane & 3) * 8;
    LAS unsigned char* Kb = lds; LAS unsigned char* Vb = lds + 16384; LAS float* wsf = (LAS float*)(lds + 32768) + w * 64;
    const unsigned char* tblb = ws + WS_TBL + (size_t)((MODE == 2 ? NDI : 0) * 8 + h) * 4096 + lane * 16;
    u32 mk = 0xffffffffu; if (MODE == 1) mk = ((const u32*)(ws + WS_SEL))[(tb + tq) * 2 + g];
    u32x4 kreg = *(const u32x4*)(ksrc + (size_t)j0 * 64 * 768), vreg = *(const u32x4*)(vsrc + (size_t)j0 * 64 * 768);
    *(LAS u32x4*)(Kb + w * 1024 + lane * 16) = kreg; *(LAS u32x4*)(Vb + w * 1024 + lane * 16) = vreg;
    __syncthreads();
    float m = -1e30f, l = 0.f; f32x16 o[2];
#pragma unroll
    for (int r = 0; r < 16; ++r) { o[0][r] = 0.f; o[1][r] = 0.f; }
    const LAS unsigned char* vrd0 = Vb + ((lane >> 4) & 1) * 32 + (lane & 3) * 8 + (4 * hi + ((lane & 15) >> 2)) * 64;
    for (int jt = j0; jt <= j1; ++jt) {
        const int cur = (jt - j0) & 1;
        if (jt < j1) { kreg = *(const u32x4*)(ksrc + (size_t)(jt + 1) * 64 * 768); vreg = *(const u32x4*)(vsrc + (size_t)(jt + 1) * 64 * 768); }
        int di = 2 * (qt - jt) + tsub; if (di > NDI - 1) di = NDI - 1;
        const unsigned char* tp = tblb + (size_t)di * 32768;
        const bf16x8 tf00 = *(const bf16x8*)(tp), tf01 = *(const bf16x8*)(tp + 1024), tf10 = *(const bf16x8*)(tp + 2048), tf11 = *(const bf16x8*)(tp + 3072);
        const float cinit = (MODE == 1 && !((mk >> jt) & 1u)) ? -30000.f : 0.f;
        f32x16 p0, p1;
#pragma unroll
        for (int r = 0; r < 16; ++r) p0[r] = cinit;
        p1 = __builtin_amdgcn_mfma_f32_32x32x16_bf16(tf01, oh[0], p0, 0, 0, 0);
        p0 = __builtin_amdgcn_mfma_f32_32x32x16_bf16(tf00, oh[0], p0, 0, 0, 0);
        p0 = __builtin_amdgcn_mfma_f32_32x32x16_bf16(tf10, oh[1], p0, 0, 0, 0);
        p1 = __builtin_amdgcn_mfma_f32_32x32x16_bf16(tf11, oh[1], p1, 0, 0, 0);
        const LAS unsigned char* kb = Kb + cur * 8192 + hi * 1024 + r32 * 16;
#pragma unroll
        for (int d0 = 0; d0 < 4; ++d0) {
            const bf16x8 k0 = *(const LAS bf16x8*)(kb + d0 * 2048), k1 = *(const LAS bf16x8*)(kb + d0 * 2048 + 512);
            p0 = __builtin_amdgcn_mfma_f32_32x32x16_bf16(k0, qr[d0], p0, 0, 0, 0);
            p1 = __builtin_amdgcn_mfma_f32_32x32x16_bf16(k1, qr[d0], p1, 0, 0, 0);
        }
        float rm = fmaxf(p0[0], p1[0]);
#pragma unroll
        for (int r = 1; r < 16; ++r) rm = fmaxf(rm, fmaxf(p0[r], p1[r]));
        rm = hswap_max(rm);
        const float mn = fmaxf(m, rm);
        if (__any(mn > m)) {
            const float sc = __builtin_amdgcn_exp2f(m - mn); l *= sc; m = mn;
            if (hi == 0) wsf[r32] = sc;
            LDS_WAIT();
#pragma unroll
            for (int r = 0; r < 16; ++r) { const float f = wsf[crow(r, hi)]; o[0][r] *= f; o[1][r] *= f; }
            LDS_WAIT();
        }
        float sacc = 0.f;
#pragma unroll
        for (int r = 0; r < 16; ++r) { p0[r] = __builtin_amdgcn_exp2f(p0[r] - m); p1[r] = __builtin_amdgcn_exp2f(p1[r] - m); sacc += p0[r] + p1[r]; }
        l += sacc;
        u32x4 pw[4];
#pragma unroll
        for (int e = 0; e < 4; ++e) { pw[0][e] = cvtpk(p0[2 * e], p0[2 * e + 1]); pw[1][e] = cvtpk(p0[8 + 2 * e], p0[8 + 2 * e + 1]); pw[2][e] = cvtpk(p1[2 * e], p1[2 * e + 1]); pw[3][e] = cvtpk(p1[8 + 2 * e], p1[8 + 2 * e + 1]); }
        const LAS unsigned char* vrd = vrd0 + cur * 8192;
#pragma unroll
        for (int d0 = 0; d0 < 2; ++d0)
#pragma unroll
            for (int ks = 0; ks < 4; ++ks) {
                const s16x4 lo = __builtin_bit_cast(s16x4, __builtin_amdgcn_ds_read_tr16_b64_v4i16((LAS v4i16_t*)(vrd + d0 * 4096 + ks * 1024)));
                const s16x4 hh = __builtin_bit_cast(s16x4, __builtin_amdgcn_ds_read_tr16_b64_v4i16((LAS v4i16_t*)(vrd + d0 * 4096 + ks * 1024 + 512)));
                const bf16x8 vf = (bf16x8){lo[0], lo[1], lo[2], lo[3], hh[0], hh[1], hh[2], hh[3]};
                o[d0] = __builtin_amdgcn_mfma_f32_32x32x16_bf16(__builtin_bit_cast(bf16x8, pw[ks]), vf, o[d0], 0, 0, 0);
            }
        if (jt < j1) { *(LAS u32x4*)(Kb + (cur ^ 1) * 8192 + w * 1024 + lane * 16) = kreg; *(LAS u32x4*)(Vb + (cur ^ 1) * 8192 + w * 1024 + lane * 16) = vreg; }
        __syncthreads();
    }
    l = hswap_sum(l);
    if (hi == 0) wsf[32 + r32] = l;
    LDS_WAIT();
    const float* sm = (const float*)(ws + WS_SM); float* oacc = (float*)(ws + WS_OACC);
    const bf16* za = (const bf16*)(ws + WS_ZA); bf16* oa = (bf16*)(ws + WS_OA);
    float dmax = 0.f;
#pragma unroll
    for (int r = 0; r < 16; ++r) {
        const int qi = crow(r, hi); const size_t row = (size_t)(tb + t0 + tsub * 32 + qi);
        const float rl = __builtin_amdgcn_rcpf(wsf[32 + qi]);
        const float gate = sigm(sm[row * 32 + (MODE == 1 ? 8 : 16) + h]);
#pragma unroll
        for (int d0 = 0; d0 < 2; ++d0) { const size_t oo = row * 512 + h * 64 + d0 * 32 + r32; const float val = gate * o[d0][r] * rl;
            if (PROBE) dmax = fmaxf(dmax, (MODE == 2) ? fabsf(val - oacc[oo]) : fabsf((oacc[oo] + val) * bf2f(za[oo]) - bf2f(oa[oo])));
            else if (MODE == 2) oacc[oo] = val;
            else oa[oo] = (bf16)f2bf((oacc[oo] + val) * bf2f(za[oo])); }
    }
    LDS_WAIT();
    if (PROBE) atomicMax((unsigned*)(ws + WS_DBG), __float_as_uint(dmax));
}
template <int MODE, bool PROBE>
__device__ __forceinline__ void attn_mfma_phase(const Args& a, LAS unsigned char* lds, int tid) {
    for (int i = blockIdx.x; i < 256; i += gridDim.x) {
        const int bg = i >> 4, s = i & 15;
        attn_mfma_unit<MODE, PROBE>(a, lds, tid, bg >> 1, bg & 1, s);
        attn_mfma_unit<MODE, PROBE>(a, lds, tid, bg >> 1, bg & 1, 31 - s);
    }
}

__device__ __forceinline__ void dn_scan_phase(const Args& a, LAS unsigned char* lds, int tid) {
    if (tid >= 64) return;
    unsigned char* ws = a.ws; const int lane = tid, kq = lane >> 4, vc = lane & 15;
    const bf16* qn = (const bf16*)a.out; const bf16* kn = qn + (size_t)T * 512; const bf16* vv = kn + (size_t)T * 512;
    const float* gg = (const float*)(ws + WS_GG); const float* bb = (const float*)(ws + WS_BB);
    float* od = (float*)(ws + WS_OD);
    LAS unsigned char* kbuf = lds; LAS unsigned char* qbuf = lds + 16384; LAS unsigned char* vbuf = lds + 32768;
    for (int u = blockIdx.x; u < 256; u += gridDim.x) {
        const int b = u >> 5, h = (u >> 3) & 3, vb = u & 7;
        float S[32];
#pragma unroll
        for (int k = 0; k < 32; ++k) S[k] = 0.f;
        for (int c = 0; c < 32; ++c) {
            const int t0 = b * SEQ + c * 64;
#pragma unroll 4
            for (int i = 0; i < 16; ++i) { const int p = i * 64 + lane, row = p >> 4, ch = p & 15;
                *(LAS u32x4*)(kbuf + row * 256 + ch * 16) = *(const u32x4*)(kn + (size_t)(t0 + row) * 512 + h * 128 + ch * 8);
                *(LAS u32x4*)(qbuf + row * 256 + ch * 16) = *(const u32x4*)(qn + (size_t)(t0 + row) * 512 + h * 128 + ch * 8); }
#pragma unroll
            for (int i = 0; i < 2; ++i) { const int p = i * 64 + lane, row = p >> 1, ch = p & 1;
                *(LAS u32x4*)(vbuf + row * 32 + ch * 16) = *(const u32x4*)(vv + (size_t)(t0 + row) * 512 + h * 128 + vb * 16 + ch * 8); }
            const float gl = gg[(t0 + lane) * 4 + h], bl = bb[(t0 + lane) * 4 + h];
            LDS_WAIT();
            for (int s = 0; s < 64; ++s) {
                const float alpha = expf(__int_as_float(__builtin_amdgcn_readlane(__float_as_int(gl), s)));
                const float beta = __int_as_float(__builtin_amdgcn_readlane(__float_as_int(bl), s));
                const float v = bf2f(*(const LAS bf16*)(vbuf + s * 32 + vc * 2));
                float kk[32];
#pragma unroll
                for (int k8 = 0; k8 < 4; ++k8) { const u32x4 w = *(const LAS u32x4*)(kbuf + s * 256 + kq * 64 + k8 * 16);
                    kk[k8 * 8 + 0] = bf2f(w.x & 0xffffu); kk[k8 * 8 + 1] = bf2f(w.x >> 16); kk[k8 * 8 + 2] = bf2f(w.y & 0xffffu); kk[k8 * 8 + 3] = bf2f(w.y >> 16);
                    kk[k8 * 8 + 4] = bf2f(w.z & 0xffffu); kk[k8 * 8 + 5] = bf2f(w.z >> 16); kk[k8 * 8 + 6] = bf2f(w.w & 0xffffu); kk[k8 * 8 + 7] = bf2f(w.w >> 16); }
                float kS = 0.f;
#pragma unroll
                for (int k = 0; k < 32; ++k) { S[k] *= alpha; kS = fmaf(kk[k], S[k], kS); }
                kS += wshfl_xor(kS, 16, tid); kS += wshfl_xor(kS, 32, tid);
                const float vn = beta * (v - kS);
                float o = 0.f;
#pragma unroll
                for (int k8 = 0; k8 < 4; ++k8) { const u32x4 wq = *(const LAS u32x4*)(qbuf + s * 256 + kq * 64 + k8 * 16);
                    const float qq[8] = {bf2f(wq.x & 0xffffu), bf2f(wq.x >> 16), bf2f(wq.y & 0xffffu), bf2f(wq.y >> 16), bf2f(wq.z & 0xffffu), bf2f(wq.z >> 16), bf2f(wq.w & 0xffffu), bf2f(wq.w >> 16)};
#pragma unroll
                    for (int e = 0; e < 8; ++e) { S[k8 * 8 + e] = fmaf(kk[k8 * 8 + e], vn, S[k8 * 8 + e]); o = fmaf(qq[e], S[k8 * 8 + e], o); } }
                o += wshfl_xor(o, 16, tid); o += wshfl_xor(o, 32, tid);
                if (kq == 0) od[(size_t)(t0 + s) * 512 + h * 128 + vb * 16 + vc] = o * 0.08838834764831845f;
            }
            LDS_WAIT();
        }
    }
}

__device__ __forceinline__ void dn_out_phase(const Args& a, LAS unsigned char* lds, int tid) {
    unsigned char* ws = a.ws; const float* od = (const float*)(ws + WS_OD); const bf16* zb = (const bf16*)(ws + WS_ZB); const float* norm_w = a.in[13];
    bf16* ob = (bf16*)a.out;
    LAS float* red = (LAS float*)lds;
    const int h = tid >> 7, d = tid & 127, wave = tid >> 6; const float nw = norm_w[d];
    for (int t = blockIdx.x; t < T; t += gridDim.x) {
        const size_t o = (size_t)t * 512 + h * 128 + d;
        const float v = od[o]; float s = v * v;
#pragma unroll
        for (int off = 32; off > 0; off >>= 1) s += wshfl_xor(s, off, tid);
        if ((tid & 63) == 0) red[wave] = s;
        __syncthreads();
        s = (red[h * 2] + red[h * 2 + 1]) * (1.f / 128.f);
        ob[o] = (bf16)f2bf(v * (1.0f / sqrtf(s + 1e-6f)) * nw * bf2f(zb[o]));
        __syncthreads();
    }
}

__device__ __forceinline__ void final_ln_phase(const Args& a, int tid) {
    const int lane = tid & 63, wave = tid >> 6; const int gw = blockIdx.x * 8 + wave, NGW = gridDim.x * 8;
    const float* ln_g = a.in[19]; const float* ln_b = a.in[20];
    f32x4 gv[4], bv[4];
#pragma unroll
    for (int j = 0; j < 4; ++j) { gv[j] = ((const f32x4*)ln_g)[lane + 64 * j]; bv[j] = ((const f32x4*)ln_b)[lane + 64 * j]; }
    for (int m = gw; m < T; m += NGW) {
        f32x4* xr = (f32x4*)(a.out + (size_t)m * 1024) + lane;
        f32x4 v[4]; float s = 0.f;
#pragma unroll
        for (int j = 0; j < 4; ++j) { v[j] = xr[64 * j]; s += (v[j].x + v[j].y) + (v[j].z + v[j].w); }
#pragma unroll
        for (int o = 1; o < 64; o <<= 1) s += wshfl_xor(s, o, tid);
        const float mean = s * (1.f / 1024.f); float s2 = 0.f;
#pragma unroll
        for (int j = 0; j < 4; ++j) { v[j] = v[j] - mean; s2 += (v[j].x * v[j].x + v[j].y * v[j].y) + (v[j].z * v[j].z + v[j].w * v[j].w); }
#pragma unroll
        for (int o = 1; o < 64; o <<= 1) s2 += wshfl_xor(s2, o, tid);
        const float rstd = 1.0f / sqrtf(s2 * (1.f / 1024.f) + 1e-5f);
#pragma unroll
        for (int j = 0; j < 4; ++j) xr[64 * j] = v[j] * rstd * gv[j] + bv[j];
    }
}

__global__ void __launch_bounds__(512, 2) mega_fwd(Args a) {
    extern __shared__ __attribute__((aligned(16))) unsigned char lds_raw[];
    LAS unsigned char* lds = (LAS unsigned char*)lds_raw;
    cg::grid_group grid = cg::this_grid();
    int tid = threadIdx.x; const int G = gridDim.x;
    unsigned char* ws = a.ws;
#define FRESH_TID() do { tid = threadIdx.x; asm volatile("" : "+v"(tid)); } while (0)

    FRESH_TID();
    p0_prologue(a, lds, tid);
    grid.sync();
    { pg8::Gemm g{(const pg8::bf16_t*)(ws + WS_XB), (const pg8::bf16_t*)(ws + WS_WIN), T, 6144, 1024}; pg8::StaticOrder S; S.init(T, 6144, G, (int)blockIdx.x);
      EpiProj E{ws}; pg8::gemm_phase<EpiProj, pg8::StaticOrder, true, true>(lds, g, S, E); }
    grid.sync();
    FRESH_TID(); dn_prep_phase(a, lds, tid);
    __syncthreads();
    FRESH_TID(); cmp_gemm1_phase(a, lds, tid);
    __syncthreads();
#ifdef SIMPLE_WIN
    FRESH_TID(); attn_simple_phase<2>(a, lds, tid);
#else
    FRESH_TID(); attn_mfma_phase<2, false>(a, lds, tid);
#endif
    grid.sync();
    FRESH_TID(); cmp_gemm2_phase(a, lds, tid);
    __syncthreads();
#ifdef PROBE_WIN
    FRESH_TID(); attn_mfma_phase<2, true>(a, lds, tid);
    __syncthreads();
#endif
    FRESH_TID(); dn_scan_phase(a, lds, tid);
    grid.sync();
    FRESH_TID(); attn_simple_phase<0>(a, lds, tid);
    grid.sync();
#if defined(PROBE_SEL) || defined(SIMPLE_SEL)
    FRESH_TID(); attn_simple_phase<1>(a, lds, tid);
    __syncthreads();
#ifdef PROBE_SEL
    grid.sync();
    FRESH_TID(); attn_mfma_phase<1, true>(a, lds, tid);
#endif
#else
    FRESH_TID(); attn_mfma_phase<1, false>(a, lds, tid);
#endif
    __syncthreads();
    FRESH_TID(); dn_out_phase(a, lds, tid);
    grid.sync();
    { pg8::Gemm g{(const pg8::bf16_t*)(ws + WS_OA), (const pg8::bf16_t*)(ws + WS_WA), T, 1024, 512}; pg8::StaticOrder S; S.init(T, 1024, G, (int)blockIdx.x);
      EpiYA E{(const bf16*)(ws + WS_GM), (float*)(ws + WS_PARTA)}; pg8::gemm_phase<EpiYA, pg8::StaticOrder, true, true>(lds, g, S, E); }
    { pg8::Gemm g{(const pg8::bf16_t*)a.out, (const pg8::bf16_t*)(ws + WS_WB), T, 1024, 512}; pg8::StaticOrder S; S.init(T, 1024, G, (int)blockIdx.x);
      EpiYB E{(const bf16*)(ws + WS_GM), (const float*)(ws + WS_PARTA), (bf16*)(ws + WS_M)}; pg8::gemm_phase<EpiYB, pg8::StaticOrder, true, true>(lds, g, S, E); }
    grid.sync();
    { pg8::Gemm g{(const pg8::bf16_t*)(ws + WS_M), (const pg8::bf16_t*)(ws + WS_WOUT), T, 1024, 1024}; pg8::StaticOrder S; S.init(T, 1024, G, (int)blockIdx.x);
      EpiH E{a.in[0], (float*)(ws + WS_H), (bf16*)(ws + WS_HB)}; pg8::gemm_phase<EpiH, pg8::StaticOrder, true, true>(lds, g, S, E); }
    { pg8::Gemm g{(const pg8::bf16_t*)(ws + WS_PB), (const pg8::bf16_t*)(ws + WS_WPLE), T, 1024, 256}; pg8::StaticOrder S; S.init(T, 1024, G, (int)blockIdx.x);
      EpiPE E{(float*)(ws + WS_PE)}; pg8::gemm_phase<EpiPE, pg8::StaticOrder, true, true>(lds, g, S, E); }
    grid.sync();
    { pg8::Gemm g{(const pg8::bf16_t*)(ws + WS_HB), (const pg8::bf16_t*)(ws + WS_WPG), T, 1024, 1024}; pg8::StaticOrder S; S.init(T, 1024, G, (int)blockIdx.x);
      EpiGate E{(const float*)(ws + WS_H), (const float*)(ws + WS_PE), a.out}; pg8::gemm_phase<EpiGate, pg8::StaticOrder, true, true>(lds, g, S, E); }
    grid.sync();
    FRESH_TID(); final_ln_phase(a, tid);
#if defined(PROBE_WIN) || defined(PROBE_SEL)
    if (blockIdx.x == 0 && threadIdx.x == 0) a.out[0] += *(const float*)(ws + WS_DBG) * 1000.f;
#endif
}

extern "C" void kernel_launch(void* const* d_in, const int* in_sizes, int n_in, void* d_out, int out_size, void* d_ws, size_t ws_size, hipStream_t stream) {
    static int grid = 0;
    if (grid == 0) {
        if (n_in != 21 || out_size != T * DM || ws_size < WS_END) { fprintf(stderr, "kernel_launch: unexpected shapes (n_in %d out %d ws %zu)\n", n_in, out_size, ws_size); grid = -1; return; }
        int dev = 0, cus = 0, per_cu = 0;
        hipGetDevice(&dev); hipDeviceGetAttribute(&cus, hipDeviceAttributeMultiprocessorCount, dev);
        hipFuncSetAttribute((const void*)mega_fwd, hipFuncAttributeMaxDynamicSharedMemorySize, LDS_BYTES);
        hipOccupancyMaxActiveBlocksPerMultiprocessor(&per_cu, (const void*)mega_fwd, 512, LDS_BYTES);
        if (per_cu < 1) { fprintf(stderr, "kernel_launch: occupancy query says %d blocks/CU\n", per_cu); per_cu = 1; }
        grid = cus;
        (void)hipGetLastError();
    }
    if (grid < 0) return;
    Args a{};
    for (int i = 0; i < 21; ++i) a.in[i] = (const float*)d_in[i];
    a.out = (float*)d_out; a.ws = (unsigned char*)d_ws;
    void* args[] = {&a};
    hipError_t e = hipLaunchCooperativeKernel((const void*)mega_fwd, dim3(grid), dim3(512), args, LDS_BYTES, stream);
    if (e != hipSuccess) fprintf(stderr, "cooperative launch failed: %s (grid %d)\n", hipGetErrorString(e), grid);
}
```

```cpp
#include <hip/hip_runtime.h>
#include <hip/hip_cooperative_groups.h>
#include <cstdio>
#include <cstdint>
#include <cmath>
namespace cg = cooperative_groups;
namespace pg8 {
#define PG8_LAS __attribute__((address_space(3)))
typedef unsigned short bf16_t;
typedef short bf16x8 __attribute__((ext_vector_type(8)));
typedef float f32x4 __attribute__((ext_vector_type(4)));
typedef unsigned u32x4 __attribute__((ext_vector_type(4)));
constexpr int BM = 256, BK = 64, HALF = 128, HTB = HALF * BK * 2  , STAGE_BYTES = 8 * HTB, NXCD = 8, WGM = 8;

__host__ __device__ __forceinline__ int lds_byte(int r, int c) { const int st = (r >> 4) * 2 + (c >> 5), rr = r & 15, cc = c & 31, ob = rr * 64 + cc * 2; return st * 1024 + (ob ^ (((ob >> 9) & 1) << 5)); }
__host__ __device__ __forceinline__ void stage_rc(int b, int& R, int& C) { const int st = b / 1024, sb = b % 1024, swz = sb ^ (((sb >> 9) & 1) << 5); R = (st >> 1) * 16 + swz / 64; C = (st & 1) * 32 + (swz % 64) / 2; }
__host__ __device__ __forceinline__ int perm32(int rho) { const int n = rho >> 4, i = rho & 15; return 8 * (i >> 2) + 4 * n + (i & 3); }

struct Unit { int pm, pn; };
struct Gemm { const bf16_t* A; const bf16_t* Bt; int M, N, K; };

struct StaticOrder {
    int nM, nN, nwg, G, c;
    __host__ __device__ void init(int M, int N, int G_, int c_) { nM = M / BM; nN = N / BM; nwg = nM * nN; G = G_; c = c_; }
    __host__ __device__ bool next(int i, Unit& u) const {
        const long L = (long)i * G + c; if (L >= nwg) return false;
        int wgid = (int)L; { const int q = nwg / NXCD, r = nwg % NXCD, xcd = wgid % NXCD, off = wgid / NXCD; wgid = (xcd < r ? xcd * (q + 1) : r * (q + 1) + (xcd - r) * q) + off; }
        const int nig = WGM * nN, gid = wgid / nig, fm = gid * WGM, gsz = (nM - fm) < WGM ? (nM - fm) : WGM;
        u.pm = fm + ((wgid % nig) % gsz); u.pn = (wgid % nig) / gsz; return true;
    }
    __device__ __forceinline__ void a_ready(const Unit&) const {}
    __device__ __forceinline__ void done(const Unit&) const {}
};

__device__ __forceinline__ unsigned cvt_pk_bf16(float lo, float hi) { unsigned r; asm volatile("v_cvt_pk_bf16_f32 %0, %1, %2" : "=v"(r) : "v"(lo), "v"(hi)); return r; }
typedef float f32x2 __attribute__((ext_vector_type(2)));
template <class Epi, class Sched, bool ALIGN_EPI = false, bool SP2 = false>
__device__ __forceinline__ void gemm_phase(PG8_LAS unsigned char* lds, const Gemm g, const Sched& S, const Epi& E) {
    int tid_ = threadIdx.x; asm volatile("" : "+v"(tid_)); const int tid = tid_, wid = __builtin_amdgcn_readfirstlane(tid >> 6), lane = tid & 63, wr = wid >> 2, wc = wid & 3, fr = lane & 15, fq = lane >> 4;
    const int K = g.K, nt = K / BK;
    unsigned voffA[2], voffB[2];
#pragma unroll
    for (int i = 0; i < 2; ++i) { int R, C; stage_rc(tid * 16 + i * 8192, R, C); const int Rb = Epi::PERM ? ((R & ~31) + perm32(R & 31)) : R;
        voffA[i] = (unsigned)(R * K + C) * 2u; voffB[i] = (unsigned)(Rb * K + C) * 2u; }
    const size_t kstep = (size_t)(BK * 2);
    const size_t hstep = (size_t)HALF * K * 2;
    const size_t tstep = 2 * hstep;
    const unsigned ldsw = (unsigned)wid * 1024u;
    const int aoff = lds_byte(wr * 64 + fr, fq * 8), boff = lds_byte(wc * 32 + fr, fq * 8);
#define PG8_SA(b, h) (((b) * 2 + (h)) * HTB)
#define PG8_SB(b, h) ((4 + (b) * 2 + (h)) * HTB)
#define PG8_STAGE(bufoff, gbase, voff) do { _Pragma("unroll") for (int _i = 0; _i < 2; ++_i) \
        __builtin_amdgcn_global_load_lds((const unsigned*)((const char*)(gbase) + (voff)[_i]), (PG8_LAS unsigned*)(lds + (bufoff) + ldsw + _i * 8192), 16, 0, 0); } while (0)
#define PG8_LDA(dst, b, h) do { _Pragma("unroll") for (int m = 0; m < 4; ++m) _Pragma("unroll") for (int k = 0; k < 2; ++k) dst[m][k] = *(const PG8_LAS bf16x8*)(lds + PG8_SA(b, h) + aoff + m * 2048 + k * 1024); } while (0)
#define PG8_LDB(dst, b, h) do { _Pragma("unroll") for (int n = 0; n < 2; ++n) _Pragma("unroll") for (int k = 0; k < 2; ++k) dst[n][k] = *(const PG8_LAS bf16x8*)(lds + PG8_SB(b, h) + boff + n * 2048 + k * 1024); } while (0)
#define PG8_MMA(ai, bj, At, Bt) do { __builtin_amdgcn_s_setprio(1); _Pragma("unroll") for (int m = 0; m < 4; ++m) _Pragma("unroll") for (int n = 0; n < 2; ++n) _Pragma("unroll") for (int k = 0; k < 2; ++k) \
        acc[ai][bj][m][n] = __builtin_amdgcn_mfma_f32_16x16x32_bf16(Bt[n][k], At[m][k], acc[ai][bj][m][n], 0, 0, 0); __builtin_amdgcn_s_setprio(0); } while (0)
#define PG8_WAIT_V(n) asm volatile("s_waitcnt vmcnt(" #n ")" ::: "memory")
#define PG8_WAIT_L(n) asm volatile("s_waitcnt lgkmcnt(" #n ")" ::: "memory")
#define PG8_BAR __builtin_amdgcn_s_barrier()
#define PG8_SCHED __builtin_amdgcn_sched_barrier(0)
    Unit cur, nxt; int ui = 0;
    if (!S.next(0, cur)) return;
    f32x4 acc[2][2][4][2];
#pragma unroll
    for (int a = 0; a < 2; ++a)
#pragma unroll
        for (int b = 0; b < 2; ++b)
#pragma unroll
            for (int m = 0; m < 4; ++m)
#pragma unroll
                for (int n = 0; n < 2; ++n) acc[a][b][m][n] = (f32x4){0.f, 0.f, 0.f, 0.f};
    bf16x8 At[4][2], B0[2][2], B1[2][2];
    const char* cA = (const char*)g.A + (size_t)cur.pm * tstep; const char* cB = (const char*)g.Bt + (size_t)cur.pn * tstep;
    S.a_ready(cur);
    if constexpr (SP2) {
        PG8_STAGE(PG8_SB(0, 0), cB, voffB); PG8_STAGE(PG8_SB(0, 1), cB + hstep, voffB); PG8_STAGE(PG8_SA(0, 0), cA, voffA); PG8_STAGE(PG8_SA(0, 1), cA + hstep, voffA);
        if (wr == 1) PG8_BAR;
        PG8_WAIT_V(2); PG8_BAR;
        PG8_STAGE(PG8_SB(1, 0), cB + kstep, voffB); PG8_STAGE(PG8_SA(1, 0), cA + kstep, voffA); PG8_STAGE(PG8_SB(1, 1), cB + hstep + kstep, voffB);
        PG8_WAIT_V(6); PG8_BAR;
    } else {
        PG8_STAGE(PG8_SB(0, 0), cB, voffB); PG8_STAGE(PG8_SA(0, 0), cA, voffA); PG8_STAGE(PG8_SB(0, 1), cB + hstep, voffB); PG8_STAGE(PG8_SA(0, 1), cA + hstep, voffA);
        if (wr == 1) PG8_BAR;
        PG8_WAIT_V(4); PG8_BAR;
        PG8_STAGE(PG8_SB(1, 0), cB + kstep, voffB); PG8_STAGE(PG8_SA(1, 0), cA + kstep, voffA); PG8_STAGE(PG8_SB(1, 1), cB + hstep + kstep, voffB);
        PG8_WAIT_V(6); PG8_BAR;
    }
    for (;;) {
        const bool has_next = S.next(ui + 1, nxt);
        const char* nA = has_next ? (const char*)g.A + (size_t)nxt.pm * tstep : cA; const char* nB = has_next ? (const char*)g.Bt + (size_t)nxt.pn * tstep : cB;
        for (int t = 0; t < nt; t += 2) {
            const bool last = (t == nt - 2);
            const char* a1 = cA + (size_t)(t + 1) * kstep;
            const char* a2 = last ? nA : cA + (size_t)(t + 2) * kstep; const char* b2 = last ? nB : cB + (size_t)(t + 2) * kstep;
            const char* a3 = a2 + kstep; const char* b3 = b2 + kstep;
            if (last && has_next) S.a_ready(nxt);
            if constexpr (SP2) {
            PG8_LDB(B0, 0, 0); PG8_LDB(B1, 0, 1); PG8_SCHED; PG8_LDA(At, 0, 0); PG8_STAGE(PG8_SA(1, 1), a1 + hstep, voffA);
            PG8_WAIT_V(8); PG8_WAIT_L(0); PG8_BAR; PG8_MMA(0, 0, At, B0); PG8_MMA(0, 1, At, B1); PG8_BAR; PG8_SCHED;
            PG8_LDA(At, 0, 1); PG8_STAGE(PG8_SB(0, 0), b2, voffB); PG8_STAGE(PG8_SB(0, 1), b2 + hstep, voffB); PG8_STAGE(PG8_SA(0, 0), a2, voffA);
            PG8_WAIT_V(8); PG8_WAIT_L(0); PG8_BAR; PG8_MMA(1, 0, At, B0); PG8_MMA(1, 1, At, B1); PG8_BAR; PG8_SCHED;
            PG8_LDB(B0, 1, 0); PG8_LDB(B1, 1, 1); PG8_SCHED; PG8_LDA(At, 1, 0); PG8_STAGE(PG8_SA(0, 1), a2 + hstep, voffA);
            PG8_WAIT_V(8); PG8_WAIT_L(0); PG8_BAR; PG8_MMA(0, 0, At, B0); PG8_MMA(0, 1, At, B1); PG8_BAR; PG8_SCHED;
            PG8_LDA(At, 1, 1); PG8_STAGE(PG8_SB(1, 0), b3, voffB); PG8_STAGE(PG8_SB(1, 1), b3 + hstep, voffB); PG8_STAGE(PG8_SA(1, 0), a3, voffA);
            PG8_WAIT_V(8); PG8_WAIT_L(0); PG8_BAR; PG8_MMA(1, 0, At, B0); PG8_MMA(1, 1, At, B1); PG8_BAR; PG8_SCHED;
            } else {
            PG8_LDB(B0, 0, 0); PG8_SCHED; PG8_LDA(At, 0, 0); PG8_STAGE(PG8_SA(1, 1), a1 + hstep, voffA);
            PG8_WAIT_L(8); PG8_BAR; PG8_WAIT_L(0); PG8_MMA(0, 0, At, B0); PG8_BAR; PG8_SCHED;
            PG8_LDB(B1, 0, 1); PG8_STAGE(PG8_SB(0, 0), b2, voffB);
            PG8_BAR; PG8_WAIT_L(0); PG8_MMA(0, 1, At, B1); PG8_BAR;
            PG8_LDA(At, 0, 1); PG8_STAGE(PG8_SA(0, 0), a2, voffA);
            PG8_BAR; PG8_WAIT_L(0); PG8_MMA(1, 0, At, B0); PG8_BAR; PG8_SCHED;
            PG8_STAGE(PG8_SB(0, 1), b2 + hstep, voffB);
            PG8_WAIT_V(6); PG8_BAR; PG8_MMA(1, 1, At, B1); PG8_BAR;
            PG8_LDB(B0, 1, 0); PG8_SCHED; PG8_LDA(At, 1, 0); PG8_STAGE(PG8_SA(0, 1), a2 + hstep, voffA);
            PG8_WAIT_L(8); PG8_BAR; PG8_WAIT_L(0); PG8_MMA(0, 0, At, B0); PG8_BAR; PG8_SCHED;
            PG8_LDB(B1, 1, 1); PG8_STAGE(PG8_SB(1, 0), b3, voffB);
            PG8_BAR; PG8_WAIT_L(0); PG8_MMA(0, 1, At, B1); PG8_BAR;
            PG8_LDA(At, 1, 1); PG8_STAGE(PG8_SA(1, 0), a3, voffA);
            PG8_BAR; PG8_WAIT_L(0); PG8_MMA(1, 0, At, B0); PG8_BAR; PG8_SCHED;
            PG8_STAGE(PG8_SB(1, 1), b3 + hstep, voffB);
            PG8_WAIT_V(6); PG8_BAR; PG8_MMA(1, 1, At, B1); PG8_BAR;
            }
        }
        if constexpr (ALIGN_EPI) { if (wr == 0) PG8_BAR; }
        if constexpr (!Epi::AFTER_DRAIN) { E(acc, cur, wr, wc, fr, fq); S.done(cur); }
        if (!has_next) break;
#pragma unroll
        for (int a = 0; a < 2; ++a)
#pragma unroll
            for (int b = 0; b < 2; ++b)
#pragma unroll
                for (int m = 0; m < 4; ++m)
#pragma unroll
                    for (int n = 0; n < 2; ++n) acc[a][b][m][n] = (f32x4){0.f, 0.f, 0.f, 0.f};
        cur = nxt; cA = nA; cB = nB; ++ui;
        if constexpr (ALIGN_EPI) { if (wr == 1) PG8_BAR; }
    }
    PG8_WAIT_V(0);
    if constexpr (!ALIGN_EPI) { if (wr == 0) PG8_BAR; }
    PG8_BAR;
    if constexpr (Epi::AFTER_DRAIN) { E.fused(acc, cur, wr, wc, fr, fq, lds, wid, lane); S.done(cur); }
#undef PG8_SA
#undef PG8_SB
#undef PG8_STAGE
#undef PG8_LDA
#undef PG8_LDB
#undef PG8_MMA
#undef PG8_WAIT_V
#undef PG8_WAIT_L
#undef PG8_BAR
#undef PG8_SCHED
}
}

constexpr int T = 16384, SEQ = 2048, DM = 1024;
constexpr float ALPHA = 1.189207115002721f;
typedef unsigned short bf16;
typedef unsigned u32;
typedef unsigned u32x4 __attribute__((ext_vector_type(4)));
typedef unsigned u32x2 __attribute__((ext_vector_type(2)));
typedef float f32x4 __attribute__((ext_vector_type(4)));
typedef short bf16x8 __attribute__((ext_vector_type(8)));
#define LAS __attribute__((address_space(3)))
constexpr size_t MiB = (size_t)1 << 20;
constexpr size_t WS_WIN = 1 * MiB, WS_W1K = 13 * MiB, WS_W1V = 14 * MiB, WS_WA = 15 * MiB, WS_WB = 16 * MiB, WS_WOUT = 17 * MiB, WS_WPG = 19 * MiB, WS_WPLE = 21 * MiB;
constexpr size_t WS_PB = 22 * MiB, WS_SM = 30 * MiB, WS_XB = 32 * MiB, WS_Q = 64 * MiB, WS_KV = 80 * MiB, WS_ZA = 104 * MiB, WS_QKVB = 120 * MiB, WS_ZB = 168 * MiB, WS_GM = 184 * MiB;
constexpr size_t WS_HID = 248 * MiB, WS_KC = 250 * MiB, WS_VC = 250 * MiB + 512 * 1024, WS_SEL = 251 * MiB, WS_GG = 251 * MiB + 256 * 1024, WS_BB = 251 * MiB + 512 * 1024, WS_TBL = 252 * MiB, WS_DBG = 254 * MiB, WS_KCB = 254 * MiB + 65536, WS_VCB = 254 * MiB + 65536 + 262144, WS_END = 255 * MiB;
constexpr size_t WS_OACC = WS_XB, WS_OD = WS_QKVB, WS_OA = WS_QKVB + 32 * MiB, WS_PARTA = 32 * MiB, WS_M = 96 * MiB, WS_H = 32 * MiB, WS_HB = 128 * MiB, WS_PE = 184 * MiB;
constexpr int LDS_BYTES = 147456;
constexpr int NDI = 28;

__device__ __forceinline__ float bf2f(unsigned v) { return __uint_as_float(v << 16); }
__device__ __forceinline__ unsigned f2bf(float f) { unsigned u = __float_as_uint(f); return (u + 0x7fffu + ((u >> 16) & 1u)) >> 16; }
__device__ __forceinline__ unsigned pk2(float lo, float hi) { return f2bf(lo) | (f2bf(hi) << 16); }
__device__ __forceinline__ float fexp(float x) { return __builtin_amdgcn_exp2f(x * 1.4426950408889634f); }
__device__ __forceinline__ float sigm(float x) { return __builtin_amdgcn_rcpf(1.f + fexp(-x)); }
__device__ __forceinline__ float siluf_(float x) { return x * sigm(x); }
__device__ __forceinline__ int rel_bucket(int n) {
    if (n < 16) return n < 0 ? 0 : n;
    return 16 + (n >= 21) + (n >= 27) + (n >= 35) + (n >= 46) + (n >= 59) + (n >= 77) + (n >= 99) + (n >= 128) + (n >= 166) + (n >= 216) + (n >= 280) + (n >= 363) + (n >= 470) + (n >= 609) + (n >= 790);
}
#define LDS_WAIT() asm volatile("s_waitcnt lgkmcnt(0)" ::: "memory")
__device__ __forceinline__ float wshfl_xor(float v, int o, int tid) { return __int_as_float(__builtin_amdgcn_ds_bpermute(((tid ^ o) & 63) << 2, __float_as_int(v))); }

#if defined(PROBE_FUSED)
#define PROBE_SCALE ((PROBE_FUSED) == 2 ? 1.f : 1000.f)
#else
#define PROBE_SCALE 1000.f
#endif
struct Args { const float* in[21]; float* out; unsigned char* ws; };

__device__ __forceinline__ int win_srccol(int r) {
    if (r < 1280) return r;
    if (r < 3328) return r + 24;
    if (r < 5888) return r + 32;
    if (r < 5912) return 1280 + (r - 5888);
    if (r < 5916) return 3352 + (r - 5912);
    if (r < 5920) return 3356 + (r - 5916);
    return -1;
}
template <bool REMAP>
__device__ __forceinline__ void transpose_item(const float* __restrict__ W, int K, int N, bf16* __restrict__ WT, LAS float* scr, int k0, int n0, int lane) {
    const int sc = REMAP ? win_srccol(n0 + (lane & 31)) : n0 + (lane & 31);
#pragma unroll 8
    for (int i = 0; i < 32; ++i) { const int kk = 2 * i + (lane >> 5); scr[kk * 33 + (lane & 31)] = (sc >= 0) ? W[(size_t)(k0 + kk) * N + sc] : 0.f; }
    LDS_WAIT();
    const int c = lane & 7;
#pragma unroll
    for (int j = 0; j < 4; ++j) { const int n = (lane >> 3) + 8 * j; const LAS float* s = scr + (8 * c) * 33 + n;
        u32x4 o; o.x = pk2(s[0 * 33], s[1 * 33]); o.y = pk2(s[2 * 33], s[3 * 33]); o.z = pk2(s[4 * 33], s[5 * 33]); o.w = pk2(s[6 * 33], s[7 * 33]);
        *(u32x4*)(WT + (size_t)(n0 + n) * K + k0 + 8 * c) = o; }
    LDS_WAIT();
}
__device__ __forceinline__ void p0_prologue(const Args& a, LAS unsigned char* lds, int tid) {
    const int lane = tid & 63, wave = tid >> 6;
    LAS float* scr = (LAS float*)(lds + wave * 8704);
    const int gw = blockIdx.x * 8 + wave, NGW = gridDim.x * 8;
    unsigned char* ws = a.ws;
    constexpr int I_WIN = 16 * 192, I_W1 = 32 * 8, I_WAB = 8 * 32, I_WSQ = 16 * 32, I_WPLE = 4 * 32;
    constexpr int NITEMS = I_WIN + 2 * I_W1 + 2 * I_WAB + 2 * I_WSQ + I_WPLE;
    for (int it = gw; it < NITEMS; it += NGW) {
        int r = it;
        if (r < I_WIN) { transpose_item<true>(a.in[2], 1024, 5920, (bf16*)(ws + WS_WIN), scr, (r / 192) * 64, (r % 192) * 32, lane); continue; } r -= I_WIN;
        if (r < I_W1) { transpose_item<false>(a.in[5], 2048, 256, (bf16*)(ws + WS_W1K), scr, (r / 8) * 64, (r % 8) * 32, lane); continue; } r -= I_W1;
        if (r < I_W1) { transpose_item<false>(a.in[7], 2048, 256, (bf16*)(ws + WS_W1V), scr, (r / 8) * 64, (r % 8) * 32, lane); continue; } r -= I_W1;
        if (r < I_WAB) { transpose_item<false>(a.in[14], 512, 1024, (bf16*)(ws + WS_WA), scr, (r / 32) * 64, (r % 32) * 32, lane); continue; } r -= I_WAB;
        if (r < I_WAB) { transpose_item<false>(a.in[15], 512, 1024, (bf16*)(ws + WS_WB), scr, (r / 32) * 64, (r % 32) * 32, lane); continue; } r -= I_WAB;
        if (r < I_WSQ) { transpose_item<false>(a.in[16], 1024, 1024, (bf16*)(ws + WS_WOUT), scr, (r / 32) * 64, (r % 32) * 32, lane); continue; } r -= I_WSQ;
        if (r < I_WSQ) { transpose_item<false>(a.in[18], 1024, 1024, (bf16*)(ws + WS_WPG), scr, (r / 32) * 64, (r % 32) * 32, lane); continue; } r -= I_WSQ;
        transpose_item<false>(a.in[17], 256, 1024, (bf16*)(ws + WS_WPLE), scr, (r / 32) * 64, (r % 32) * 32, lane);
    }
    const float* x = a.in[0]; bf16* xb = (bf16*)(ws + WS_XB);
    for (int m = gw; m < T; m += NGW) {
        const f32x4* xr = (const f32x4*)(x + (size_t)m * 1024) + lane; u32x2* o = (u32x2*)(xb + (size_t)m * 1024) + lane;
#pragma unroll
        for (int j = 0; j < 4; ++j) { const f32x4 v = xr[64 * j]; u32x2 w; w.x = pk2(v.x, v.y); w.y = pk2(v.z, v.w); o[64 * j] = w; }
    }
    const float* p = a.in[1]; bf16* pb = (bf16*)(ws + WS_PB);
    for (int m = gw; m < T; m += NGW) {
        const f32x4 v = ((const f32x4*)(p + (size_t)m * 256))[lane]; u32x2 w; w.x = pk2(v.x, v.y); w.y = pk2(v.z, v.w); ((u32x2*)(pb + (size_t)m * 256))[lane] = w;
    }
    { const float* rel_bias = a.in[9]; bf16* tbl = (bf16*)(ws + WS_TBL);
      for (int idx = blockIdx.x * 512 + tid; idx < 2 * NDI * 8 * 2 * 2 * 64 * 8; idx += gridDim.x * 512) {
          const int j = idx & 7, ln = (idx >> 3) & 63, half = (idx >> 9) & 1, sx = (idx >> 10) & 1, h = (idx >> 11) & 7, rest = idx >> 14, di = rest % NDI, type = rest / NDI;
          const int kj = 32 * half + (ln & 31), qi = 16 * sx + 8 * (ln >> 5) + j, dist = 32 * di + qi - kj;
          const float v = (dist < 0 || (type == 1 && dist >= 512)) ? -30000.f : rel_bias[rel_bucket(dist) * 8 + h] * 1.4426950408889634f;
          tbl[idx] = (bf16)f2bf(v); } }
    if (blockIdx.x == 0 && tid == 0) *(float*)(ws + WS_DBG) = 0.f;
}

struct EpiProj {
    static constexpr bool PERM = true, AFTER_DRAIN = false;
    unsigned char* ws;
    __device__ __forceinline__ void operator()(const pg8::f32x4 (&acc)[2][2][4][2], const pg8::Unit& u, int wr, int wc, int fr, int fq) const {
        const int pn = u.pn; const int row0 = u.pm * 256 + wr * 64 + fr;
        if (pn == 23) {
            if (wc == 0) { float* sm = (float*)(ws + WS_SM);
#pragma unroll
                for (int ai = 0; ai < 2; ++ai)
#pragma unroll
                    for (int m = 0; m < 4; ++m) { float* o = sm + (size_t)(row0 + ai * 128 + m * 16) * 32 + 8 * fq; *(f32x4*)o = acc[ai][0][m][0]; *(f32x4*)(o + 4) = acc[ai][0][m][1]; } }
            return;
        }
        int kind, ldc, colt; size_t boff;
        if (pn < 2) { kind = 1; boff = WS_Q; ldc = 512; colt = pn * 256; }
        else if (pn < 5) { kind = 0; boff = WS_KV; ldc = 768; colt = (pn - 2) * 256; }
        else if (pn < 7) { kind = 2; boff = WS_ZA; ldc = 512; colt = (pn - 5) * 256; }
        else if (pn < 13) { kind = 0; boff = WS_QKVB; ldc = 1536; colt = (pn - 7) * 256; }
        else if (pn < 15) { kind = 2; boff = WS_ZB; ldc = 512; colt = (pn - 13) * 256; }
        else { kind = 3; boff = WS_GM; ldc = 2048; colt = (pn - 15) * 256; }
        bf16* base = (bf16*)(ws + boff); const int col0 = colt + wc * 32 + 8 * fq;
#pragma unroll
        for (int ai = 0; ai < 2; ++ai)
#pragma unroll
            for (int m = 0; m < 4; ++m) { bf16* rowp = base + (size_t)(row0 + ai * 128 + m * 16) * ldc + col0;
#pragma unroll
                for (int bj = 0; bj < 2; ++bj) { float v[8];
#pragma unroll
                    for (int e = 0; e < 4; ++e) { v[e] = acc[ai][bj][m][0][e]; v[4 + e] = acc[ai][bj][m][1][e]; }
                    if (kind == 1) {
#pragma unroll
                        for (int e = 0; e < 8; ++e) v[e] *= 0.18033688011112042f;
                    } else if (kind == 2) {
#pragma unroll
                        for (int e = 0; e < 8; ++e) v[e] = siluf_(v[e]);
                    } else if (kind == 3) {
#pragma unroll
                        for (int e = 0; e < 8; ++e) v[e] = sigm(v[e]);
                    }
                    u32x4 w; w.x = pk2(v[0], v[1]); w.y = pk2(v[2], v[3]); w.z = pk2(v[4], v[5]); w.w = pk2(v[6], v[7]);
                    *(u32x4*)(rowp + bj * 128) = w; } }
    }
};
struct EpiYA {
    static constexpr bool PERM = true, AFTER_DRAIN = false;
    const bf16* gm; float* part;
    __device__ __forceinline__ void operator()(const pg8::f32x4 (&acc)[2][2][4][2], const pg8::Unit& u, int wr, int wc, int fr, int fq) const {
        const int row0 = u.pm * 256 + wr * 64 + fr, col0 = u.pn * 256 + wc * 32 + 8 * fq;
#pragma unroll
        for (int ai = 0; ai < 2; ++ai)
#pragma unroll
            for (int m = 0; m < 4; ++m)
#pragma unroll
                for (int bj = 0; bj < 2; ++bj) { const size_t r = row0 + ai * 128 + m * 16; const int c = col0 + bj * 128;
                    const u32x4 g = *(const u32x4*)(gm + r * 2048 + c);
                    f32x4 o0, o1;
                    o0.x = acc[ai][bj][m][0].x * bf2f(g.x & 0xffffu); o0.y = acc[ai][bj][m][0].y * bf2f(g.x >> 16); o0.z = acc[ai][bj][m][0].z * bf2f(g.y & 0xffffu); o0.w = acc[ai][bj][m][0].w * bf2f(g.y >> 16);
                    o1.x = acc[ai][bj][m][1].x * bf2f(g.z & 0xffffu); o1.y = acc[ai][bj][m][1].y * bf2f(g.z >> 16); o1.z = acc[ai][bj][m][1].z * bf2f(g.w & 0xffffu); o1.w = acc[ai][bj][m][1].w * bf2f(g.w >> 16);
                    float* o = part + r * 1024 + c; *(f32x4*)o = o0; *(f32x4*)(o + 4) = o1; }
    }
};
struct EpiYB {
    static constexpr bool PERM = true, AFTER_DRAIN = false;
    const bf16* gm; const float* part; bf16* mo;
    __device__ __forceinline__ void operator()(const pg8::f32x4 (&acc)[2][2][4][2], const pg8::Unit& u, int wr, int wc, int fr, int fq) const {
        const int row0 = u.pm * 256 + wr * 64 + fr, col0 = u.pn * 256 + wc * 32 + 8 * fq;
#pragma unroll
        for (int ai = 0; ai < 2; ++ai)
#pragma unroll
            for (int m = 0; m < 4; ++m)
#pragma unroll
                for (int bj = 0; bj < 2; ++bj) { const size_t r = row0 + ai * 128 + m * 16; const int c = col0 + bj * 128;
                    const u32x4 g = *(const u32x4*)(gm + r * 2048 + 1024 + c);
                    const float* pp = part + r * 1024 + c; const f32x4 p0 = *(const f32x4*)pp, p1 = *(const f32x4*)(pp + 4);
                    f32x4 o0, o1;
                    o0.x = p0.x + acc[ai][bj][m][0].x * bf2f(g.x & 0xffffu); o0.y = p0.y + acc[ai][bj][m][0].y * bf2f(g.x >> 16); o0.z = p0.z + acc[ai][bj][m][0].z * bf2f(g.y & 0xffffu); o0.w = p0.w + acc[ai][bj][m][0].w * bf2f(g.y >> 16);
                    o1.x = p1.x + acc[ai][bj][m][1].x * bf2f(g.z & 0xffffu); o1.y = p1.y + acc[ai][bj][m][1].y * bf2f(g.z >> 16); o1.z = p1.z + acc[ai][bj][m][1].z * bf2f(g.w & 0xffffu); o1.w = p1.w + acc[ai][bj][m][1].w * bf2f(g.w >> 16);
                    u32x4 w; w.x = pk2(o0.x, o0.y); w.y = pk2(o0.z, o0.w); w.z = pk2(o1.x, o1.y); w.w = pk2(o1.z, o1.w);
                    *(u32x4*)(mo + r * 1024 + c) = w; }
    }
};
struct EpiH {
    static constexpr bool PERM = true, AFTER_DRAIN = false;
    const float* x; float* h; bf16* hb;
    __device__ __forceinline__ void operator()(const pg8::f32x4 (&acc)[2][2][4][2], const pg8::Unit& u, int wr, int wc, int fr, int fq) const {
        const int row0 = u.pm * 256 + wr * 64 + fr, col0 = u.pn * 256 + wc * 32 + 8 * fq;
#pragma unroll
        for (int ai = 0; ai < 2; ++ai)
#pragma unroll
            for (int m = 0; m < 4; ++m)
#pragma unroll
                for (int bj = 0; bj < 2; ++bj) { const size_t off = (size_t)(row0 + ai * 128 + m * 16) * 1024 + col0 + bj * 128;
                    const f32x4 x0 = *(const f32x4*)(x + off), x1 = *(const f32x4*)(x + off + 4);
                    const f32x4 o0 = x0 * ALPHA + acc[ai][bj][m][0], o1 = x1 * ALPHA + acc[ai][bj][m][1];
                    *(f32x4*)(h + off) = o0; *(f32x4*)(h + off + 4) = o1;
                    u32x4 w; w.x = pk2(o0.x, o0.y); w.y = pk2(o0.z, o0.w); w.z = pk2(o1.x, o1.y); w.w = pk2(o1.z, o1.w);
                    *(u32x4*)(hb + off) = w; }
    }
};
struct EpiPE {
    static constexpr bool PERM = true, AFTER_DRAIN = false;
    float* pe;
    __device__ __forceinline__ void operator()(const pg8::f32x4 (&acc)[2][2][4][2], const pg8::Unit& u, int wr, int wc, int fr, int fq) const {
        const int row0 = u.pm * 256 + wr * 64 + fr, col0 = u.pn * 256 + wc * 32 + 8 * fq;
#pragma unroll
        for (int ai = 0; ai < 2; ++ai)
#pragma unroll
            for (int m = 0; m < 4; ++m)
#pragma unroll
                for (int bj = 0; bj < 2; ++bj) { const size_t off = (size_t)(row0 + ai * 128 + m * 16) * 1024 + col0 + bj * 128;
                    *(f32x4*)(pe + off) = acc[ai][bj][m][0]; *(f32x4*)(pe + off + 4) = acc[ai][bj][m][1]; }
    }
};
struct EpiGate {
    static constexpr bool PERM = true, AFTER_DRAIN = false;
    const float* h; const float* pe; float* out;
    __device__ __forceinline__ void operator()(const pg8::f32x4 (&acc)[2][2][4][2], const pg8::Unit& u, int wr, int wc, int fr, int fq) const {
        const int row0 = u.pm * 256 + wr * 64 + fr, col0 = u.pn * 256 + wc * 32 + 8 * fq;
#pragma unroll
        for (int ai = 0; ai < 2; ++ai)
#pragma unroll
            for (int m = 0; m < 4; ++m)
#pragma unroll
                for (int bj = 0; bj < 2; ++bj) { const size_t off = (size_t)(row0 + ai * 128 + m * 16) * 1024 + col0 + bj * 128;
                    const f32x4 h0 = *(const f32x4*)(h + off), h1 = *(const f32x4*)(h + off + 4), p0 = *(const f32x4*)(pe + off), p1 = *(const f32x4*)(pe + off + 4);
                    f32x4 o0, o1;
                    o0.x = h0.x + sigm(acc[ai][bj][m][0].x) * p0.x; o0.y = h0.y + sigm(acc[ai][bj][m][0].y) * p0.y; o0.z = h0.z + sigm(acc[ai][bj][m][0].z) * p0.z; o0.w = h0.w + sigm(acc[ai][bj][m][0].w) * p0.w;
                    o1.x = h1.x + sigm(acc[ai][bj][m][1].x) * p1.x; o1.y = h1.y + sigm(acc[ai][bj][m][1].y) * p1.y; o1.z = h1.z + sigm(acc[ai][bj][m][1].z) * p1.z; o1.w = h1.w + sigm(acc[ai][bj][m][1].w) * p1.w;
                    *(f32x4*)(out + off) = o0; *(f32x4*)(out + off + 4) = o1; }
    }
};

template <class LA, class LB, class ST>
__device__ __forceinline__ void sgemm_tile64(LAS float* As, LAS float* Bs, int K, int tid, LA loadA4, LB loadB4, ST store4) {
    const int tx = tid & 15, ty = (tid >> 4) & 15;
    float acc[4][4];
#pragma unroll
    for (int i = 0; i < 4; ++i)
#pragma unroll
        for (int j = 0; j < 4; ++j) acc[i][j] = 0.f;
    const int arow = (tid >> 2) & 63, akq = (tid & 3) * 4, bk = (tid >> 4) & 15, bnq = (tid & 15) * 4;
    for (int k0 = 0; k0 < K; k0 += 16) {
        if (tid < 256) {
            const f32x4 av = loadA4(arow, k0 + akq), bv = loadB4(k0 + bk, bnq);
            As[(akq + 0) * 68 + arow] = av.x; As[(akq + 1) * 68 + arow] = av.y; As[(akq + 2) * 68 + arow] = av.z; As[(akq + 3) * 68 + arow] = av.w;
            *(LAS f32x4*)&Bs[bk * 68 + bnq] = bv;
        }
        __syncthreads();
        if (tid < 256) {
#pragma unroll
            for (int k = 0; k < 16; ++k) {
                const f32x4 av = *(const LAS f32x4*)&As[k * 68 + ty * 4], bv = *(const LAS f32x4*)&Bs[k * 68 + tx * 4];
#pragma unroll
                for (int i = 0; i < 4; ++i)
#pragma unroll
                    for (int j = 0; j < 4; ++j) acc[i][j] = fmaf(av[i], bv[j], acc[i][j]);
            }
        }
        __syncthreads();
    }
    if (tid < 256) {
#pragma unroll
        for (int i = 0; i < 4; ++i) store4(ty * 4 + i, tx * 4, (f32x4){acc[i][0], acc[i][1], acc[i][2], acc[i][3]});
    }
}

__device__ __forceinline__ void dn_prep_phase(const Args& a, LAS unsigned char* lds, int tid) {
    unsigned char* ws = a.ws;
    const bf16* qkvb = (const bf16*)(ws + WS_QKVB); const float* sm = (const float*)(ws + WS_SM);
    const float* conv_w = a.in[10]; const float* a_log = a.in[11]; const float* dt_bias = a.in[12];
    bf16* qn = (bf16*)a.out; bf16* kn = qn + (size_t)T * 512; bf16* vv = kn + (size_t)T * 512;
    float* gg = (float*)(ws + WS_GG); float* bb = (float*)(ws + WS_BB);
    LAS float* red = (LAS float*)lds;
    const int h = tid >> 7, d = tid & 127, wave = tid >> 6;
    float cw[3][4];
#pragma unroll
    for (int part = 0; part < 3; ++part)
#pragma unroll
        for (int w = 0; w < 4; ++w) cw[part][w] = conv_w[w * 1536 + part * 512 + h * 128 + d];
    for (int t = blockIdx.x; t < T; t += gridDim.x) {
        const int ts = t & (SEQ - 1);
        float val[3];
#pragma unroll
        for (int part = 0; part < 3; ++part) { const int c = part * 512 + h * 128 + d; float acc = 0.f;
#pragma unroll
            for (int w = 0; w < 4; ++w) if (ts + w - 3 >= 0) acc = fmaf(cw[part][w], bf2f(qkvb[(size_t)(t + w - 3) * 1536 + c]), acc);
            val[part] = siluf_(acc); }
        float sq = val[0] * val[0], sk = val[1] * val[1];
#pragma unroll
        for (int o = 32; o > 0; o >>= 1) { sq += wshfl_xor(sq, o, tid); sk += wshfl_xor(sk, o, tid); }
        if ((tid & 63) == 0) { red[wave * 2] = sq; red[wave * 2 + 1] = sk; }
        __syncthreads();
        sq = red[(h * 2) * 2] + red[(h * 2 + 1) * 2]; sk = red[(h * 2) * 2 + 1] + red[(h * 2 + 1) * 2 + 1];
        const size_t o = (size_t)t * 512 + h * 128 + d;
        qn[o] = (bf16)f2bf(val[0] * (1.0f / sqrtf(sq + 1e-6f)));
        kn[o] = (bf16)f2bf(val[1] * (1.0f / sqrtf(sk + 1e-6f)));
        vv[o] = (bf16)f2bf(val[2]);
        if (d == 0) {
            bb[t * 4 + h] = 1.f / (1.f + expf(-sm[(size_t)t * 32 + 24 + h]));
            const float xx = sm[(size_t)t * 32 + 28 + h] + dt_bias[h];
            const float sp = (xx > 20.f) ? xx : log1pf(expf(xx));
            gg[t * 4 + h] = -expf(a_log[h]) * sp;
        }
        __syncthreads();
    }
}

__device__ __forceinline__ void cmp_gemm1_phase(const Args& a, LAS unsigned char* lds, int tid) {
    unsigned char* ws = a.ws; const bf16* kv = (const bf16*)(ws + WS_KV); bf16* hid = (bf16*)(ws + WS_HID);
    LAS float* As = (LAS float*)lds; LAS float* Bs = As + 16 * 68;
    for (int u = blockIdx.x; u < 256; u += gridDim.x) {
        const int which = u >> 7, mt = (u >> 2) & 31, nt = u & 3;
        const float* pos = a.in[3 + which]; const float* w1 = a.in[which ? 7 : 5];
        const int col0 = which * 128;
        auto la = [&](int r, int k) -> f32x4 {
            const int row = mt * 64 + r, g = row & 1, bn = row >> 1, b = bn >> 7, n = bn & 127, j = k >> 6, d = k & 63;
            const u32x2 w = *(const u32x2*)(kv + (size_t)(b * SEQ + 16 * n + j) * 768 + col0 + g * 64 + d);
            const f32x4 pv = *(const f32x4*)(pos + j * 64 + d);
            return (f32x4){bf2f(w.x & 0xffffu) + pv.x, bf2f(w.x >> 16) + pv.y, bf2f(w.y & 0xffffu) + pv.z, bf2f(w.y >> 16) + pv.w};
        };
        auto lb = [&](int k, int c) -> f32x4 { return *(const f32x4*)(w1 + (size_t)k * 256 + nt * 64 + c); };
        auto st = [&](int r, int c, f32x4 v) {
            float o[4];
#pragma unroll
            for (int e = 0; e < 4; ++e) { const float x = v[e]; o[e] = 0.5f * x * (1.f + tanhf(0.7978845608028654f * (x + 0.044715f * x * x * x))); }
            u32x2 w; w.x = pk2(o[0], o[1]); w.y = pk2(o[2], o[3]);
            *(u32x2*)(hid + ((size_t)which * 2048 + mt * 64 + r) * 256 + nt * 64 + c) = w;
        };
        sgemm_tile64(As, Bs, 2048, tid, la, lb, st);
    }
}
__device__ __forceinline__ void cmp_gemm2_phase(const Args& a, LAS unsigned char* lds, int tid) {
    unsigned char* ws = a.ws; const bf16* hid = (const bf16*)(ws + WS_HID);
    LAS float* As = (LAS float*)lds; LAS float* Bs = As + 16 * 68;
    for (int u = blockIdx.x; u < 64; u += gridDim.x) {
        const int which = u >> 5, mt = u & 31;
        const float* w2 = a.in[which ? 8 : 6]; float* outp = (float*)(ws + (which ? WS_VC : WS_KC));
        auto la = [&](int r, int k) -> f32x4 { const u32x2 w = *(const u32x2*)(hid + ((size_t)which * 2048 + mt * 64 + r) * 256 + k);
            return (f32x4){bf2f(w.x & 0xffffu), bf2f(w.x >> 16), bf2f(w.y & 0xffffu), bf2f(w.y >> 16)}; };
        auto lb = [&](int k, int c) -> f32x4 { return *(const f32x4*)(w2 + (size_t)k * 64 + c); };
        bf16* outb = (bf16*)(ws + (which ? WS_VCB : WS_KCB));
        auto st = [&](int r, int c, f32x4 v) { *(f32x4*)(outp + (size_t)(mt * 64 + r) * 64 + c) = v;
            const int row = mt * 64 + r, gg_ = row & 1, bn = row >> 1, bb_ = bn >> 7, n = bn & 127;
            u32x2 wv; wv.x = (n == 127) ? 0u : pk2(v.x, v.y); wv.y = (n == 127) ? 0u : pk2(v.z, v.w);
            *(u32x2*)(outb + ((size_t)((bb_ * 2 + gg_) * 128 + n)) * 64 + c) = wv; };
        sgemm_tile64(As, Bs, 256, tid, la, lb, st);
    }
}

template <int MODE>
__device__ __forceinline__ void attn_simple_phase(const Args& a, LAS unsigned char* lds, int tid) {
    constexpr int NK = (MODE == 0) ? 127 : 512;
    unsigned char* ws = a.ws;
    const bf16* Q = (const bf16*)(ws + WS_Q); const bf16* KV = (const bf16*)(ws + WS_KV); const float* sm = (const float*)(ws + WS_SM);
    const float* kc = (const float*)(ws + WS_KC); const float* vc = (const float*)(ws + WS_VC);
    const float* rel_bias = a.in[9];
    float* oacc = (float*)(ws + WS_OACC); u32* sel = (u32*)(ws + WS_SEL);
    const bf16* za = (const bf16*)(ws + WS_ZA); bf16* oa = (bf16*)(ws + WS_OA);
    const int sb = tid >> 8, stid = tid & 255;
    LAS float* qs = (LAS float*)(lds + sb * 12288);
    LAS float* sc = qs + 256;
    LAS int* blk = (LAS int*)(sc + 2048);
    LAS float* imp = (LAS float*)(blk + 8);
    const int NU = T * 2, G2 = gridDim.x * 2;
    for (int u0 = 0; u0 < NU; u0 += G2) {
        const int u = u0 + blockIdx.x * 2 + sb; const bool act = u < NU;
        const int t = act ? (u >> 1) : 0, g = u & 1, ts = t & (SEQ - 1), tb = t - ts;
        qs[stid] = bf2f(Q[(size_t)t * 512 + (g * 4 + (stid >> 6)) * 64 + (stid & 63)]);
        if (MODE == 1 && stid == 0) { u32 mk = sel[t * 2 + g]; int k = 0; for (int j = 0; j < 32; ++j) if ((mk >> j) & 1u) { if (k < 8) blk[k] = j; ++k; } for (; k < 8; ++k) blk[k] = 0; }
        __syncthreads();
        for (int i = stid; i < NK; i += 256) {
            int dist, kpos; bool valid; const bf16* kb = nullptr; const float* kf = nullptr;
            if (MODE == 0) { dist = ts - (16 * i + 31); valid = dist >= 0; kf = kc + (size_t)((((tb >> 11) * 128) + i) * 2 + g) * 64; }
            else if (MODE == 1) { kpos = blk[i >> 6] * 64 + (i & 63); dist = ts - kpos; valid = dist >= 0; kb = KV + (size_t)(tb + kpos) * 768 + 256 + g * 64; }
            else { kpos = ts - 511 + i; dist = 511 - i; valid = kpos >= 0; kb = KV + (size_t)(tb + (kpos < 0 ? 0 : kpos)) * 768 + 512 + g * 64; }
            float s0 = 0.f, s1 = 0.f, s2 = 0.f, s3 = 0.f;
            if (valid) {
#pragma unroll 2
                for (int d = 0; d < 64; d += 8) {
                    float kk[8];
                    if (MODE == 0) { const f32x4 k0 = *(const f32x4*)(kf + d), k1 = *(const f32x4*)(kf + d + 4); kk[0] = k0.x; kk[1] = k0.y; kk[2] = k0.z; kk[3] = k0.w; kk[4] = k1.x; kk[5] = k1.y; kk[6] = k1.z; kk[7] = k1.w; }
                    else { const u32x4 w = *(const u32x4*)(kb + d); kk[0] = bf2f(w.x & 0xffffu); kk[1] = bf2f(w.x >> 16); kk[2] = bf2f(w.y & 0xffffu); kk[3] = bf2f(w.y >> 16); kk[4] = bf2f(w.z & 0xffffu); kk[5] = bf2f(w.z >> 16); kk[6] = bf2f(w.w & 0xffffu); kk[7] = bf2f(w.w >> 16); }
#pragma unroll
                    for (int e = 0; e < 8; ++e) { s0 = fmaf(kk[e], qs[d + e], s0); s1 = fmaf(kk[e], qs[64 + d + e], s1); s2 = fmaf(kk[e], qs[128 + d + e], s2); s3 = fmaf(kk[e], qs[192 + d + e], s3); }
                }
                const float* rb = rel_bias + rel_bucket(dist) * 8 + g * 4;
                s0 += rb[0] * 1.4426950408889634f; s1 += rb[1] * 1.4426950408889634f; s2 += rb[2] * 1.4426950408889634f; s3 += rb[3] * 1.4426950408889634f;
            } else { s0 = s1 = s2 = s3 = -1e30f; }
            sc[i] = s0; sc[512 + i] = s1; sc[1024 + i] = s2; sc[1536 + i] = s3;
        }
        __syncthreads();
        {
            const int w = stid >> 6, lane = stid & 63; LAS float* row = sc + w * 512;
            float mx = -1e30f;
            for (int i = lane; i < NK; i += 64) mx = fmaxf(mx, row[i]);
#pragma unroll
            for (int o = 32; o > 0; o >>= 1) mx = fmaxf(mx, wshfl_xor(mx, o, tid));
            float sum = 0.f;
            for (int i = lane; i < NK; i += 64) { const float s = row[i]; const float e = (s > -1e29f) ? exp2f(s - mx) : 0.f; row[i] = e; sum += e; }
#pragma unroll
            for (int o = 32; o > 0; o >>= 1) sum += wshfl_xor(sum, o, tid);
            const float inv = (sum > 0.f) ? 1.f / sum : 0.f;
            for (int i = lane; i < NK; i += 64) row[i] *= inv;
        }
        __syncthreads();
        {
            const int hg = stid >> 6, d = stid & 63; const LAS float* row = sc + hg * 512;
            float acc = 0.f;
            for (int i = 0; i < NK; ++i) {
                const float p = row[i];
                if (p != 0.f) {
                    float v;
                    if (MODE == 0) v = vc[(size_t)((((tb >> 11) * 128) + i) * 2 + g) * 64 + d];
                    else if (MODE == 1) v = bf2f(KV[(size_t)(tb + blk[i >> 6] * 64 + (i & 63)) * 768 + 384 + g * 64 + d]);
                    else v = bf2f(KV[(size_t)(tb + ts - 511 + i) * 768 + 640 + g * 64 + d]);
                    acc = fmaf(p, v, acc);
                }
            }
            if (act) {
                const int h = g * 4 + hg; const size_t o = (size_t)t * 512 + h * 64 + d;
                const float gate = 1.f / (1.f + expf(-sm[(size_t)t * 32 + (MODE == 0 ? 0 : MODE == 1 ? 8 : 16) + h]));
                if (MODE == 2) oacc[o] = gate * acc;
                else if (MODE == 0) oacc[o] += gate * acc;
                else oa[o] = (bf16)f2bf((oacc[o] + gate * acc) * bf2f(za[o]));
            }
        }
        if (MODE == 0) {
            if (stid < 32) {
                const int j = stid; float s = 0.f;
                for (int n = 4 * j - 1; n <= 4 * j + 3; ++n) if (n >= 0 && n < 127) s += (sc[n] + sc[512 + n]) + (sc[1024 + n] + sc[1536 + n]);
                const int cur = ts >> 6;
                if (j == 0 || j == cur || j == cur - 1) s = 1e6f; else if (j > cur) s = -1e6f;
                imp[j] = s;
            }
            __syncthreads();
            if (stid == 0 && act) {
                u32 taken = 0u;
                for (int k = 0; k < 8; ++k) { int best = -1; float bv = 0.f;
                    for (int j = 0; j < 32; ++j) if (!((taken >> j) & 1u)) { const float x = imp[j]; if (best < 0 || x > bv) { best = j; bv = x; } }
                    taken |= 1u << best; }
                sel[t * 2 + g] = taken;
            }
        }
        __syncthreads();
    }
}

typedef float f32x16 __attribute__((ext_vector_type(16)));
typedef short s16x4 __attribute__((ext_vector_type(4)));
__device__ __forceinline__ int crow(int r, int hi) { return (r & 3) + 8 * (r >> 2) + 4 * hi; }
__device__ __forceinline__ unsigned cvtpk(float lo, float hi) { typedef float f2 __attribute__((ext_vector_type(2))); typedef __bf16 b2 __attribute__((ext_vector_type(2))); f2 v = {lo, hi}; b2 b = __builtin_convertvector(v, b2); return __builtin_bit_cast(unsigned, b); }
__device__ __forceinline__ float hswap_max(float v) { auto rr = __builtin_amdgcn_permlane32_swap(__float_as_uint(v), __float_as_uint(v), false, false); return fmaxf(__uint_as_float(rr[0]), __uint_as_float(rr[1])); }
__device__ __forceinline__ float hswap_sum(float v) { auto rr = __builtin_amdgcn_permlane32_swap(__float_as_uint(v), __float_as_uint(v), false, false); return __uint_as_float(rr[0]) + __uint_as_float(rr[1]); }
template <int MODE, bool PROBE>
__device__ __forceinline__ void attn_mfma_unit(const Args& a, LAS unsigned char* lds, int tid, int b, int g, int qt) {
    typedef short v4i16_t __attribute__((ext_vector_type(4)));
    unsigned char* ws = a.ws;
    const int lane = tid & 63, w = __builtin_amdgcn_readfirstlane(tid >> 6), r32 = lane & 31, hi = lane >> 5;
    const int hg = w >> 1, tsub = w & 1, h = g * 4 + hg;
    const int tb = b * SEQ, t0 = qt * 64, tq = t0 + tsub * 32 + r32;
    const bf16* Q = (const bf16*)(ws + WS_Q); const bf16* KV = (const bf16*)(ws + WS_KV);
    const int kcol = (MODE == 1 ? 256 : 512) + g * 64, vcol = kcol + 128;
    bf16x8 qr[4];
#pragma unroll
    for (int d0 = 0; d0 < 4; ++d0) qr[d0] = *(const bf16x8*)(Q + (size_t)(tb + tq) * 512 + h * 64 + d0 * 16 + hi * 8);
    bf16x8 oh[2];
#pragma unroll
    for (int sx = 0; sx < 2; ++sx)
#pragma unroll
        for (int j = 0; j < 8; ++j) oh[sx][j] = (16 * sx + 8 * hi + j == r32) ? (short)0x3F80 : (short)0;
    const int j0 = (MODE == 2) ? (qt > 8 ? qt - 8 : 0) : 0, j1 = qt;
    const bf16* ksrc = KV + (size_t)(tb + lane) * 768 + kcol + w * 8;
    const bf16* vsrc = KV + (size_t)(tb + 16 * (w & 3) + (lane >> 2)) * 768 + vcol + (w >> 2) * 32 + (lane & 3) * 8;
    LAS unsigned char* Kb = lds; LAS unsigned char* Vb = lds + 16384; LAS float* wsf = (LAS float*)(lds + 32768) + w * 64;
    const unsigned char* tblb = ws + WS_TBL + (size_t)((MODE == 2 ? NDI : 0) * 8 + h) * 4096 + lane * 16;
    u32 mk = 0xffffffffu; if (MODE == 1) mk = ((const u32*)(ws + WS_SEL))[(tb + tq) * 2 + g];
    u32x4 kreg = *(const u32x4*)(ksrc + (size_t)j0 * 64 * 768), vreg = *(const u32x4*)(vsrc + (size_t)j0 * 64 * 768);
    *(LAS u32x4*)(Kb + w * 1024 + lane * 16) = kreg; *(LAS u32x4*)(Vb + w * 1024 + lane * 16) = vreg;
    __syncthreads();
    float m = -1e30f, l = 0.f; f32x16 o[2];
#pragma unroll
    for (int r = 0; r < 16; ++r) { o[0][r] = 0.f; o[1][r] = 0.f; }
    const LAS unsigned char* vrd0 = Vb + ((lane >> 4) & 1) * 32 + (lane & 3) * 8 + (4 * hi + ((lane & 15) >> 2)) * 64;
    for (int jt = j0; jt <= j1; ++jt) {
        const int cur = (jt - j0) & 1;
        if (jt < j1) { kreg = *(const u32x4*)(ksrc + (size_t)(jt + 1) * 64 * 768); vreg = *(const u32x4*)(vsrc + (size_t)(jt + 1) * 64 * 768); }
        int di = 2 * (qt - jt) + tsub; if (di > NDI - 1) di = NDI - 1;
        const unsigned char* tp = tblb + (size_t)di * 32768;
        const bf16x8 tf00 = *(const bf16x8*)(tp), tf01 = *(const bf16x8*)(tp + 1024), tf10 = *(const bf16x8*)(tp + 2048), tf11 = *(const bf16x8*)(tp + 3072);
        const float cinit = (MODE == 1 && !((mk >> jt) & 1u)) ? -30000.f : 0.f;
        f32x16 p0, p1;
#pragma unroll
        for (int r = 0; r < 16; ++r) p0[r] = cinit;
        p1 = __builtin_amdgcn_mfma_f32_32x32x16_bf16(tf01, oh[0], p0, 0, 0, 0);
        p0 = __builtin_amdgcn_mfma_f32_32x32x16_bf16(tf00, oh[0], p0, 0, 0, 0);
        p0 = __builtin_amdgcn_mfma_f32_32x32x16_bf16(tf10, oh[1], p0, 0, 0, 0);
        p1 = __builtin_amdgcn_mfma_f32_32x32x16_bf16(tf11, oh[1], p1, 0, 0, 0);
        const LAS unsigned char* kb = Kb + cur * 8192 + hi * 1024 + r32 * 16;
#pragma unroll
        for (int d0 = 0; d0 < 4; ++d0) {
            const bf16x8 k0 = *(const LAS bf16x8*)(kb + d0 * 2048), k1 = *(const LAS bf16x8*)(kb + d0 * 2048 + 512);
            p0 = __builtin_amdgcn_mfma_f32_32x32x16_bf16(k0, qr[d0], p0, 0, 0, 0);
            p1 = __builtin_amdgcn_mfma_f32_32x32x16_bf16(k1, qr[d0], p1, 0, 0, 0);
        }
        float rm = fmaxf(p0[0], p1[0]);
#pragma unroll
        for (int r = 1; r < 16; ++r) rm = fmaxf(rm, fmaxf(p0[r], p1[r]));
        rm = hswap_max(rm);
        const float mn = fmaxf(m, rm);
        if (__any(mn > m)) {
            const float sc = __builtin_amdgcn_exp2f(m - mn); l *= sc; m = mn;
            if (hi == 0) wsf[r32] = sc;
            LDS_WAIT();
#pragma unroll
            for (int r = 0; r < 16; ++r) { const float f = wsf[crow(r, hi)]; o[0][r] *= f; o[1][r] *= f; }
            LDS_WAIT();
        }
        float sacc = 0.f;
#pragma unroll
        for (int r = 0; r < 16; ++r) { p0[r] = __builtin_amdgcn_exp2f(p0[r] - m); p1[r] = __builtin_amdgcn_exp2f(p1[r] - m); sacc += p0[r] + p1[r]; }
        l += sacc;
        u32x4 pw[4];
#pragma unroll
        for (int e = 0; e < 4; ++e) { pw[0][e] = cvtpk(p0[2 * e], p0[2 * e + 1]); pw[1][e] = cvtpk(p0[8 + 2 * e], p0[8 + 2 * e + 1]); pw[2][e] = cvtpk(p1[2 * e], p1[2 * e + 1]); pw[3][e] = cvtpk(p1[8 + 2 * e], p1[8 + 2 * e + 1]); }
        const LAS unsigned char* vrd = vrd0 + cur * 8192;
#pragma unroll
        for (int d0 = 0; d0 < 2; ++d0)
#pragma unroll
            for (int ks = 0; ks < 4; ++ks) {
                const s16x4 lo = __builtin_bit_cast(s16x4, __builtin_amdgcn_ds_read_tr16_b64_v4i16((LAS v4i16_t*)(vrd + d0 * 4096 + ks * 1024)));
                const s16x4 hh = __builtin_bit_cast(s16x4, __builtin_amdgcn_ds_read_tr16_b64_v4i16((LAS v4i16_t*)(vrd + d0 * 4096 + ks * 1024 + 512)));
                const bf16x8 vf = (bf16x8){lo[0], lo[1], lo[2], lo[3], hh[0], hh[1], hh[2], hh[3]};
                o[d0] = __builtin_amdgcn_mfma_f32_32x32x16_bf16(__builtin_bit_cast(bf16x8, pw[ks]), vf, o[d0], 0, 0, 0);
            }
        if (jt < j1) { *(LAS u32x4*)(Kb + (cur ^ 1) * 8192 + w * 1024 + lane * 16) = kreg; *(LAS u32x4*)(Vb + (cur ^ 1) * 8192 + w * 1024 + lane * 16) = vreg; }
        __syncthreads();
    }
    l = hswap_sum(l);
    if (hi == 0) wsf[32 + r32] = l;
    LDS_WAIT();
    const float* sm = (const float*)(ws + WS_SM); float* oacc = (float*)(ws + WS_OACC);
    const bf16* za = (const bf16*)(ws + WS_ZA); bf16* oa = (bf16*)(ws + WS_OA);
    float dmax = 0.f;
#pragma unroll
    for (int r = 0; r < 16; ++r) {
        const int qi = crow(r, hi); const size_t row = (size_t)(tb + t0 + tsub * 32 + qi);
        const float rl = __builtin_amdgcn_rcpf(wsf[32 + qi]);
        const float gate = sigm(sm[row * 32 + (MODE == 1 ? 8 : 16) + h]);
#pragma unroll
        for (int d0 = 0; d0 < 2; ++d0) { const size_t oo = row * 512 + h * 64 + d0 * 32 + r32; const float val = gate * o[d0][r] * rl;
            if (PROBE) dmax = fmaxf(dmax, (MODE == 2) ? fabsf(val - oacc[oo]) : fabsf((oacc[oo] + val) * bf2f(za[oo]) - bf2f(oa[oo])));
            else if (MODE == 2) oacc[oo] = val;
            else oa[oo] = (bf16)f2bf((oacc[oo] + val) * bf2f(za[oo])); }
    }
    LDS_WAIT();
    if (PROBE) atomicMax((unsigned*)(ws + WS_DBG), __float_as_uint(dmax));
}
template <int MODE, bool PROBE>
__device__ __forceinline__ void attn_mfma_phase(const Args& a, LAS unsigned char* lds, int tid) {
    for (int i = blockIdx.x; i < 256; i += gridDim.x) {
        const int bg = i >> 4, s = i & 15;
        attn_mfma_unit<MODE, PROBE>(a, lds, tid, bg >> 1, bg & 1, s);
        attn_mfma_unit<MODE, PROBE>(a, lds, tid, bg >> 1, bg & 1, 31 - s);
    }
}

constexpr int FA_KB = 0, FA_VB = 16384, FA_WSF = 32768, FA_SELM = 36864, FA_IMP = 37376, FA_BIAS = 70144, FA_END = 102912;
template <int MODE>
__device__ __forceinline__ void fa_branch(const unsigned char* ws, LAS unsigned char* lds, int tid, int tb, int g, int qt, int h, u32 mk, const float* smg, f32x16 (&osum)[2]) {
    typedef short v4i16_t __attribute__((ext_vector_type(4)));
    const int lane = tid & 63, w = __builtin_amdgcn_readfirstlane(tid >> 6), r32 = lane & 31, hi = lane >> 5, tsub = w & 1;
    const bf16* KV = (const bf16*)(ws + WS_KV);
    const int kcol = (MODE == 1 ? 256 : 512) + g * 64, vcol = kcol + 128;
    const int j0 = (MODE == 2) ? (qt > 8 ? qt - 8 : 0) : 0, j1 = qt;
    bf16x8 qr[4];
    { const bf16* Q = (const bf16*)(ws + WS_Q) + (size_t)(tb + qt * 64 + tsub * 32 + r32) * 512 + h * 64 + hi * 8;
#pragma unroll
      for (int d0 = 0; d0 < 4; ++d0) qr[d0] = *(const bf16x8*)(Q + d0 * 16); }
    bf16x8 oh[2];
#pragma unroll
    for (int sx = 0; sx < 2; ++sx)
#pragma unroll
        for (int j = 0; j < 8; ++j) oh[sx][j] = (16 * sx + 8 * hi + j == r32) ? (short)0x3F80 : (short)0;
    const bf16* ksrc = KV + (size_t)(tb + lane) * 768 + kcol + w * 8;
    const bf16* vsrc = KV + (size_t)(tb + 16 * (w & 3) + (lane >> 2)) * 768 + vcol + (w >> 2) * 32 + (lane & 3) * 8;
    LAS unsigned char* Kb = lds + FA_KB; LAS unsigned char* Vb = lds + FA_VB; LAS float* wsf = (LAS float*)(lds + FA_WSF) + w * 128;
    const unsigned char* tblb = ws + WS_TBL + (size_t)((MODE == 2 ? NDI : 0) * 8 + h) * 4096 + lane * 16;
    u32x4 kreg = *(const u32x4*)(ksrc + (size_t)j0 * 64 * 768), vreg = *(const u32x4*)(vsrc + (size_t)j0 * 64 * 768);
    *(LAS u32x4*)(Kb + w * 1024 + lane * 16) = kreg; *(LAS u32x4*)(Vb + w * 1024 + lane * 16) = vreg;
    __syncthreads();
    float m = -1e30f, l = 0.f; f32x16 o[2];
#pragma unroll
    for (int r = 0; r < 16; ++r) { o[0][r] = 0.f; o[1][r] = 0.f; }
    const LAS unsigned char* vrd0 = Vb + ((lane >> 4) & 1) * 32 + (lane & 3) * 8 + (4 * hi + ((lane & 15) >> 2)) * 64;
    for (int jt = j0; jt <= j1; ++jt) {
        const int cur = (jt - j0) & 1;
        if (jt < j1) { kreg = *(const u32x4*)(ksrc + (size_t)(jt + 1) * 64 * 768); vreg = *(const u32x4*)(vsrc + (size_t)(jt + 1) * 64 * 768); }
        int di = 2 * (qt - jt) + tsub; if (di > NDI - 1) di = NDI - 1;
        const unsigned char* tp = tblb + (size_t)di * 32768;
        const bf16x8 tf00 = *(const bf16x8*)(tp), tf01 = *(const bf16x8*)(tp + 1024), tf10 = *(const bf16x8*)(tp + 2048), tf11 = *(const bf16x8*)(tp + 3072);
        const float cinit = (MODE == 1 && !((mk >> jt) & 1u)) ? -30000.f : 0.f;
        f32x16 p0, p1;
#pragma unroll
        for (int r = 0; r < 16; ++r) p0[r] = cinit;
        p1 = __builtin_amdgcn_mfma_f32_32x32x16_bf16(tf01, oh[0], p0, 0, 0, 0);
        p0 = __builtin_amdgcn_mfma_f32_32x32x16_bf16(tf00, oh[0], p0, 0, 0, 0);
        p0 = __builtin_amdgcn_mfma_f32_32x32x16_bf16(tf10, oh[1], p0, 0, 0, 0);
        p1 = __builtin_amdgcn_mfma_f32_32x32x16_bf16(tf11, oh[1], p1, 0, 0, 0);
        const LAS unsigned char* kb = Kb + cur * 8192 + hi * 1024 + r32 * 16;
#pragma unroll
        for (int d0 = 0; d0 < 4; ++d0) {
            const bf16x8 k0 = *(const LAS bf16x8*)(kb + d0 * 2048), k1 = *(const LAS bf16x8*)(kb + d0 * 2048 + 512);
            p0 = __builtin_amdgcn_mfma_f32_32x32x16_bf16(k0, qr[d0], p0, 0, 0, 0);
            p1 = __builtin_amdgcn_mfma_f32_32x32x16_bf16(k1, qr[d0], p1, 0, 0, 0);
        }
        float rm = fmaxf(p0[0], p1[0]);
#pragma unroll
        for (int r = 1; r < 16; ++r) rm = fmaxf(rm, fmaxf(p0[r], p1[r]));
        rm = hswap_max(rm);
        const float mn = fmaxf(m, rm);
        if (__any(mn > m)) {
            const float sc = __builtin_amdgcn_exp2f(m - mn); l *= sc; m = mn;
            if (hi == 0) wsf[r32] = sc;
            LDS_WAIT();
#pragma unroll
            for (int r = 0; r < 16; ++r) { const float f = wsf[crow(r, hi)]; o[0][r] *= f; o[1][r] *= f; }
            LDS_WAIT();
        }
        float sacc = 0.f;
#pragma unroll
        for (int r = 0; r < 16; ++r) { p0[r] = __builtin_amdgcn_exp2f(p0[r] - m); p1[r] = __builtin_amdgcn_exp2f(p1[r] - m); sacc += p0[r] + p1[r]; }
        l += sacc;
        u32x4 pw[4];
#pragma unroll
        for (int e = 0; e < 4; ++e) { pw[0][e] = cvtpk(p0[2 * e], p0[2 * e + 1]); pw[1][e] = cvtpk(p0[8 + 2 * e], p0[8 + 2 * e + 1]); pw[2][e] = cvtpk(p1[2 * e], p1[2 * e + 1]); pw[3][e] = cvtpk(p1[8 + 2 * e], p1[8 + 2 * e + 1]); }
        const LAS unsigned char* vrd = vrd0 + cur * 8192;
#pragma unroll
        for (int d0 = 0; d0 < 2; ++d0)
#pragma unroll
            for (int ks = 0; ks < 4; ++ks) {
                const s16x4 lo = __builtin_bit_cast(s16x4, __builtin_amdgcn_ds_read_tr16_b64_v4i16((LAS v4i16_t*)(vrd + d0 * 4096 + ks * 1024)));
                const s16x4 hh = __builtin_bit_cast(s16x4, __builtin_amdgcn_ds_read_tr16_b64_v4i16((LAS v4i16_t*)(vrd + d0 * 4096 + ks * 1024 + 512)));
                const bf16x8 vf = (bf16x8){lo[0], lo[1], lo[2], lo[3], hh[0], hh[1], hh[2], hh[3]};
                o[d0] = __builtin_amdgcn_mfma_f32_32x32x16_bf16(__builtin_bit_cast(bf16x8, pw[ks]), vf, o[d0], 0, 0, 0);
            }
        if (jt < j1) { *(LAS u32x4*)(Kb + (cur ^ 1) * 8192 + w * 1024 + lane * 16) = kreg; *(LAS u32x4*)(Vb + (cur ^ 1) * 8192 + w * 1024 + lane * 16) = vreg; }
        __syncthreads();
    }
    l = hswap_sum(l);
    if (hi == 0) wsf[32 + r32] = sigm(smg[(size_t)r32 * 32]) * __builtin_amdgcn_rcpf(l);
    LDS_WAIT();
#pragma unroll
    for (int r = 0; r < 16; ++r) { const float f = wsf[32 + crow(r, hi)]; osum[0][r] = fmaf(f, o[0][r], osum[0][r]); osum[1][r] = fmaf(f, o[1][r], osum[1][r]); }
    LDS_WAIT();
}
template <int PROBE>
__device__ __forceinline__ void fused_attn_unit(const Args& a, LAS unsigned char* lds, int tid, int b, int g, int qt) {
    typedef short v4i16_t __attribute__((ext_vector_type(4)));
    unsigned char* ws = a.ws;
    const int lane = tid & 63, w = __builtin_amdgcn_readfirstlane(tid >> 6), r32 = lane & 31, hi = lane >> 5;
    const int hg = w >> 1, tsub = w & 1, h = g * 4 + hg;
    const int tb = b * SEQ, t0 = qt * 64, tq = t0 + tsub * 32 + r32;
    const bf16* Q = (const bf16*)(ws + WS_Q); const float* sm = (const float*)(ws + WS_SM);
    LAS unsigned char* Kb = lds + FA_KB; LAS unsigned char* Vb = lds + FA_VB; LAS float* wsf = (LAS float*)(lds + FA_WSF) + w * 128;
    LAS u32* selm = (LAS u32*)(lds + FA_SELM); LAS float* impb = (LAS float*)(lds + FA_IMP); const LAS float* biasL = (const LAS float*)(lds + FA_BIAS) + hg * 2048;
    f32x16 osum[2];
    {
        bf16x8 qr[4];
#pragma unroll
        for (int d0 = 0; d0 < 4; ++d0) qr[d0] = *(const bf16x8*)(Q + (size_t)(tb + tq) * 512 + h * 64 + d0 * 16 + hi * 8);
        const bf16* kcb = (const bf16*)(ws + WS_KCB) + (size_t)(b * 2 + g) * 128 * 64; const bf16* vcb = (const bf16*)(ws + WS_VCB) + (size_t)(b * 2 + g) * 128 * 64;
#pragma unroll
        for (int jt = 0; jt < 2; ++jt) {
            *(LAS u32x4*)(Kb + jt * 8192 + w * 1024 + lane * 16) = *(const u32x4*)(kcb + (size_t)(jt * 64 + lane) * 64 + w * 8);
            *(LAS u32x4*)(Vb + jt * 8192 + w * 1024 + lane * 16) = *(const u32x4*)(vcb + (size_t)(jt * 64 + 16 * (w & 3) + (lane >> 2)) * 64 + (w >> 2) * 32 + (lane & 3) * 8);
        }
        __syncthreads();
        f32x16 p[4];
#pragma unroll
        for (int t = 0; t < 4; ++t)
#pragma unroll
            for (int r = 0; r < 16; ++r) p[t][r] = 0.f;
#pragma unroll
        for (int jt = 0; jt < 2; ++jt) {
            const LAS unsigned char* kb = Kb + jt * 8192 + hi * 1024 + r32 * 16;
#pragma unroll
            for (int d0 = 0; d0 < 4; ++d0) {
                const bf16x8 k0 = *(const LAS bf16x8*)(kb + d0 * 2048), k1 = *(const LAS bf16x8*)(kb + d0 * 2048 + 512);
                p[2 * jt] = __builtin_amdgcn_mfma_f32_32x32x16_bf16(k0, qr[d0], p[2 * jt], 0, 0, 0);
                p[2 * jt + 1] = __builtin_amdgcn_mfma_f32_32x32x16_bf16(k1, qr[d0], p[2 * jt + 1], 0, 0, 0);
            }
        }
        float mx = -30000.f;
#pragma unroll
        for (int t = 0; t < 4; ++t)
#pragma unroll
            for (int r = 0; r < 16; ++r) { const int n = 32 * t + crow(r, hi); const int dist = tq - 16 * n - 31;
                const float v = (dist >= 0) ? p[t][r] + biasL[dist < 0 ? 0 : dist] : -30000.f; p[t][r] = v; mx = fmaxf(mx, v); }
        mx = fmaxf(hswap_max(mx), -10000.f);
        float l = 0.f;
#pragma unroll
        for (int t = 0; t < 4; ++t)
#pragma unroll
            for (int r = 0; r < 16; ++r) { p[t][r] = __builtin_amdgcn_exp2f(p[t][r] - mx); l += p[t][r]; }
        l = hswap_sum(l);
        const float inv = (l > 0.f) ? 1.f / l : 0.f;
#pragma unroll
        for (int t = 0; t < 4; ++t)
#pragma unroll
            for (int r = 0; r < 16; ++r) p[t][r] *= inv;
        float plast[16];
#pragma unroll
        for (int cg = 0; cg < 16; ++cg) { const float lastv = p[cg >> 2][4 * (cg & 3) + 3];
            auto rr = __builtin_amdgcn_permlane32_swap(__float_as_uint(lastv), __float_as_uint(lastv), false, false); plast[cg] = __uint_as_float(hi ? rr[0] : rr[1]); }
        LAS float* myimp = impb + (size_t)(hg * 64 + tsub * 32 + r32) * 32 + hi;
#pragma unroll
        for (int cg = 0; cg < 16; ++cg) { const int t = cg >> 2, c = cg & 3;
            const float s4 = (p[t][4 * c] + p[t][4 * c + 1]) + (p[t][4 * c + 2] + p[t][4 * c + 3]);
            const float extra = hi ? plast[cg] : (cg > 0 ? plast[cg > 0 ? cg - 1 : 0] : 0.f);
            myimp[2 * cg] = s4 + extra; }
        f32x16 o[2];
#pragma unroll
        for (int r = 0; r < 16; ++r) { o[0][r] = 0.f; o[1][r] = 0.f; }
        const LAS unsigned char* vrd0 = Vb + ((lane >> 4) & 1) * 32 + (lane & 3) * 8 + (4 * hi + ((lane & 15) >> 2)) * 64;
#pragma unroll
        for (int jt = 0; jt < 2; ++jt) {
            u32x4 pw[4];
#pragma unroll
            for (int e = 0; e < 4; ++e) { pw[0][e] = cvtpk(p[2 * jt][2 * e], p[2 * jt][2 * e + 1]); pw[1][e] = cvtpk(p[2 * jt][8 + 2 * e], p[2 * jt][8 + 2 * e + 1]);
                pw[2][e] = cvtpk(p[2 * jt + 1][2 * e], p[2 * jt + 1][2 * e + 1]); pw[3][e] = cvtpk(p[2 * jt + 1][8 + 2 * e], p[2 * jt + 1][8 + 2 * e + 1]); }
#pragma unroll
            for (int d0 = 0; d0 < 2; ++d0)
#pragma unroll
                for (int ks = 0; ks < 4; ++ks) {
                    const s16x4 lo = __builtin_bit_cast(s16x4, __builtin_amdgcn_ds_read_tr16_b64_v4i16((LAS v4i16_t*)(vrd0 + jt * 8192 + d0 * 4096 + ks * 1024)));
                    const s16x4 hh = __builtin_bit_cast(s16x4, __builtin_amdgcn_ds_read_tr16_b64_v4i16((LAS v4i16_t*)(vrd0 + jt * 8192 + d0 * 4096 + ks * 1024 + 512)));
                    const bf16x8 vf = (bf16x8){lo[0], lo[1], lo[2], lo[3], hh[0], hh[1], hh[2], hh[3]};
                    o[d0] = __builtin_amdgcn_mfma_f32_32x32x16_bf16(__builtin_bit_cast(bf16x8, pw[ks]), vf, o[d0], 0, 0, 0);
                }
        }
        if (hi == 0) wsf[64 + r32] = sigm(sm[(size_t)(tb + tq) * 32 + h]);
        LDS_WAIT();
#pragma unroll
        for (int r = 0; r < 16; ++r) { const float gt = wsf[64 + crow(r, hi)]; osum[0][r] = gt * o[0][r]; osum[1][r] = gt * o[1][r]; }
        __syncthreads();
#pragma unroll 1
        for (int it = 0; it < 4; ++it) {
            const int tok = w * 8 + it * 2 + hi, j = r32;
            float v = (impb[(size_t)(0 * 64 + tok) * 32 + j] + impb[(size_t)(1 * 64 + tok) * 32 + j]) + (impb[(size_t)(2 * 64 + tok) * 32 + j] + impb[(size_t)(3 * 64 + tok) * 32 + j]);
            if (j == 0 || j == qt || j == qt - 1) v = 1e6f; else if (j > qt) v = -1e6f;
            wsf[lane] = v;
            LDS_WAIT();
            int cnt = 0;
#pragma unroll
            for (int i = 0; i < 32; ++i) { const float vi = wsf[hi * 32 + i]; cnt += ((vi > v) || (vi == v && i < j)) ? 1 : 0; }
            const unsigned long long bal = __ballot(cnt < 8);
            if (r32 == 0) selm[tok] = (u32)(bal >> (hi * 32));
            LDS_WAIT();
        }
        __syncthreads();
    }
    u32 mk = selm[tsub * 32 + r32];
    if (PROBE != 0) { const u32 ref = ((const u32*)(ws + WS_SEL))[(tb + tq) * 2 + g];
        if (PROBE == 2 && hg == 0 && hi == 0 && ref != mk) atomicAdd((float*)(ws + WS_DBG), 100.f / 32768.f);
        mk = ref; }
    const float* smrow = sm + (size_t)(tb + t0 + tsub * 32) * 32 + h;
    { int t2 = tid; asm volatile("" : "+v"(t2)); fa_branch<2>(ws, lds, t2, tb, g, qt, h, 0xffffffffu, smrow + 16, osum); }
    { int t2 = tid; asm volatile("" : "+v"(t2)); fa_branch<1>(ws, lds, t2, tb, g, qt, h, mk, smrow + 8, osum); }
    { LAS bf16* stg = (LAS bf16*)(lds + w * 4096);
#pragma unroll
      for (int r = 0; r < 16; ++r)
#pragma unroll
          for (int d0 = 0; d0 < 2; ++d0) stg[crow(r, hi) * 64 + d0 * 32 + r32] = (bf16)f2bf(osum[d0][r]);
      LDS_WAIT();
      const bf16* za = (const bf16*)(ws + WS_ZA) + (size_t)(tb + t0 + tsub * 32 + (lane >> 3)) * 512 + h * 64 + (lane & 7) * 8;
      bf16* oa = (bf16*)(ws + WS_OA) + (size_t)(tb + t0 + tsub * 32 + (lane >> 3)) * 512 + h * 64 + (lane & 7) * 8;
      float dmax = 0.f;
#pragma unroll
      for (int i = 0; i < 4; ++i) {
          const u32x4 ov = *(const LAS u32x4*)(stg + (i * 8 + (lane >> 3)) * 64 + (lane & 7) * 8);
          const u32x4 zv = *(const u32x4*)(za + (size_t)i * 8 * 512);
          u32x4 rv;
#pragma unroll
          for (int e = 0; e < 4; ++e) rv[e] = pk2(bf2f(ov[e] & 0xffffu) * bf2f(zv[e] & 0xffffu), bf2f(ov[e] >> 16) * bf2f(zv[e] >> 16));
          if (PROBE == 0) *(u32x4*)(oa + (size_t)i * 8 * 512) = rv;
          else { const u32x4 old_ = *(const u32x4*)(oa + (size_t)i * 8 * 512);
#pragma unroll
              for (int e = 0; e < 4; ++e) { dmax = fmaxf(dmax, fabsf(bf2f(rv[e] & 0xffffu) - bf2f(old_[e] & 0xffffu))); dmax = fmaxf(dmax, fabsf(bf2f(rv[e] >> 16) - bf2f(old_[e] >> 16))); } }
      }
      if (PROBE == 1) atomicMax((unsigned*)(ws + WS_DBG), __float_as_uint(dmax));
      LDS_WAIT();
    }
    __syncthreads();
}
template <int PROBE>
__device__ __forceinline__ void fused_attn_phase(const Args& a, LAS unsigned char* lds, int tid) {
    for (int i = blockIdx.x; i < 256; i += gridDim.x) {
        const int bg = i >> 4, s = i & 15, g = bg & 1;
        LAS float* biasL = (LAS float*)(lds + FA_BIAS);
        for (int idx = tid; idx < 4 * 2048; idx += 512) biasL[idx] = a.in[9][rel_bucket(idx & 2047) * 8 + g * 4 + (idx >> 11)] * 1.4426950408889634f;
        __syncthreads();
#pragma unroll 1
        for (int uu = 0; uu < 2; ++uu) { int t2 = tid; asm volatile("" : "+v"(t2)); fused_attn_unit<PROBE>(a, lds, t2, bg >> 1, g, uu ? 31 - s : s); }
        __syncthreads();
    }
}

__device__ __forceinline__ void dn_scan_phase(const Args& a, LAS unsigned char* lds, int tid) {
    if (tid >= 64) return;
    unsigned char* ws = a.ws; const int lane = tid, kq = lane >> 4, vc = lane & 15;
    const bf16* qn = (const bf16*)a.out; const bf16* kn = qn + (size_t)T * 512; const bf16* vv = kn + (size_t)T * 512;
    const float* gg = (const float*)(ws + WS_GG); const float* bb = (const float*)(ws + WS_BB);
    float* od = (float*)(ws + WS_OD);
    LAS unsigned char* kbuf = lds; LAS unsigned char* qbuf = lds + 16384; LAS unsigned char* vbuf = lds + 32768;
    for (int u = blockIdx.x; u < 256; u += gridDim.x) {
        const int b = u >> 5, h = (u >> 3) & 3, vb = u & 7;
        float S[32];
#pragma unroll
        for (int k = 0; k < 32; ++k) S[k] = 0.f;
        for (int c = 0; c < 32; ++c) {
            const int t0 = b * SEQ + c * 64;
#pragma unroll 4
            for (int i = 0; i < 16; ++i) { const int p = i * 64 + lane, row = p >> 4, ch = p & 15;
                *(LAS u32x4*)(kbuf + row * 256 + ch * 16) = *(const u32x4*)(kn + (size_t)(t0 + row) * 512 + h * 128 + ch * 8);
                *(LAS u32x4*)(qbuf + row * 256 + ch * 16) = *(const u32x4*)(qn + (size_t)(t0 + row) * 512 + h * 128 + ch * 8); }
#pragma unroll
            for (int i = 0; i < 2; ++i) { const int p = i * 64 + lane, row = p >> 1, ch = p & 1;
                *(LAS u32x4*)(vbuf + row * 32 + ch * 16) = *(const u32x4*)(vv + (size_t)(t0 + row) * 512 + h * 128 + vb * 16 + ch * 8); }
            const float gl = gg[(t0 + lane) * 4 + h], bl = bb[(t0 + lane) * 4 + h];
            LDS_WAIT();
            for (int s = 0; s < 64; ++s) {
                const float alpha = expf(__int_as_float(__builtin_amdgcn_readlane(__float_as_int(gl), s)));
                const float beta = __int_as_float(__builtin_amdgcn_readlane(__float_as_int(bl), s));
                const float v = bf2f(*(const LAS bf16*)(vbuf + s * 32 + vc * 2));
                float kk[32];
#pragma unroll
                for (int k8 = 0; k8 < 4; ++k8) { const u32x4 w = *(const LAS u32x4*)(kbuf + s * 256 + kq * 64 + k8 * 16);
                    kk[k8 * 8 + 0] = bf2f(w.x & 0xffffu); kk[k8 * 8 + 1] = bf2f(w.x >> 16); kk[k8 * 8 + 2] = bf2f(w.y & 0xffffu); kk[k8 * 8 + 3] = bf2f(w.y >> 16);
                    kk[k8 * 8 + 4] = bf2f(w.z & 0xffffu); kk[k8 * 8 + 5] = bf2f(w.z >> 16); kk[k8 * 8 + 6] = bf2f(w.w & 0xffffu); kk[k8 * 8 + 7] = bf2f(w.w >> 16); }
                float kS = 0.f;
#pragma unroll
                for (int k = 0; k < 32; ++k) { S[k] *= alpha; kS = fmaf(kk[k], S[k], kS); }
                kS += wshfl_xor(kS, 16, tid); kS += wshfl_xor(kS, 32, tid);
                const float vn = beta * (v - kS);
                float o = 0.f;
#pragma unroll
                for (int k8 = 0; k8 < 4; ++k8) { const u32x4 wq = *(const LAS u32x4*)(qbuf + s * 256 + kq * 64 + k8 * 16);
                    const float qq[8] = {bf2f(wq.x & 0xffffu), bf2f(wq.x >> 16), bf2f(wq.y & 0xffffu), bf2f(wq.y >> 16), bf2f(wq.z & 0xffffu), bf2f(wq.z >> 16), bf2f(wq.w & 0xffffu), bf2f(wq.w >> 16)};
#pragma unroll
                    for (int e = 0; e < 8; ++e) { S[k8 * 8 + e] = fmaf(kk[k8 * 8 + e], vn, S[k8 * 8 + e]); o = fmaf(qq[e], S[k8 * 8 + e], o); } }
                o += wshfl_xor(o, 16, tid); o += wshfl_xor(o, 32, tid);
                if (kq == 0) od[(size_t)(t0 + s) * 512 + h * 128 + vb * 16 + vc] = o * 0.08838834764831845f;
            }
            LDS_WAIT();
        }
    }
}

__device__ __forceinline__ void dn_out_phase(const Args& a, LAS unsigned char* lds, int tid) {
    unsigned char* ws = a.ws; const float* od = (const float*)(ws + WS_OD); const bf16* zb = (const bf16*)(ws + WS_ZB); const float* norm_w = a.in[13];
    bf16* ob = (bf16*)a.out;
    LAS float* red = (LAS float*)lds;
    const int h = tid >> 7, d = tid & 127, wave = tid >> 6; const float nw = norm_w[d];
    for (int t = blockIdx.x; t < T; t += gridDim.x) {
        const size_t o = (size_t)t * 512 + h * 128 + d;
        const float v = od[o]; float s = v * v;
#pragma unroll
        for (int off = 32; off > 0; off >>= 1) s += wshfl_xor(s, off, tid);
        if ((tid & 63) == 0) red[wave] = s;
        __syncthreads();
        s = (red[h * 2] + red[h * 2 + 1]) * (1.f / 128.f);
        ob[o] = (bf16)f2bf(v * (1.0f / sqrtf(s + 1e-6f)) * nw * bf2f(zb[o]));
        __syncthreads();
    }
}

__device__ __forceinline__ void final_ln_phase(const Args& a, int tid) {
    const int lane = tid & 63, wave = tid >> 6; const int gw = blockIdx.x * 8 + wave, NGW = gridDim.x * 8;
    const float* ln_g = a.in[19]; const float* ln_b = a.in[20];
    f32x4 gv[4], bv[4];
#pragma unroll
    for (int j = 0; j < 4; ++j) { gv[j] = ((const f32x4*)ln_g)[lane + 64 * j]; bv[j] = ((const f32x4*)ln_b)[lane + 64 * j]; }
    for (int m = gw; m < T; m += NGW) {
        f32x4* xr = (f32x4*)(a.out + (size_t)m * 1024) + lane;
        f32x4 v[4]; float s = 0.f;
#pragma unroll
        for (int j = 0; j < 4; ++j) { v[j] = xr[64 * j]; s += (v[j].x + v[j].y) + (v[j].z + v[j].w); }
#pragma unroll
        for (int o = 1; o < 64; o <<= 1) s += wshfl_xor(s, o, tid);
        const float mean = s * (1.f / 1024.f); float s2 = 0.f;
#pragma unroll
        for (int j = 0; j < 4; ++j) { v[j] = v[j] - mean; s2 += (v[j].x * v[j].x + v[j].y * v[j].y) + (v[j].z * v[j].z + v[j].w * v[j].w); }
#pragma unroll
        for (int o = 1; o < 64; o <<= 1) s2 += wshfl_xor(s2, o, tid);
        const float rstd = 1.0f / sqrtf(s2 * (1.f / 1024.f) + 1e-5f);
#pragma unroll
        for (int j = 0; j < 4; ++j) xr[64 * j] = v[j] * rstd * gv[j] + bv[j];
    }
}

__global__ void __launch_bounds__(512, 2) mega_fwd(Args a) {
    extern __shared__ __attribute__((aligned(16))) unsigned char lds_raw[];
    LAS unsigned char* lds = (LAS unsigned char*)lds_raw;
    cg::grid_group grid = cg::this_grid();
    int tid = threadIdx.x; const int G = gridDim.x;
    unsigned char* ws = a.ws;
#ifdef PROBE_TS
    unsigned long long ts_prev = __builtin_amdgcn_s_memrealtime(); int ts_n = 0; float ts_val = 0.f;
#define STAMP() do { const unsigned long long t_ = __builtin_amdgcn_s_memrealtime(); if (ts_n == PROBE_TS) ts_val = (float)(t_ - ts_prev) * 1e-3f; ts_prev = t_; ++ts_n; } while (0)
#else
#define STAMP() do {} while (0)
#endif
#define FRESH_TID() do { tid = threadIdx.x; asm volatile("" : "+v"(tid)); } while (0)

    FRESH_TID();
    p0_prologue(a, lds, tid);
    grid.sync(); STAMP();
    { pg8::Gemm g{(const pg8::bf16_t*)(ws + WS_XB), (const pg8::bf16_t*)(ws + WS_WIN), T, 6144, 1024}; pg8::StaticOrder S; S.init(T, 6144, G, (int)blockIdx.x);
      EpiProj E{ws}; pg8::gemm_phase<EpiProj, pg8::StaticOrder, true, true>(lds, g, S, E); }
    grid.sync(); STAMP();
#if !defined(PROBE_FUSED)
    FRESH_TID(); dn_prep_phase(a, lds, tid);
    __syncthreads();
    FRESH_TID(); cmp_gemm1_phase(a, lds, tid);
    grid.sync(); STAMP();
    FRESH_TID(); cmp_gemm2_phase(a, lds, tid);
    __syncthreads();
    FRESH_TID(); dn_scan_phase(a, lds, tid);
    grid.sync(); STAMP();
    FRESH_TID(); fused_attn_phase<0>(a, lds, tid);
    __syncthreads();
    FRESH_TID(); dn_out_phase(a, lds, tid);
    grid.sync(); STAMP();
#else
    FRESH_TID(); dn_prep_phase(a, lds, tid);
    __syncthreads();
    FRESH_TID(); cmp_gemm1_phase(a, lds, tid);
    __syncthreads();
    FRESH_TID(); attn_mfma_phase<2, false>(a, lds, tid);
    grid.sync();
    FRESH_TID(); cmp_gemm2_phase(a, lds, tid);
    __syncthreads();
    FRESH_TID(); dn_scan_phase(a, lds, tid);
    grid.sync();
    FRESH_TID(); attn_simple_phase<0>(a, lds, tid);
    grid.sync();
    FRESH_TID(); attn_mfma_phase<1, false>(a, lds, tid);
    grid.sync();
    FRESH_TID(); fused_attn_phase<PROBE_FUSED>(a, lds, tid);
    __syncthreads();
    FRESH_TID(); dn_out_phase(a, lds, tid);
    grid.sync();
#endif
    { pg8::Gemm g{(const pg8::bf16_t*)(ws + WS_OA), (const pg8::bf16_t*)(ws + WS_WA), T, 1024, 512}; pg8::StaticOrder S; S.init(T, 1024, G, (int)blockIdx.x);
      EpiYA E{(const bf16*)(ws + WS_GM), (float*)(ws + WS_PARTA)}; pg8::gemm_phase<EpiYA, pg8::StaticOrder, true, true>(lds, g, S, E); }
    { pg8::Gemm g{(const pg8::bf16_t*)a.out, (const pg8::bf16_t*)(ws + WS_WB), T, 1024, 512}; pg8::StaticOrder S; S.init(T, 1024, G, (int)blockIdx.x);
      EpiYB E{(const bf16*)(ws + WS_GM), (const float*)(ws + WS_PARTA), (bf16*)(ws + WS_M)}; pg8::gemm_phase<EpiYB, pg8::StaticOrder, true, true>(lds, g, S, E); }
    grid.sync(); STAMP();
    { pg8::Gemm g{(const pg8::bf16_t*)(ws + WS_M), (const pg8::bf16_t*)(ws + WS_WOUT), T, 1024, 1024}; pg8::StaticOrder S; S.init(T, 1024, G, (int)blockIdx.x);
      EpiH E{a.in[0], (float*)(ws + WS_H), (bf16*)(ws + WS_HB)}; pg8::gemm_phase<EpiH, pg8::StaticOrder, true, true>(lds, g, S, E); }
    { pg8::Gemm g{(const pg8::bf16_t*)(ws + WS_PB), (const pg8::bf16_t*)(ws + WS_WPLE), T, 1024, 256}; pg8::StaticOrder S; S.init(T, 1024, G, (int)blockIdx.x);
      EpiPE E{(float*)(ws + WS_PE)}; pg8::gemm_phase<EpiPE, pg8::StaticOrder, true, true>(lds, g, S, E); }
    grid.sync(); STAMP();
    { pg8::Gemm g{(const pg8::bf16_t*)(ws + WS_HB), (const pg8::bf16_t*)(ws + WS_WPG), T, 1024, 1024}; pg8::StaticOrder S; S.init(T, 1024, G, (int)blockIdx.x);
      EpiGate E{(const float*)(ws + WS_H), (const float*)(ws + WS_PE), a.out}; pg8::gemm_phase<EpiGate, pg8::StaticOrder, true, true>(lds, g, S, E); }
    grid.sync(); STAMP();
    FRESH_TID(); final_ln_phase(a, tid);
#if defined(PROBE_WIN) || defined(PROBE_SEL) || defined(PROBE_FUSED)
    if (blockIdx.x == 0 && threadIdx.x == 0) a.out[0] += *(const float*)(ws + WS_DBG) * (PROBE_SCALE);
#endif
#ifdef PROBE_TS
    STAMP();
    if (blockIdx.x == 0 && threadIdx.x == 0) a.out[0] += ts_val;
#endif
}

extern "C" void kernel_launch(void* const* d_in, const int* in_sizes, int n_in, void* d_out, int out_size, void* d_ws, size_t ws_size, hipStream_t stream) {
    static int grid = 0;
    if (grid == 0) {
        if (n_in != 21 || out_size != T * DM || ws_size < WS_END) { fprintf(stderr, "kernel_launch: unexpected shapes (n_in %d out %d ws %zu)\n", n_in, out_size, ws_size); grid = -1; return; }
        int dev = 0, cus = 0, per_cu = 0;
        hipGetDevice(&dev); hipDeviceGetAttribute(&cus, hipDeviceAttributeMultiprocessorCount, dev);
        hipFuncSetAttribute((const void*)mega_fwd, hipFuncAttributeMaxDynamicSharedMemorySize, LDS_BYTES);
        hipOccupancyMaxActiveBlocksPerMultiprocessor(&per_cu, (const void*)mega_fwd, 512, LDS_BYTES);
        if (per_cu < 1) { fprintf(stderr, "kernel_launch: occupancy query says %d blocks/CU\n", per_cu); per_cu = 1; }
        grid = cus;
        (void)hipGetLastError();
    }
    if (grid < 0) return;
    Args a{};
    for (int i = 0; i < 21; ++i) a.in[i] = (const float*)d_in[i];
    a.out = (float*)d_out; a.ws = (unsigned char*)d_ws;
    void* args[] = {&a};
    hipError_t e = hipLaunchCooperativeKernel((const void*)mega_fwd, dim3(grid), dim3(512), args, LDS_BYTES, stream);
    if (e != hipSuccess) fprintf(stderr, "cooperative launch failed: %s (grid %d)\n", hipGetErrorString(e), grid);
}
```

```cpp
#include <hip/hip_runtime.h>
#include <hip/hip_cooperative_groups.h>
#include <cstdio>
#include <cstdint>
#include <cmath>
namespace cg = cooperative_groups;
namespace pg8 {
#define PG8_LAS __attribute__((address_space(3)))
typedef unsigned short bf16_t;
typedef short bf16x8 __attribute__((ext_vector_type(8)));
typedef float f32x4 __attribute__((ext_vector_type(4)));
typedef unsigned u32x4 __attribute__((ext_vector_type(4)));
constexpr int BM = 256, BK = 64, HALF = 128, HTB = HALF * BK * 2  , STAGE_BYTES = 8 * HTB, NXCD = 8, WGM = 8;

__host__ __device__ __forceinline__ int lds_byte(int r, int c) { const int st = (r >> 4) * 2 + (c >> 5), rr = r & 15, cc = c & 31, ob = rr * 64 + cc * 2; return st * 1024 + (ob ^ (((ob >> 9) & 1) << 5)); }
__host__ __device__ __forceinline__ void stage_rc(int b, int& R, int& C) { const int st = b / 1024, sb = b % 1024, swz = sb ^ (((sb >> 9) & 1) << 5); R = (st >> 1) * 16 + swz / 64; C = (st & 1) * 32 + (swz % 64) / 2; }
__host__ __device__ __forceinline__ int perm32(int rho) { const int n = rho >> 4, i = rho & 15; return 8 * (i >> 2) + 4 * n + (i & 3); }

struct Unit { int pm, pn; };
struct Gemm { const bf16_t* A; const bf16_t* Bt; int M, N, K; };

struct StaticOrder {
    int nM, nN, nwg, G, c;
    __host__ __device__ void init(int M, int N, int G_, int c_) { nM = M / BM; nN = N / BM; nwg = nM * nN; G = G_; c = c_; }
    __host__ __device__ bool next(int i, Unit& u) const {
        const long L = (long)i * G + c; if (L >= nwg) return false;
        int wgid = (int)L; { const int q = nwg / NXCD, r = nwg % NXCD, xcd = wgid % NXCD, off = wgid / NXCD; wgid = (xcd < r ? xcd * (q + 1) : r * (q + 1) + (xcd - r) * q) + off; }
        const int nig = WGM * nN, gid = wgid / nig, fm = gid * WGM, gsz = (nM - fm) < WGM ? (nM - fm) : WGM;
        u.pm = fm + ((wgid % nig) % gsz); u.pn = (wgid % nig) / gsz; return true;
    }
    __device__ __forceinline__ void a_ready(const Unit&) const {}
    __device__ __forceinline__ void done(const Unit&) const {}
};

__device__ __forceinline__ unsigned cvt_pk_bf16(float lo, float hi) { unsigned r; asm volatile("v_cvt_pk_bf16_f32 %0, %1, %2" : "=v"(r) : "v"(lo), "v"(hi)); return r; }
typedef float f32x2 __attribute__((ext_vector_type(2)));
template <class Epi, class Sched, bool ALIGN_EPI = false, bool SP2 = false>
__device__ __forceinline__ void gemm_phase(PG8_LAS unsigned char* lds, const Gemm g, const Sched& S, const Epi& E) {
    int tid_ = threadIdx.x; asm volatile("" : "+v"(tid_)); const int tid = tid_, wid = __builtin_amdgcn_readfirstlane(tid >> 6), lane = tid & 63, wr = wid >> 2, wc = wid & 3, fr = lane & 15, fq = lane >> 4;
    const int K = g.K, nt = K / BK;
    unsigned voffA[2], voffB[2];
#pragma unroll
    for (int i = 0; i < 2; ++i) { int R, C; stage_rc(tid * 16 + i * 8192, R, C); const int Rb = Epi::PERM ? ((R & ~31) + perm32(R & 31)) : R;
        voffA[i] = (unsigned)(R * K + C) * 2u; voffB[i] = (unsigned)(Rb * K + C) * 2u; }
    const size_t kstep = (size_t)(BK * 2);
    const size_t hstep = (size_t)HALF * K * 2;
    const size_t tstep = 2 * hstep;
    const unsigned ldsw = (unsigned)wid * 1024u;
    const int aoff = lds_byte(wr * 64 + fr, fq * 8), boff = lds_byte(wc * 32 + fr, fq * 8);
#define PG8_SA(b, h) (((b) * 2 + (h)) * HTB)
#define PG8_SB(b, h) ((4 + (b) * 2 + (h)) * HTB)
#define PG8_STAGE(bufoff, gbase, voff) do { _Pragma("unroll") for (int _i = 0; _i < 2; ++_i) \
        __builtin_amdgcn_global_load_lds((const unsigned*)((const char*)(gbase) + (voff)[_i]), (PG8_LAS unsigned*)(lds + (bufoff) + ldsw + _i * 8192), 16, 0, 0); } while (0)
#define PG8_LDA(dst, b, h) do { _Pragma("unroll") for (int m = 0; m < 4; ++m) _Pragma("unroll") for (int k = 0; k < 2; ++k) dst[m][k] = *(const PG8_LAS bf16x8*)(lds + PG8_SA(b, h) + aoff + m * 2048 + k * 1024); } while (0)
#define PG8_LDB(dst, b, h) do { _Pragma("unroll") for (int n = 0; n < 2; ++n) _Pragma("unroll") for (int k = 0; k < 2; ++k) dst[n][k] = *(const PG8_LAS bf16x8*)(lds + PG8_SB(b, h) + boff + n * 2048 + k * 1024); } while (0)
#define PG8_MMA(ai, bj, At, Bt) do { __builtin_amdgcn_s_setprio(1); _Pragma("unroll") for (int m = 0; m < 4; ++m) _Pragma("unroll") for (int n = 0; n < 2; ++n) _Pragma("unroll") for (int k = 0; k < 2; ++k) \
        acc[ai][bj][m][n] = __builtin_amdgcn_mfma_f32_16x16x32_bf16(Bt[n][k], At[m][k], acc[ai][bj][m][n], 0, 0, 0); __builtin_amdgcn_s_setprio(0); } while (0)
#define PG8_WAIT_V(n) asm volatile("s_waitcnt vmcnt(" #n ")" ::: "memory")
#define PG8_WAIT_L(n) asm volatile("s_waitcnt lgkmcnt(" #n ")" ::: "memory")
#define PG8_BAR __builtin_amdgcn_s_barrier()
#define PG8_SCHED __builtin_amdgcn_sched_barrier(0)
    Unit cur, nxt; int ui = 0;
    if (!S.next(0, cur)) return;
    f32x4 acc[2][2][4][2];
#pragma unroll
    for (int a = 0; a < 2; ++a)
#pragma unroll
        for (int b = 0; b < 2; ++b)
#pragma unroll
            for (int m = 0; m < 4; ++m)
#pragma unroll
                for (int n = 0; n < 2; ++n) acc[a][b][m][n] = (f32x4){0.f, 0.f, 0.f, 0.f};
    bf16x8 At[4][2], B0[2][2], B1[2][2];
    const char* cA = (const char*)g.A + (size_t)cur.pm * tstep; const char* cB = (const char*)g.Bt + (size_t)cur.pn * tstep;
    S.a_ready(cur);
    if constexpr (SP2) {
        PG8_STAGE(PG8_SB(0, 0), cB, voffB); PG8_STAGE(PG8_SB(0, 1), cB + hstep, voffB); PG8_STAGE(PG8_SA(0, 0), cA, voffA); PG8_STAGE(PG8_SA(0, 1), cA + hstep, voffA);
        if (wr == 1) PG8_BAR;
        PG8_WAIT_V(2); PG8_BAR;
        PG8_STAGE(PG8_SB(1, 0), cB + kstep, voffB); PG8_STAGE(PG8_SA(1, 0), cA + kstep, voffA); PG8_STAGE(PG8_SB(1, 1), cB + hstep + kstep, voffB);
        PG8_WAIT_V(6); PG8_BAR;
    } else {
        PG8_STAGE(PG8_SB(0, 0), cB, voffB); PG8_STAGE(PG8_SA(0, 0), cA, voffA); PG8_STAGE(PG8_SB(0, 1), cB + hstep, voffB); PG8_STAGE(PG8_SA(0, 1), cA + hstep, voffA);
        if (wr == 1) PG8_BAR;
        PG8_WAIT_V(4); PG8_BAR;
        PG8_STAGE(PG8_SB(1, 0), cB + kstep, voffB); PG8_STAGE(PG8_SA(1, 0), cA + kstep, voffA); PG8_STAGE(PG8_SB(1, 1), cB + hstep + kstep, voffB);
        PG8_WAIT_V(6); PG8_BAR;
    }
    for (;;) {
        const bool has_next = S.next(ui + 1, nxt);
        const char* nA = has_next ? (const char*)g.A + (size_t)nxt.pm * tstep : cA; const char* nB = has_next ? (const char*)g.Bt + (size_t)nxt.pn * tstep : cB;
        for (int t = 0; t < nt; t += 2) {
            const bool last = (t == nt - 2);
            const char* a1 = cA + (size_t)(t + 1) * kstep;
            const char* a2 = last ? nA : cA + (size_t)(t + 2) * kstep; const char* b2 = last ? nB : cB + (size_t)(t + 2) * kstep;
            const char* a3 = a2 + kstep; const char* b3 = b2 + kstep;
            if (last && has_next) S.a_ready(nxt);
            if constexpr (SP2) {
            PG8_LDB(B0, 0, 0); PG8_LDB(B1, 0, 1); PG8_SCHED; PG8_LDA(At, 0, 0); PG8_STAGE(PG8_SA(1, 1), a1 + hstep, voffA);
            PG8_WAIT_V(8); PG8_WAIT_L(0); PG8_BAR; PG8_MMA(0, 0, At, B0); PG8_MMA(0, 1, At, B1); PG8_BAR; PG8_SCHED;
            PG8_LDA(At, 0, 1); PG8_STAGE(PG8_SB(0, 0), b2, voffB); PG8_STAGE(PG8_SB(0, 1), b2 + hstep, voffB); PG8_STAGE(PG8_SA(0, 0), a2, voffA);
            PG8_WAIT_V(8); PG8_WAIT_L(0); PG8_BAR; PG8_MMA(1, 0, At, B0); PG8_MMA(1, 1, At, B1); PG8_BAR; PG8_SCHED;
            PG8_LDB(B0, 1, 0); PG8_LDB(B1, 1, 1); PG8_SCHED; PG8_LDA(At, 1, 0); PG8_STAGE(PG8_SA(0, 1), a2 + hstep, voffA);
            PG8_WAIT_V(8); PG8_WAIT_L(0); PG8_BAR; PG8_MMA(0, 0, At, B0); PG8_MMA(0, 1, At, B1); PG8_BAR; PG8_SCHED;
            PG8_LDA(At, 1, 1); PG8_STAGE(PG8_SB(1, 0), b3, voffB); PG8_STAGE(PG8_SB(1, 1), b3 + hstep, voffB); PG8_STAGE(PG8_SA(1, 0), a3, voffA);
            PG8_WAIT_V(8); PG8_WAIT_L(0); PG8_BAR; PG8_MMA(1, 0, At, B0); PG8_MMA(1, 1, At, B1); PG8_BAR; PG8_SCHED;
            } else {
            PG8_LDB(B0, 0, 0); PG8_SCHED; PG8_LDA(At, 0, 0); PG8_STAGE(PG8_SA(1, 1), a1 + hstep, voffA);
            PG8_WAIT_L(8); PG8_BAR; PG8_WAIT_L(0); PG8_MMA(0, 0, At, B0); PG8_BAR; PG8_SCHED;
            PG8_LDB(B1, 0, 1); PG8_STAGE(PG8_SB(0, 0), b2, voffB);
            PG8_BAR; PG8_WAIT_L(0); PG8_MMA(0, 1, At, B1); PG8_BAR;
            PG8_LDA(At, 0, 1); PG8_STAGE(PG8_SA(0, 0), a2, voffA);
            PG8_BAR; PG8_WAIT_L(0); PG8_MMA(1, 0, At, B0); PG8_BAR; PG8_SCHED;
            PG8_STAGE(PG8_SB(0, 1), b2 + hstep, voffB);
            PG8_WAIT_V(6); PG8_BAR; PG8_MMA(1, 1, At, B1); PG8_BAR;
            PG8_LDB(B0, 1, 0); PG8_SCHED; PG8_LDA(At, 1, 0); PG8_STAGE(PG8_SA(0, 1), a2 + hstep, voffA);
            PG8_WAIT_L(8); PG8_BAR; PG8_WAIT_L(0); PG8_MMA(0, 0, At, B0); PG8_BAR; PG8_SCHED;
            PG8_LDB(B1, 1, 1); PG8_STAGE(PG8_SB(1, 0), b3, voffB);
            PG8_BAR; PG8_WAIT_L(0); PG8_MMA(0, 1, At, B1); PG8_BAR;
            PG8_LDA(At, 1, 1); PG8_STAGE(PG8_SA(1, 0), a3, voffA);
            PG8_BAR; PG8_WAIT_L(0); PG8_MMA(1, 0, At, B0); PG8_BAR; PG8_SCHED;
            PG8_STAGE(PG8_SB(1, 1), b3 + hstep, voffB);
            PG8_WAIT_V(6); PG8_BAR; PG8_MMA(1, 1, At, B1); PG8_BAR;
            }
        }
        if constexpr (ALIGN_EPI) { if (wr == 0) PG8_BAR; }
        if constexpr (!Epi::AFTER_DRAIN) { E(acc, cur, wr, wc, fr, fq); S.done(cur); }
        if (!has_next) break;
#pragma unroll
        for (int a = 0; a < 2; ++a)
#pragma unroll
            for (int b = 0; b < 2; ++b)
#pragma unroll
                for (int m = 0; m < 4; ++m)
#pragma unroll
                    for (int n = 0; n < 2; ++n) acc[a][b][m][n] = (f32x4){0.f, 0.f, 0.f, 0.f};
        cur = nxt; cA = nA; cB = nB; ++ui;
        if constexpr (ALIGN_EPI) { if (wr == 1) PG8_BAR; }
    }
    PG8_WAIT_V(0);
    if constexpr (!ALIGN_EPI) { if (wr == 0) PG8_BAR; }
    PG8_BAR;
    if constexpr (Epi::AFTER_DRAIN) { E.fused(acc, cur, wr, wc, fr, fq, lds, wid, lane); S.done(cur); }
#undef PG8_SA
#undef PG8_SB
#undef PG8_STAGE
#undef PG8_LDA
#undef PG8_LDB
#undef PG8_MMA
#undef PG8_WAIT_V
#undef PG8_WAIT_L
#undef PG8_BAR
#undef PG8_SCHED
}
}

constexpr int T = 16384, SEQ = 2048, DM = 1024;
constexpr float ALPHA = 1.189207115002721f;
typedef unsigned short bf16;
typedef unsigned u32;
typedef unsigned u32x4 __attribute__((ext_vector_type(4)));
typedef unsigned u32x2 __attribute__((ext_vector_type(2)));
typedef float f32x4 __attribute__((ext_vector_type(4)));
typedef short bf16x8 __attribute__((ext_vector_type(8)));
#define LAS __attribute__((address_space(3)))
constexpr size_t MiB = (size_t)1 << 20;
constexpr size_t WS_WIN = 1 * MiB, WS_W1K = 13 * MiB, WS_W1V = 14 * MiB, WS_WA = 15 * MiB, WS_WB = 16 * MiB, WS_WOUT = 17 * MiB, WS_WPG = 19 * MiB, WS_WPLE = 21 * MiB;
constexpr size_t WS_PB = 22 * MiB, WS_SM = 30 * MiB, WS_XB = 32 * MiB, WS_Q = 64 * MiB, WS_KV = 80 * MiB, WS_ZA = 104 * MiB, WS_QKVB = 120 * MiB, WS_ZB = 168 * MiB, WS_GM = 184 * MiB;
constexpr size_t WS_HID = 248 * MiB, WS_KC = 250 * MiB, WS_VC = 250 * MiB + 512 * 1024, WS_SEL = 251 * MiB, WS_GG = 251 * MiB + 256 * 1024, WS_BB = 251 * MiB + 512 * 1024, WS_TBL = 252 * MiB, WS_DBG = 254 * MiB, WS_KCB = 254 * MiB + 65536, WS_VCB = 254 * MiB + 65536 + 262144, WS_END = 255 * MiB;
constexpr size_t WS_OACC = WS_XB, WS_OD = WS_QKVB, WS_OA = WS_QKVB + 32 * MiB, WS_PARTA = 32 * MiB, WS_M = 96 * MiB, WS_H = 32 * MiB, WS_HB = 128 * MiB, WS_PE = 184 * MiB;
constexpr int LDS_BYTES = 147456;
constexpr int NDI = 28;

__device__ __forceinline__ float bf2f(unsigned v) { return __uint_as_float(v << 16); }
__device__ __forceinline__ unsigned f2bf(float f) { unsigned u = __float_as_uint(f); return (u + 0x7fffu + ((u >> 16) & 1u)) >> 16; }
__device__ __forceinline__ unsigned pk2(float lo, float hi) { return f2bf(lo) | (f2bf(hi) << 16); }
__device__ __forceinline__ float fexp(float x) { return __builtin_amdgcn_exp2f(x * 1.4426950408889634f); }
__device__ __forceinline__ float sigm(float x) { return __builtin_amdgcn_rcpf(1.f + fexp(-x)); }
__device__ __forceinline__ float siluf_(float x) { return x * sigm(x); }
__device__ __forceinline__ int rel_bucket(int n) {
    if (n < 16) return n < 0 ? 0 : n;
    return 16 + (n >= 21) + (n >= 27) + (n >= 35) + (n >= 46) + (n >= 59) + (n >= 77) + (n >= 99) + (n >= 128) + (n >= 166) + (n >= 216) + (n >= 280) + (n >= 363) + (n >= 470) + (n >= 609) + (n >= 790);
}
#define LDS_WAIT() asm volatile("s_waitcnt lgkmcnt(0)" ::: "memory")
__device__ __forceinline__ float wshfl_xor(float v, int o, int tid) { return __int_as_float(__builtin_amdgcn_ds_bpermute(((tid ^ o) & 63) << 2, __float_as_int(v))); }

#if defined(PROBE_FUSED)
#define PROBE_SCALE ((PROBE_FUSED) == 2 ? 1.f : 1000.f)
#else
#define PROBE_SCALE 1000.f
#endif
struct Args { const float* in[21]; float* out; unsigned char* ws; };

__device__ __forceinline__ int win_srccol(int r) {
    if (r < 1280) return r;
    if (r < 3328) return r + 24;
    if (r < 5888) return r + 32;
    if (r < 5912) return 1280 + (r - 5888);
    if (r < 5916) return 3352 + (r - 5912);
    if (r < 5920) return 3356 + (r - 5916);
    return -1;
}
template <bool REMAP>
__device__ __forceinline__ void transpose_item(const float* __restrict__ W, int K, int N, bf16* __restrict__ WT, LAS float* scr, int k0, int n0, int lane) {
    const int sc = REMAP ? win_srccol(n0 + (lane & 31)) : n0 + (lane & 31);
#pragma unroll 8
    for (int i = 0; i < 32; ++i) { const int kk = 2 * i + (lane >> 5); scr[kk * 33 + (lane & 31)] = (sc >= 0) ? W[(size_t)(k0 + kk) * N + sc] : 0.f; }
    LDS_WAIT();
    const int c = lane & 7;
#pragma unroll
    for (int j = 0; j < 4; ++j) { const int n = (lane >> 3) + 8 * j; const LAS float* s = scr + (8 * c) * 33 + n;
        u32x4 o; o.x = pk2(s[0 * 33], s[1 * 33]); o.y = pk2(s[2 * 33], s[3 * 33]); o.z = pk2(s[4 * 33], s[5 * 33]); o.w = pk2(s[6 * 33], s[7 * 33]);
        *(u32x4*)(WT + (size_t)(n0 + n) * K + k0 + 8 * c) = o; }
    LDS_WAIT();
}
__device__ __forceinline__ void p0_prologue(const Args& a, LAS unsigned char* lds, int tid) {
    const int lane = tid & 63, wave = tid >> 6;
    LAS float* scr = (LAS float*)(lds + wave * 8704);
    const int gw = blockIdx.x * 8 + wave, NGW = gridDim.x * 8;
    unsigned char* ws = a.ws;
    constexpr int I_WIN = 16 * 192, I_W1 = 32 * 8, I_WAB = 8 * 32, I_WSQ = 16 * 32, I_WPLE = 4 * 32;
    constexpr int NITEMS = I_WIN + 2 * I_W1 + 2 * I_WAB + 2 * I_WSQ + I_WPLE;
    for (int it = gw; it < NITEMS; it += NGW) {
        int r = it;
        if (r < I_WIN) { transpose_item<true>(a.in[2], 1024, 5920, (bf16*)(ws + WS_WIN), scr, (r / 192) * 64, (r % 192) * 32, lane); continue; } r -= I_WIN;
        if (r < I_W1) { transpose_item<false>(a.in[5], 2048, 256, (bf16*)(ws + WS_W1K), scr, (r / 8) * 64, (r % 8) * 32, lane); continue; } r -= I_W1;
        if (r < I_W1) { transpose_item<false>(a.in[7], 2048, 256, (bf16*)(ws + WS_W1V), scr, (r / 8) * 64, (r % 8) * 32, lane); continue; } r -= I_W1;
        if (r < I_WAB) { transpose_item<false>(a.in[14], 512, 1024, (bf16*)(ws + WS_WA), scr, (r / 32) * 64, (r % 32) * 32, lane); continue; } r -= I_WAB;
        if (r < I_WAB) { transpose_item<false>(a.in[15], 512, 1024, (bf16*)(ws + WS_WB), scr, (r / 32) * 64, (r % 32) * 32, lane); continue; } r -= I_WAB;
        if (r < I_WSQ) { transpose_item<false>(a.in[16], 1024, 1024, (bf16*)(ws + WS_WOUT), scr, (r / 32) * 64, (r % 32) * 32, lane); continue; } r -= I_WSQ;
        if (r < I_WSQ) { transpose_item<false>(a.in[18], 1024, 1024, (bf16*)(ws + WS_WPG), scr, (r / 32) * 64, (r % 32) * 32, lane); continue; } r -= I_WSQ;
        transpose_item<false>(a.in[17], 256, 1024, (bf16*)(ws + WS_WPLE), scr, (r / 32) * 64, (r % 32) * 32, lane);
    }
    const float* x = a.in[0]; bf16* xb = (bf16*)(ws + WS_XB);
    for (int m = gw; m < T; m += NGW) {
        const f32x4* xr = (const f32x4*)(x + (size_t)m * 1024) + lane; u32x2* o = (u32x2*)(xb + (size_t)m * 1024) + lane;
#pragma unroll
        for (int j = 0; j < 4; ++j) { const f32x4 v = xr[64 * j]; u32x2 w; w.x = pk2(v.x, v.y); w.y = pk2(v.z, v.w); o[64 * j] = w; }
    }
    const float* p = a.in[1]; bf16* pb = (bf16*)(ws + WS_PB);
    for (int m = gw; m < T; m += NGW) {
        const f32x4 v = ((const f32x4*)(p + (size_t)m * 256))[lane]; u32x2 w; w.x = pk2(v.x, v.y); w.y = pk2(v.z, v.w); ((u32x2*)(pb + (size_t)m * 256))[lane] = w;
    }
    { const float* rel_bias = a.in[9]; bf16* tbl = (bf16*)(ws + WS_TBL);
      for (int idx = blockIdx.x * 512 + tid; idx < 2 * NDI * 8 * 2 * 2 * 64 * 8; idx += gridDim.x * 512) {
          const int j = idx & 7, ln = (idx >> 3) & 63, half = (idx >> 9) & 1, sx = (idx >> 10) & 1, h = (idx >> 11) & 7, rest = idx >> 14, di = rest % NDI, type = rest / NDI;
          const int kj = 32 * half + (ln & 31), qi = 16 * sx + 8 * (ln >> 5) + j, dist = 32 * di + qi - kj;
          const float v = (dist < 0 || (type == 1 && dist >= 512)) ? -30000.f : rel_bias[rel_bucket(dist) * 8 + h] * 1.4426950408889634f;
          tbl[idx] = (bf16)f2bf(v); } }
    if (blockIdx.x == 0 && tid == 0) *(float*)(ws + WS_DBG) = 0.f;
}

struct EpiProj {
    static constexpr bool PERM = true, AFTER_DRAIN = false;
    unsigned char* ws;
    __device__ __forceinline__ void operator()(const pg8::f32x4 (&acc)[2][2][4][2], const pg8::Unit& u, int wr, int wc, int fr, int fq) const {
        const int pn = u.pn; const int row0 = u.pm * 256 + wr * 64 + fr;
        if (pn == 23) {
            if (wc == 0) { float* sm = (float*)(ws + WS_SM);
#pragma unroll
                for (int ai = 0; ai < 2; ++ai)
#pragma unroll
                    for (int m = 0; m < 4; ++m) { float* o = sm + (size_t)(row0 + ai * 128 + m * 16) * 32 + 8 * fq; *(f32x4*)o = acc[ai][0][m][0]; *(f32x4*)(o + 4) = acc[ai][0][m][1]; } }
            return;
        }
        int kind, ldc, colt; size_t boff;
        if (pn < 2) { kind = 1; boff = WS_Q; ldc = 512; colt = pn * 256; }
        else if (pn < 5) { kind = 0; boff = WS_KV; ldc = 768; colt = (pn - 2) * 256; }
        else if (pn < 7) { kind = 2; boff = WS_ZA; ldc = 512; colt = (pn - 5) * 256; }
        else if (pn < 13) { kind = 0; boff = WS_QKVB; ldc = 1536; colt = (pn - 7) * 256; }
        else if (pn < 15) { kind = 2; boff = WS_ZB; ldc = 512; colt = (pn - 13) * 256; }
        else { kind = 3; boff = WS_GM; ldc = 2048; colt = (pn - 15) * 256; }
        bf16* base = (bf16*)(ws + boff); const int col0 = colt + wc * 32 + 8 * fq;
#pragma unroll
        for (int ai = 0; ai < 2; ++ai)
#pragma unroll
            for (int m = 0; m < 4; ++m) { bf16* rowp = base + (size_t)(row0 + ai * 128 + m * 16) * ldc + col0;
#pragma unroll
                for (int bj = 0; bj < 2; ++bj) { float v[8];
#pragma unroll
                    for (int e = 0; e < 4; ++e) { v[e] = acc[ai][bj][m][0][e]; v[4 + e] = acc[ai][bj][m][1][e]; }
                    if (kind == 1) {
#pragma unroll
                        for (int e = 0; e < 8; ++e) v[e] *= 0.18033688011112042f;
                    } else if (kind == 2) {
#pragma unroll
                        for (int e = 0; e < 8; ++e) v[e] = siluf_(v[e]);
                    } else if (kind == 3) {
#pragma unroll
                        for (int e = 0; e < 8; ++e) v[e] = sigm(v[e]);
                    }
                    u32x4 w; w.x = pk2(v[0], v[1]); w.y = pk2(v[2], v[3]); w.z = pk2(v[4], v[5]); w.w = pk2(v[6], v[7]);
                    *(u32x4*)(rowp + bj * 128) = w; } }
    }
};
struct EpiYA {
    static constexpr bool PERM = true, AFTER_DRAIN = false;
    const bf16* gm; float* part;
    __device__ __forceinline__ void operator()(const pg8::f32x4 (&acc)[2][2][4][2], const pg8::Unit& u, int wr, int wc, int fr, int fq) const {
        const int row0 = u.pm * 256 + wr * 64 + fr, col0 = u.pn * 256 + wc * 32 + 8 * fq;
#pragma unroll
        for (int ai = 0; ai < 2; ++ai)
#pragma unroll
            for (int m = 0; m < 4; ++m)
#pragma unroll
                for (int bj = 0; bj < 2; ++bj) { const size_t r = row0 + ai * 128 + m * 16; const int c = col0 + bj * 128;
                    const u32x4 g = *(const u32x4*)(gm + r * 2048 + c);
                    f32x4 o0, o1;
                    o0.x = acc[ai][bj][m][0].x * bf2f(g.x & 0xffffu); o0.y = acc[ai][bj][m][0].y * bf2f(g.x >> 16); o0.z = acc[ai][bj][m][0].z * bf2f(g.y & 0xffffu); o0.w = acc[ai][bj][m][0].w * bf2f(g.y >> 16);
                    o1.x = acc[ai][bj][m][1].x * bf2f(g.z & 0xffffu); o1.y = acc[ai][bj][m][1].y * bf2f(g.z >> 16); o1.z = acc[ai][bj][m][1].z * bf2f(g.w & 0xffffu); o1.w = acc[ai][bj][m][1].w * bf2f(g.w >> 16);
                    float* o = part + r * 1024 + c; *(f32x4*)o = o0; *(f32x4*)(o + 4) = o1; }
    }
};
struct EpiYB {
    static constexpr bool PERM = true, AFTER_DRAIN = false;
    const bf16* gm; const float* part; bf16* mo;
    __device__ __forceinline__ void operator()(const pg8::f32x4 (&acc)[2][2][4][2], const pg8::Unit& u, int wr, int wc, int fr, int fq) const {
        const int row0 = u.pm * 256 + wr * 64 + fr, col0 = u.pn * 256 + wc * 32 + 8 * fq;
#pragma unroll
        for (int ai = 0; ai < 2; ++ai)
#pragma unroll
            for (int m = 0; m < 4; ++m)
#pragma unroll
                for (int bj = 0; bj < 2; ++bj) { const size_t r = row0 + ai * 128 + m * 16; const int c = col0 + bj * 128;
                    const u32x4 g = *(const u32x4*)(gm + r * 2048 + 1024 + c);
                    const float* pp = part + r * 1024 + c; const f32x4 p0 = *(const f32x4*)pp, p1 = *(const f32x4*)(pp + 4);
                    f32x4 o0, o1;
                    o0.x = p0.x + acc[ai][bj][m][0].x * bf2f(g.x & 0xffffu); o0.y = p0.y + acc[ai][bj][m][0].y * bf2f(g.x >> 16); o0.z = p0.z + acc[ai][bj][m][0].z * bf2f(g.y & 0xffffu); o0.w = p0.w + acc[ai][bj][m][0].w * bf2f(g.y >> 16);
                    o1.x = p1.x + acc[ai][bj][m][1].x * bf2f(g.z & 0xffffu); o1.y = p1.y + acc[ai][bj][m][1].y * bf2f(g.z >> 16); o1.z = p1.z + acc[ai][bj][m][1].z * bf2f(g.w & 0xffffu); o1.w = p1.w + acc[ai][bj][m][1].w * bf2f(g.w >> 16);
                    u32x4 w; w.x = pk2(o0.x, o0.y); w.y = pk2(o0.z, o0.w); w.z = pk2(o1.x, o1.y); w.w = pk2(o1.z, o1.w);
                    *(u32x4*)(mo + r * 1024 + c) = w; }
    }
};
struct EpiH {
    static constexpr bool PERM = true, AFTER_DRAIN = false;
    const float* x; float* h; bf16* hb;
    __device__ __forceinline__ void operator()(const pg8::f32x4 (&acc)[2][2][4][2], const pg8::Unit& u, int wr, int wc, int fr, int fq) const {
        const int row0 = u.pm * 256 + wr * 64 + fr, col0 = u.pn * 256 + wc * 32 + 8 * fq;
#pragma unroll
        for (int ai = 0; ai < 2; ++ai)
#pragma unroll
            for (int m = 0; m < 4; ++m)
#pragma unroll
                for (int bj = 0; bj < 2; ++bj) { const size_t off = (size_t)(row0 + ai * 128 + m * 16) * 1024 + col0 + bj * 128;
                    const f32x4 x0 = *(const f32x4*)(x + off), x1 = *(const f32x4*)(x + off + 4);
                    const f32x4 o0 = x0 * ALPHA + acc[ai][bj][m][0], o1 = x1 * ALPHA + acc[ai][bj][m][1];
                    *(f32x4*)(h + off) = o0; *(f32x4*)(h + off + 4) = o1;
                    u32x4 w; w.x = pk2(o0.x, o0.y); w.y = pk2(o0.z, o0.w); w.z = pk2(o1.x, o1.y); w.w = pk2(o1.z, o1.w);
                    *(u32x4*)(hb + off) = w; }
    }
};
struct EpiPE {
    static constexpr bool PERM = true, AFTER_DRAIN = false;
    float* pe;
    __device__ __forceinline__ void operator()(const pg8::f32x4 (&acc)[2][2][4][2], const pg8::Unit& u, int wr, int wc, int fr, int fq) const {
        const int row0 = u.pm * 256 + wr * 64 + fr, col0 = u.pn * 256 + wc * 32 + 8 * fq;
#pragma unroll
        for (int ai = 0; ai < 2; ++ai)
#pragma unroll
            for (int m = 0; m < 4; ++m)
#pragma unroll
                for (int bj = 0; bj < 2; ++bj) { const size_t off = (size_t)(row0 + ai * 128 + m * 16) * 1024 + col0 + bj * 128;
                    *(f32x4*)(pe + off) = acc[ai][bj][m][0]; *(f32x4*)(pe + off + 4) = acc[ai][bj][m][1]; }
    }
};
struct EpiGate {
    static constexpr bool PERM = true, AFTER_DRAIN = false;
    const float* h; const float* pe; float* out;
    __device__ __forceinline__ void operator()(const pg8::f32x4 (&acc)[2][2][4][2], const pg8::Unit& u, int wr, int wc, int fr, int fq) const {
        const int row0 = u.pm * 256 + wr * 64 + fr, col0 = u.pn * 256 + wc * 32 + 8 * fq;
#pragma unroll
        for (int ai = 0; ai < 2; ++ai)
#pragma unroll
            for (int m = 0; m < 4; ++m)
#pragma unroll
                for (int bj = 0; bj < 2; ++bj) { const size_t off = (size_t)(row0 + ai * 128 + m * 16) * 1024 + col0 + bj * 128;
                    const f32x4 h0 = *(const f32x4*)(h + off), h1 = *(const f32x4*)(h + off + 4), p0 = *(const f32x4*)(pe + off), p1 = *(const f32x4*)(pe + off + 4);
                    f32x4 o0, o1;
                    o0.x = h0.x + sigm(acc[ai][bj][m][0].x) * p0.x; o0.y = h0.y + sigm(acc[ai][bj][m][0].y) * p0.y; o0.z = h0.z + sigm(acc[ai][bj][m][0].z) * p0.z; o0.w = h0.w + sigm(acc[ai][bj][m][0].w) * p0.w;
                    o1.x = h1.x + sigm(acc[ai][bj][m][1].x) * p1.x; o1.y = h1.y + sigm(acc[ai][bj][m][1].y) * p1.y; o1.z = h1.z + sigm(acc[ai][bj][m][1].z) * p1.z; o1.w = h1.w + sigm(acc[ai][bj][m][1].w) * p1.w;
                    *(f32x4*)(out + off) = o0; *(f32x4*)(out + off + 4) = o1; }
    }
};

template <class LA, class LB, class ST>
__device__ __forceinline__ void sgemm_tile64(LAS float* As, LAS float* Bs, int K, int tid, LA loadA4, LB loadB4, ST store4) {
    const int tx = tid & 15, ty = (tid >> 4) & 15;
    float acc[4][4];
#pragma unroll
    for (int i = 0; i < 4; ++i)
#pragma unroll
        for (int j = 0; j < 4; ++j) acc[i][j] = 0.f;
    const int arow = (tid >> 2) & 63, akq = (tid & 3) * 4, bk = (tid >> 4) & 15, bnq = (tid & 15) * 4;
    for (int k0 = 0; k0 < K; k0 += 16) {
        if (tid < 256) {
            const f32x4 av = loadA4(arow, k0 + akq), bv = loadB4(k0 + bk, bnq);
            As[(akq + 0) * 68 + arow] = av.x; As[(akq + 1) * 68 + arow] = av.y; As[(akq + 2) * 68 + arow] = av.z; As[(akq + 3) * 68 + arow] = av.w;
            *(LAS f32x4*)&Bs[bk * 68 + bnq] = bv;
        }
        __syncthreads();
        if (tid < 256) {
#pragma unroll
            for (int k = 0; k < 16; ++k) {
                const f32x4 av = *(const LAS f32x4*)&As[k * 68 + ty * 4], bv = *(const LAS f32x4*)&Bs[k * 68 + tx * 4];
#pragma unroll
                for (int i = 0; i < 4; ++i)
#pragma unroll
                    for (int j = 0; j < 4; ++j) acc[i][j] = fmaf(av[i], bv[j], acc[i][j]);
            }
        }
        __syncthreads();
    }
    if (tid < 256) {
#pragma unroll
        for (int i = 0; i < 4; ++i) store4(ty * 4 + i, tx * 4, (f32x4){acc[i][0], acc[i][1], acc[i][2], acc[i][3]});
    }
}

__device__ __forceinline__ void dn_prep_phase(const Args& a, LAS unsigned char* lds, int tid) {
    unsigned char* ws = a.ws;
    const bf16* qkvb = (const bf16*)(ws + WS_QKVB); const float* sm = (const float*)(ws + WS_SM);
    const float* conv_w = a.in[10]; const float* a_log = a.in[11]; const float* dt_bias = a.in[12];
    bf16* qn = (bf16*)a.out; bf16* kn = qn + (size_t)T * 512; bf16* vv = kn + (size_t)T * 512;
    float* gg = (float*)(ws + WS_GG); float* bb = (float*)(ws + WS_BB);
    LAS float* red = (LAS float*)lds;
    const int h = tid >> 7, d = tid & 127, wave = tid >> 6;
    float cw[3][4];
#pragma unroll
    for (int part = 0; part < 3; ++part)
#pragma unroll
        for (int w = 0; w < 4; ++w) cw[part][w] = conv_w[w * 1536 + part * 512 + h * 128 + d];
    for (int t = blockIdx.x; t < T; t += gridDim.x) {
        const int ts = t & (SEQ - 1);
        float val[3];
#pragma unroll
        for (int part = 0; part < 3; ++part) { const int c = part * 512 + h * 128 + d; float acc = 0.f;
#pragma unroll
            for (int w = 0; w < 4; ++w) if (ts + w - 3 >= 0) acc = fmaf(cw[part][w], bf2f(qkvb[(size_t)(t + w - 3) * 1536 + c]), acc);
            val[part] = siluf_(acc); }
        float sq = val[0] * val[0], sk = val[1] * val[1];
#pragma unroll
        for (int o = 32; o > 0; o >>= 1) { sq += wshfl_xor(sq, o, tid); sk += wshfl_xor(sk, o, tid); }
        if ((tid & 63) == 0) { red[wave * 2] = sq; red[wave * 2 + 1] = sk; }
        __syncthreads();
        sq = red[(h * 2) * 2] + red[(h * 2 + 1) * 2]; sk = red[(h * 2) * 2 + 1] + red[(h * 2 + 1) * 2 + 1];
        const size_t o = (size_t)t * 512 + h * 128 + d;
        qn[o] = (bf16)f2bf(val[0] * (1.0f / sqrtf(sq + 1e-6f)));
        kn[o] = (bf16)f2bf(val[1] * (1.0f / sqrtf(sk + 1e-6f)));
        vv[o] = (bf16)f2bf(val[2]);
        if (d == 0) {
            bb[t * 4 + h] = 1.f / (1.f + expf(-sm[(size_t)t * 32 + 24 + h]));
            const float xx = sm[(size_t)t * 32 + 28 + h] + dt_bias[h];
            const float sp = (xx > 20.f) ? xx : log1pf(expf(xx));
            gg[t * 4 + h] = -expf(a_log[h]) * sp;
        }
        __syncthreads();
    }
}

__device__ __forceinline__ void cmp_gemm1_phase(const Args& a, LAS unsigned char* lds, int tid) {
    unsigned char* ws = a.ws; const bf16* kv = (const bf16*)(ws + WS_KV); bf16* hid = (bf16*)(ws + WS_HID);
    LAS float* As = (LAS float*)lds; LAS float* Bs = As + 16 * 68;
    for (int u = blockIdx.x; u < 256; u += gridDim.x) {
        const int which = u >> 7, mt = (u >> 2) & 31, nt = u & 3;
        const float* pos = a.in[3 + which]; const float* w1 = a.in[which ? 7 : 5];
        const int col0 = which * 128;
        auto la = [&](int r, int k) -> f32x4 {
            const int row = mt * 64 + r, g = row & 1, bn = row >> 1, b = bn >> 7, n = bn & 127, j = k >> 6, d = k & 63;
            const u32x2 w = *(const u32x2*)(kv + (size_t)(b * SEQ + 16 * n + j) * 768 + col0 + g * 64 + d);
            const f32x4 pv = *(const f32x4*)(pos + j * 64 + d);
            return (f32x4){bf2f(w.x & 0xffffu) + pv.x, bf2f(w.x >> 16) + pv.y, bf2f(w.y & 0xffffu) + pv.z, bf2f(w.y >> 16) + pv.w};
        };
        auto lb = [&](int k, int c) -> f32x4 { return *(const f32x4*)(w1 + (size_t)k * 256 + nt * 64 + c); };
        auto st = [&](int r, int c, f32x4 v) {
            float o[4];
#pragma unroll
            for (int e = 0; e < 4; ++e) { const float x = v[e]; o[e] = 0.5f * x * (1.f + tanhf(0.7978845608028654f * (x + 0.044715f * x * x * x))); }
            u32x2 w; w.x = pk2(o[0], o[1]); w.y = pk2(o[2], o[3]);
            *(u32x2*)(hid + ((size_t)which * 2048 + mt * 64 + r) * 256 + nt * 64 + c) = w;
        };
        sgemm_tile64(As, Bs, 2048, tid, la, lb, st);
    }
}
__device__ __forceinline__ void cmp_gemm2_phase(const Args& a, LAS unsigned char* lds, int tid) {
    unsigned char* ws = a.ws; const bf16* hid = (const bf16*)(ws + WS_HID);
    LAS float* As = (LAS float*)lds; LAS float* Bs = As + 16 * 68;
    for (int u = blockIdx.x; u < 64; u += gridDim.x) {
        const int which = u >> 5, mt = u & 31;
        const float* w2 = a.in[which ? 8 : 6]; float* outp = (float*)(ws + (which ? WS_VC : WS_KC));
        auto la = [&](int r, int k) -> f32x4 { const u32x2 w = *(const u32x2*)(hid + ((size_t)which * 2048 + mt * 64 + r) * 256 + k);
            return (f32x4){bf2f(w.x & 0xffffu), bf2f(w.x >> 16), bf2f(w.y & 0xffffu), bf2f(w.y >> 16)}; };
        auto lb = [&](int k, int c) -> f32x4 { return *(const f32x4*)(w2 + (size_t)k * 64 + c); };
        bf16* outb = (bf16*)(ws + (which ? WS_VCB : WS_KCB));
        auto st = [&](int r, int c, f32x4 v) { *(f32x4*)(outp + (size_t)(mt * 64 + r) * 64 + c) = v;
            const int row = mt * 64 + r, gg_ = row & 1, bn = row >> 1, bb_ = bn >> 7, n = bn & 127;
            u32x2 wv; wv.x = (n == 127) ? 0u : pk2(v.x, v.y); wv.y = (n == 127) ? 0u : pk2(v.z, v.w);
            *(u32x2*)(outb + ((size_t)((bb_ * 2 + gg_) * 128 + n)) * 64 + c) = wv; };
        sgemm_tile64(As, Bs, 256, tid, la, lb, st);
    }
}

template <int MODE>
__device__ __forceinline__ void attn_simple_phase(const Args& a, LAS unsigned char* lds, int tid) {
    constexpr int NK = (MODE == 0) ? 127 : 512;
    unsigned char* ws = a.ws;
    const bf16* Q = (const bf16*)(ws + WS_Q); const bf16* KV = (const bf16*)(ws + WS_KV); const float* sm = (const float*)(ws + WS_SM);
    const float* kc = (const float*)(ws + WS_KC); const float* vc = (const float*)(ws + WS_VC);
    const float* rel_bias = a.in[9];
    float* oacc = (float*)(ws + WS_OACC); u32* sel = (u32*)(ws + WS_SEL);
    const bf16* za = (const bf16*)(ws + WS_ZA); bf16* oa = (bf16*)(ws + WS_OA);
    const int sb = tid >> 8, stid = tid & 255;
    LAS float* qs = (LAS float*)(lds + sb * 12288);
    LAS float* sc = qs + 256;
    LAS int* blk = (LAS int*)(sc + 2048);
    LAS float* imp = (LAS float*)(blk + 8);
    const int NU = T * 2, G2 = gridDim.x * 2;
    for (int u0 = 0; u0 < NU; u0 += G2) {
        const int u = u0 + blockIdx.x * 2 + sb; const bool act = u < NU;
        const int t = act ? (u >> 1) : 0, g = u & 1, ts = t & (SEQ - 1), tb = t - ts;
        qs[stid] = bf2f(Q[(size_t)t * 512 + (g * 4 + (stid >> 6)) * 64 + (stid & 63)]);
        if (MODE == 1 && stid == 0) { u32 mk = sel[t * 2 + g]; int k = 0; for (int j = 0; j < 32; ++j) if ((mk >> j) & 1u) { if (k < 8) blk[k] = j; ++k; } for (; k < 8; ++k) blk[k] = 0; }
        __syncthreads();
        for (int i = stid; i < NK; i += 256) {
            int dist, kpos; bool valid; const bf16* kb = nullptr; const float* kf = nullptr;
            if (MODE == 0) { dist = ts - (16 * i + 31); valid = dist >= 0; kf = kc + (size_t)((((tb >> 11) * 128) + i) * 2 + g) * 64; }
            else if (MODE == 1) { kpos = blk[i >> 6] * 64 + (i & 63); dist = ts - kpos; valid = dist >= 0; kb = KV + (size_t)(tb + kpos) * 768 + 256 + g * 64; }
            else { kpos = ts - 511 + i; dist = 511 - i; valid = kpos >= 0; kb = KV + (size_t)(tb + (kpos < 0 ? 0 : kpos)) * 768 + 512 + g * 64; }
            float s0 = 0.f, s1 = 0.f, s2 = 0.f, s3 = 0.f;
            if (valid) {
#pragma unroll 2
                for (int d = 0; d < 64; d += 8) {
                    float kk[8];
                    if (MODE == 0) { const f32x4 k0 = *(const f32x4*)(kf + d), k1 = *(const f32x4*)(kf + d + 4); kk[0] = k0.x; kk[1] = k0.y; kk[2] = k0.z; kk[3] = k0.w; kk[4] = k1.x; kk[5] = k1.y; kk[6] = k1.z; kk[7] = k1.w; }
                    else { const u32x4 w = *(const u32x4*)(kb + d); kk[0] = bf2f(w.x & 0xffffu); kk[1] = bf2f(w.x >> 16); kk[2] = bf2f(w.y & 0xffffu); kk[3] = bf2f(w.y >> 16); kk[4] = bf2f(w.z & 0xffffu); kk[5] = bf2f(w.z >> 16); kk[6] = bf2f(w.w & 0xffffu); kk[7] = bf2f(w.w >> 16); }
#pragma unroll
                    for (int e = 0; e < 8; ++e) { s0 = fmaf(kk[e], qs[d + e], s0); s1 = fmaf(kk[e], qs[64 + d + e], s1); s2 = fmaf(kk[e], qs[128 + d + e], s2); s3 = fmaf(kk[e], qs[192 + d + e], s3); }
                }
                const float* rb = rel_bias + rel_bucket(dist) * 8 + g * 4;
                s0 += rb[0] * 1.4426950408889634f; s1 += rb[1] * 1.4426950408889634f; s2 += rb[2] * 1.4426950408889634f; s3 += rb[3] * 1.4426950408889634f;
            } else { s0 = s1 = s2 = s3 = -1e30f; }
            sc[i] = s0; sc[512 + i] = s1; sc[1024 + i] = s2; sc[1536 + i] = s3;
        }
        __syncthreads();
        {
            const int w = stid >> 6, lane = stid & 63; LAS float* row = sc + w * 512;
            float mx = -1e30f;
            for (int i = lane; i < NK; i += 64) mx = fmaxf(mx, row[i]);
#pragma unroll
            for (int o = 32; o > 0; o >>= 1) mx = fmaxf(mx, wshfl_xor(mx, o, tid));
            float sum = 0.f;
            for (int i = lane; i < NK; i += 64) { const float s = row[i]; const float e = (s > -1e29f) ? exp2f(s - mx) : 0.f; row[i] = e; sum += e; }
#pragma unroll
            for (int o = 32; o > 0; o >>= 1) sum += wshfl_xor(sum, o, tid);
            const float inv = (sum > 0.f) ? 1.f / sum : 0.f;
            for (int i = lane; i < NK; i += 64) row[i] *= inv;
        }
        __syncthreads();
        {
            const int hg = stid >> 6, d = stid & 63; const LAS float* row = sc + hg * 512;
            float acc = 0.f;
            for (int i = 0; i < NK; ++i) {
                const float p = row[i];
                if (p != 0.f) {
                    float v;
                    if (MODE == 0) v = vc[(size_t)((((tb >> 11) * 128) + i) * 2 + g) * 64 + d];
                    else if (MODE == 1) v = bf2f(KV[(size_t)(tb + blk[i >> 6] * 64 + (i & 63)) * 768 + 384 + g * 64 + d]);
                    else v = bf2f(KV[(size_t)(tb + ts - 511 + i) * 768 + 640 + g * 64 + d]);
                    acc = fmaf(p, v, acc);
                }
            }
            if (act) {
                const int h = g * 4 + hg; const size_t o = (size_t)t * 512 + h * 64 + d;
                const float gate = 1.f / (1.f + expf(-sm[(size_t)t * 32 + (MODE == 0 ? 0 : MODE == 1 ? 8 : 16) + h]));
                if (MODE == 2) oacc[o] = gate * acc;
                else if (MODE == 0) oacc[o] += gate * acc;
                else oa[o] = (bf16)f2bf((oacc[o] + gate * acc) * bf2f(za[o]));
            }
        }
        if (MODE == 0) {
            if (stid < 32) {
                const int j = stid; float s = 0.f;
                for (int n = 4 * j - 1; n <= 4 * j + 3; ++n) if (n >= 0 && n < 127) s += (sc[n] + sc[512 + n]) + (sc[1024 + n] + sc[1536 + n]);
                const int cur = ts >> 6;
                if (j == 0 || j == cur || j == cur - 1) s = 1e6f; else if (j > cur) s = -1e6f;
                imp[j] = s;
            }
            __syncthreads();
            if (stid == 0 && act) {
                u32 taken = 0u;
                for (int k = 0; k < 8; ++k) { int best = -1; float bv = 0.f;
                    for (int j = 0; j < 32; ++j) if (!((taken >> j) & 1u)) { const float x = imp[j]; if (best < 0 || x > bv) { best = j; bv = x; } }
                    taken |= 1u << best; }
                sel[t * 2 + g] = taken;
            }
        }
        __syncthreads();
    }
}

typedef float f32x16 __attribute__((ext_vector_type(16)));
typedef short s16x4 __attribute__((ext_vector_type(4)));
__device__ __forceinline__ int crow(int r, int hi) { return (r & 3) + 8 * (r >> 2) + 4 * hi; }
__device__ __forceinline__ unsigned cvtpk(float lo, float hi) { typedef float f2 __attribute__((ext_vector_type(2))); typedef __bf16 b2 __attribute__((ext_vector_type(2))); f2 v = {lo, hi}; b2 b = __builtin_convertvector(v, b2); return __builtin_bit_cast(unsigned, b); }
__device__ __forceinline__ float hswap_max(float v) { auto rr = __builtin_amdgcn_permlane32_swap(__float_as_uint(v), __float_as_uint(v), false, false); return fmaxf(__uint_as_float(rr[0]), __uint_as_float(rr[1])); }
__device__ __forceinline__ float hswap_sum(float v) { auto rr = __builtin_amdgcn_permlane32_swap(__float_as_uint(v), __float_as_uint(v), false, false); return __uint_as_float(rr[0]) + __uint_as_float(rr[1]); }
template <int MODE, bool PROBE>
__device__ __forceinline__ void attn_mfma_unit(const Args& a, LAS unsigned char* lds, int tid, int b, int g, int qt) {
    typedef short v4i16_t __attribute__((ext_vector_type(4)));
    unsigned char* ws = a.ws;
    const int lane = tid & 63, w = __builtin_amdgcn_readfirstlane(tid >> 6), r32 = lane & 31, hi = lane >> 5;
    const int hg = w >> 1, tsub = w & 1, h = g * 4 + hg;
    const int tb = b * SEQ, t0 = qt * 64, tq = t0 + tsub * 32 + r32;
    const bf16* Q = (const bf16*)(ws + WS_Q); const bf16* KV = (const bf16*)(ws + WS_KV);
    const int kcol = (MODE == 1 ? 256 : 512) + g * 64, vcol = kcol + 128;
    bf16x8 qr[4];
#pragma unroll
    for (int d0 = 0; d0 < 4; ++d0) qr[d0] = *(const bf16x8*)(Q + (size_t)(tb + tq) * 512 + h * 64 + d0 * 16 + hi * 8);
    bf16x8 oh[2];
#pragma unroll
    for (int sx = 0; sx < 2; ++sx)
#pragma unroll
        for (int j = 0; j < 8; ++j) oh[sx][j] = (16 * sx + 8 * hi + j == r32) ? (short)0x3F80 : (short)0;
    const int j0 = (MODE == 2) ? (qt > 8 ? qt - 8 : 0) : 0, j1 = qt;
    const bf16* ksrc = KV + (size_t)(tb + lane) * 768 + kcol + w * 8;
    const bf16* vsrc = KV + (size_t)(tb + 16 * (w & 3) + (lane >> 2)) * 768 + vcol + (w >> 2) * 32 + (lane & 3) * 8;
    LAS unsigned char* Kb = lds; LAS unsigned char* Vb = lds + 16384; LAS float* wsf = (LAS float*)(lds + 32768) + w * 64;
    const unsigned char* tblb = ws + WS_TBL + (size_t)((MODE == 2 ? NDI : 0) * 8 + h) * 4096 + lane * 16;
    u32 mk = 0xffffffffu; if (MODE == 1) mk = ((const u32*)(ws + WS_SEL))[(tb + tq) * 2 + g];
    u32x4 kreg = *(const u32x4*)(ksrc + (size_t)j0 * 64 * 768), vreg = *(const u32x4*)(vsrc + (size_t)j0 * 64 * 768);
    *(LAS u32x4*)(Kb + w * 1024 + lane * 16) = kreg; *(LAS u32x4*)(Vb + w * 1024 + lane * 16) = vreg;
    __syncthreads();
    float m = -1e30f, l = 0.f; f32x16 o[2];
#pragma unroll
    for (int r = 0; r < 16; ++r) { o[0][r] = 0.f; o[1][r] = 0.f; }
    const LAS unsigned char* vrd0 = Vb + ((lane >> 4) & 1) * 32 + (lane & 3) * 8 + (4 * hi + ((lane & 15) >> 2)) * 64;
    for (int jt = j0; jt <= j1; ++jt) {
        const int cur = (jt - j0) & 1;
        if (jt < j1) { kreg = *(const u32x4*)(ksrc + (size_t)(jt + 1) * 64 * 768); vreg = *(const u32x4*)(vsrc + (size_t)(jt + 1) * 64 * 768); }
        int di = 2 * (qt - jt) + tsub; if (di > NDI - 1) di = NDI - 1;
        const unsigned char* tp = tblb + (size_t)di * 32768;
        const bf16x8 tf00 = *(const bf16x8*)(tp), tf01 = *(const bf16x8*)(tp + 1024), tf10 = *(const bf16x8*)(tp + 2048), tf11 = *(const bf16x8*)(tp + 3072);
        const float cinit = (MODE == 1 && !((mk >> jt) & 1u)) ? -30000.f : 0.f;
        f32x16 p0, p1;
#pragma unroll
        for (int r = 0; r < 16; ++r) p0[r] = cinit;
        p1 = __builtin_amdgcn_mfma_f32_32x32x16_bf16(tf01, oh[0], p0, 0, 0, 0);
        p0 = __builtin_amdgcn_mfma_f32_32x32x16_bf16(tf00, oh[0], p0, 0, 0, 0);
        p0 = __builtin_amdgcn_mfma_f32_32x32x16_bf16(tf10, oh[1], p0, 0, 0, 0);
        p1 = __builtin_amdgcn_mfma_f32_32x32x16_bf16(tf11, oh[1], p1, 0, 0, 0);
        const LAS unsigned char* kb = Kb + cur * 8192 + hi * 1024 + r32 * 16;
#pragma unroll
        for (int d0 = 0; d0 < 4; ++d0) {
            const bf16x8 k0 = *(const LAS bf16x8*)(kb + d0 * 2048), k1 = *(const LAS bf16x8*)(kb + d0 * 2048 + 512);
            p0 = __builtin_amdgcn_mfma_f32_32x32x16_bf16(k0, qr[d0], p0, 0, 0, 0);
            p1 = __builtin_amdgcn_mfma_f32_32x32x16_bf16(k1, qr[d0], p1, 0, 0, 0);
        }
        float rm = fmaxf(p0[0], p1[0]);
#pragma unroll
        for (int r = 1; r < 16; ++r) rm = fmaxf(rm, fmaxf(p0[r], p1[r]));
        rm = hswap_max(rm);
        const float mn = fmaxf(m, rm);
        if (__any(mn > m)) {
            const float sc = __builtin_amdgcn_exp2f(m - mn); l *= sc; m = mn;
            if (hi == 0) wsf[r32] = sc;
            LDS_WAIT();
#pragma unroll
            for (int r = 0; r < 16; ++r) { const float f = wsf[crow(r, hi)]; o[0][r] *= f; o[1][r] *= f; }
            LDS_WAIT();
        }
        float sacc = 0.f;
#pragma unroll
        for (int r = 0; r < 16; ++r) { p0[r] = __builtin_amdgcn_exp2f(p0[r] - m); p1[r] = __builtin_amdgcn_exp2f(p1[r] - m); sacc += p0[r] + p1[r]; }
        l += sacc;
        u32x4 pw[4];
#pragma unroll
        for (int e = 0; e < 4; ++e) { pw[0][e] = cvtpk(p0[2 * e], p0[2 * e + 1]); pw[1][e] = cvtpk(p0[8 + 2 * e], p0[8 + 2 * e + 1]); pw[2][e] = cvtpk(p1[2 * e], p1[2 * e + 1]); pw[3][e] = cvtpk(p1[8 + 2 * e], p1[8 + 2 * e + 1]); }
        const LAS unsigned char* vrd = vrd0 + cur * 8192;
#pragma unroll
        for (int d0 = 0; d0 < 2; ++d0)
#pragma unroll
            for (int ks = 0; ks < 4; ++ks) {
                const s16x4 lo = __builtin_bit_cast(s16x4, __builtin_amdgcn_ds_read_tr16_b64_v4i16((LAS v4i16_t*)(vrd + d0 * 4096 + ks * 1024)));
                const s16x4 hh = __builtin_bit_cast(s16x4, __builtin_amdgcn_ds_read_tr16_b64_v4i16((LAS v4i16_t*)(vrd + d0 * 4096 + ks * 1024 + 512)));
                const bf16x8 vf = (bf16x8){lo[0], lo[1], lo[2], lo[3], hh[0], hh[1], hh[2], hh[3]};
                o[d0] = __builtin_amdgcn_mfma_f32_32x32x16_bf16(__builtin_bit_cast(bf16x8, pw[ks]), vf, o[d0], 0, 0, 0);
            }
        if (jt < j1) { *(LAS u32x4*)(Kb + (cur ^ 1) * 8192 + w * 1024 + lane * 16) = kreg; *(LAS u32x4*)(Vb + (cur ^ 1) * 8192 + w * 1024 + lane * 16) = vreg; }
        __syncthreads();
    }
    l = hswap_sum(l);
    if (hi == 0) wsf[32 + r32] = l;
    LDS_WAIT();
    const float* sm = (const float*)(ws + WS_SM); float* oacc = (float*)(ws + WS_OACC);
    const bf16* za = (const bf16*)(ws + WS_ZA); bf16* oa = (bf16*)(ws + WS_OA);
    float dmax = 0.f;
#pragma unroll
    for (int r = 0; r < 16; ++r) {
        const int qi = crow(r, hi); const size_t row = (size_t)(tb + t0 + tsub * 32 + qi);
        const float rl = __builtin_amdgcn_rcpf(wsf[32 + qi]);
        const float gate = sigm(sm[row * 32 + (MODE == 1 ? 8 : 16) + h]);
#pragma unroll
        for (int d0 = 0; d0 < 2; ++d0) { const size_t oo = row * 512 + h * 64 + d0 * 32 + r32; const float val = gate * o[d0][r] * rl;
            if (PROBE) dmax = fmaxf(dmax, (MODE == 2) ? fabsf(val - oacc[oo]) : fabsf((oacc[oo] + val) * bf2f(za[oo]) - bf2f(oa[oo])));
            else if (MODE == 2) oacc[oo] = val;
            else oa[oo] = (bf16)f2bf((oacc[oo] + val) * bf2f(za[oo])); }
    }
    LDS_WAIT();
    if (PROBE) atomicMax((unsigned*)(ws + WS_DBG), __float_as_uint(dmax));
}
template <int MODE, bool PROBE>
__device__ __forceinline__ void attn_mfma_phase(const Args& a, LAS unsigned char* lds, int tid) {
    for (int i = blockIdx.x; i < 256; i += gridDim.x) {
        const int bg = i >> 4, s = i & 15;
        attn_mfma_unit<MODE, PROBE>(a, lds, tid, bg >> 1, bg & 1, s);
        attn_mfma_unit<MODE, PROBE>(a, lds, tid, bg >> 1, bg & 1, 31 - s);
    }
}

constexpr int FA_KB = 0, FA_VB = 16384, FA_WSF = 32768, FA_SELM = 36864, FA_IMP = 37376, FA_BIAS = 70144, FA_END = 102912;
template <int MODE>
__device__ __forceinline__ void fa_branch(const unsigned char* ws, LAS unsigned char* lds, int tid, int tb, int g, int qt, int h, u32 mk, const float* smg, f32x16 (&osum)[2]) {
    typedef short v4i16_t __attribute__((ext_vector_type(4)));
    const int lane = tid & 63, w = __builtin_amdgcn_readfirstlane(tid >> 6), r32 = lane & 31, hi = lane >> 5, tsub = w & 1;
    const bf16* KV = (const bf16*)(ws + WS_KV);
    const int kcol = (MODE == 1 ? 256 : 512) + g * 64, vcol = kcol + 128;
    const int j0 = (MODE == 2) ? (qt > 8 ? qt - 8 : 0) : 0, j1 = qt;
    bf16x8 qr[4];
    { const bf16* Q = (const bf16*)(ws + WS_Q) + (size_t)(tb + qt * 64 + tsub * 32 + r32) * 512 + h * 64 + hi * 8;
#pragma unroll
      for (int d0 = 0; d0 < 4; ++d0) qr[d0] = *(const bf16x8*)(Q + d0 * 16); }
    bf16x8 oh[2];
#pragma unroll
    for (int sx = 0; sx < 2; ++sx)
#pragma unroll
        for (int j = 0; j < 8; ++j) oh[sx][j] = (16 * sx + 8 * hi + j == r32) ? (short)0x3F80 : (short)0;
    const bf16* ksrc = KV + (size_t)(tb + lane) * 768 + kcol + w * 8;
    const bf16* vsrc = KV + (size_t)(tb + 16 * (w & 3) + (lane >> 2)) * 768 + vcol + (w >> 2) * 32 + (lane & 3) * 8;
    LAS unsigned char* Kb = lds + FA_KB; LAS unsigned char* Vb = lds + FA_VB; LAS float* wsf = (LAS float*)(lds + FA_WSF) + w * 128;
    const unsigned char* tblb = ws + WS_TBL + (size_t)((MODE == 2 ? NDI : 0) * 8 + h) * 4096 + lane * 16;
    u32x4 kreg = *(const u32x4*)(ksrc + (size_t)j0 * 64 * 768), vreg = *(const u32x4*)(vsrc + (size_t)j0 * 64 * 768);
    *(LAS u32x4*)(Kb + w * 1024 + lane * 16) = kreg; *(LAS u32x4*)(Vb + w * 1024 + lane * 16) = vreg;
    __syncthreads();
    float m = -1e30f, l = 0.f; f32x16 o[2];
#pragma unroll
    for (int r = 0; r < 16; ++r) { o[0][r] = 0.f; o[1][r] = 0.f; }
    const LAS unsigned char* vrd0 = Vb + ((lane >> 4) & 1) * 32 + (lane & 3) * 8 + (4 * hi + ((lane & 15) >> 2)) * 64;
    for (int jt = j0; jt <= j1; ++jt) {
        const int cur = (jt - j0) & 1;
        if (jt < j1) { kreg = *(const u32x4*)(ksrc + (size_t)(jt + 1) * 64 * 768); vreg = *(const u32x4*)(vsrc + (size_t)(jt + 1) * 64 * 768); }
        int di = 2 * (qt - jt) + tsub; if (di > NDI - 1) di = NDI - 1;
        const unsigned char* tp = tblb + (size_t)di * 32768;
        const bf16x8 tf00 = *(const bf16x8*)(tp), tf01 = *(const bf16x8*)(tp + 1024), tf10 = *(const bf16x8*)(tp + 2048), tf11 = *(const bf16x8*)(tp + 3072);
        const float cinit = (MODE == 1 && !((mk >> jt) & 1u)) ? -30000.f : 0.f;
        f32x16 p0, p1;
#pragma unroll
        for (int r = 0; r < 16; ++r) p0[r] = cinit;
        p1 = __builtin_amdgcn_mfma_f32_32x32x16_bf16(tf01, oh[0], p0, 0, 0, 0);
        p0 = __builtin_amdgcn_mfma_f32_32x32x16_bf16(tf00, oh[0], p0, 0, 0, 0);
        p0 = __builtin_amdgcn_mfma_f32_32x32x16_bf16(tf10, oh[1], p0, 0, 0, 0);
        p1 = __builtin_amdgcn_mfma_f32_32x32x16_bf16(tf11, oh[1], p1, 0, 0, 0);
        const LAS unsigned char* kb = Kb + cur * 8192 + hi * 1024 + r32 * 16;
#pragma unroll
        for (int d0 = 0; d0 < 4; ++d0) {
            const bf16x8 k0 = *(const LAS bf16x8*)(kb + d0 * 2048), k1 = *(const LAS bf16x8*)(kb + d0 * 2048 + 512);
            p0 = __builtin_amdgcn_mfma_f32_32x32x16_bf16(k0, qr[d0], p0, 0, 0, 0);
            p1 = __builtin_amdgcn_mfma_f32_32x32x16_bf16(k1, qr[d0], p1, 0, 0, 0);
        }
        float rm = fmaxf(p0[0], p1[0]);
#pragma unroll
        for (int r = 1; r < 16; ++r) rm = fmaxf(rm, fmaxf(p0[r], p1[r]));
        rm = hswap_max(rm);
        const float mn = fmaxf(m, rm);
        if (__any(mn > m)) {
            const float sc = __builtin_amdgcn_exp2f(m - mn); l *= sc; m = mn;
            if (hi == 0) wsf[r32] = sc;
            LDS_WAIT();
#pragma unroll
            for (int r = 0; r < 16; ++r) { const float f = wsf[crow(r, hi)]; o[0][r] *= f; o[1][r] *= f; }
            LDS_WAIT();
        }
        float sacc = 0.f;
#pragma unroll
        for (int r = 0; r < 16; ++r) { p0[r] = __builtin_amdgcn_exp2f(p0[r] - m); p1[r] = __builtin_amdgcn_exp2f(p1[r] - m); sacc += p0[r] + p1[r]; }
        l += sacc;
        u32x4 pw[4];
#pragma unroll
        for (int e = 0; e < 4; ++e) { pw[0][e] = cvtpk(p0[2 * e], p0[2 * e + 1]); pw[1][e] = cvtpk(p0[8 + 2 * e], p0[8 + 2 * e + 1]); pw[2][e] = cvtpk(p1[2 * e], p1[2 * e + 1]); pw[3][e] = cvtpk(p1[8 + 2 * e], p1[8 + 2 * e + 1]); }
        const LAS unsigned char* vrd = vrd0 + cur * 8192;
#pragma unroll
        for (int d0 = 0; d0 < 2; ++d0)
#pragma unroll
            for (int ks = 0; ks < 4; ++ks) {
                const s16x4 lo = __builtin_bit_cast(s16x4, __builtin_amdgcn_ds_read_tr16_b64_v4i16((LAS v4i16_t*)(vrd + d0 * 4096 + ks * 1024)));
                const s16x4 hh = __builtin_bit_cast(s16x4, __builtin_amdgcn_ds_read_tr16_b64_v4i16((LAS v4i16_t*)(vrd + d0 * 4096 + ks * 1024 + 512)));
                const bf16x8 vf = (bf16x8){lo[0], lo[1], lo[2], lo[3], hh[0], hh[1], hh[2], hh[3]};
                o[d0] = __builtin_amdgcn_mfma_f32_32x32x16_bf16(__builtin_bit_cast(bf16x8, pw[ks]), vf, o[d0], 0, 0, 0);
            }
        if (jt < j1) { *(LAS u32x4*)(Kb + (cur ^ 1) * 8192 + w * 1024 + lane * 16) = kreg; *(LAS u32x4*)(Vb + (cur ^ 1) * 8192 + w * 1024 + lane * 16) = vreg; }
        __syncthreads();
    }
    l = hswap_sum(l);
    if (hi == 0) wsf[32 + r32] = sigm(smg[(size_t)r32 * 32]) * __builtin_amdgcn_rcpf(l);
    LDS_WAIT();
#pragma unroll
    for (int r = 0; r < 16; ++r) { const float f = wsf[32 + crow(r, hi)]; osum[0][r] = fmaf(f, o[0][r], osum[0][r]); osum[1][r] = fmaf(f, o[1][r], osum[1][r]); }
    LDS_WAIT();
}
template <int PROBE>
__device__ __forceinline__ void fused_attn_unit(const Args& a, LAS unsigned char* lds, int tid, int b, int g, int qt) {
    typedef short v4i16_t __attribute__((ext_vector_type(4)));
    unsigned char* ws = a.ws;
    const int lane = tid & 63, w = __builtin_amdgcn_readfirstlane(tid >> 6), r32 = lane & 31, hi = lane >> 5;
    const int hg = w >> 1, tsub = w & 1, h = g * 4 + hg;
    const int tb = b * SEQ, t0 = qt * 64, tq = t0 + tsub * 32 + r32;
    const bf16* Q = (const bf16*)(ws + WS_Q); const float* sm = (const float*)(ws + WS_SM);
    LAS unsigned char* Kb = lds + FA_KB; LAS unsigned char* Vb = lds + FA_VB; LAS float* wsf = (LAS float*)(lds + FA_WSF) + w * 128;
    LAS u32* selm = (LAS u32*)(lds + FA_SELM); LAS float* impb = (LAS float*)(lds + FA_IMP); const LAS float* biasL = (const LAS float*)(lds + FA_BIAS) + hg * 2048;
    f32x16 osum[2];
    {
        bf16x8 qr[4];
#pragma unroll
        for (int d0 = 0; d0 < 4; ++d0) qr[d0] = *(const bf16x8*)(Q + (size_t)(tb + tq) * 512 + h * 64 + d0 * 16 + hi * 8);
        const bf16* kcb = (const bf16*)(ws + WS_KCB) + (size_t)(b * 2 + g) * 128 * 64; const bf16* vcb = (const bf16*)(ws + WS_VCB) + (size_t)(b * 2 + g) * 128 * 64;
#pragma unroll
        for (int jt = 0; jt < 2; ++jt) {
            *(LAS u32x4*)(Kb + jt * 8192 + w * 1024 + lane * 16) = *(const u32x4*)(kcb + (size_t)(jt * 64 + lane) * 64 + w * 8);
            *(LAS u32x4*)(Vb + jt * 8192 + w * 1024 + lane * 16) = *(const u32x4*)(vcb + (size_t)(jt * 64 + 16 * (w & 3) + (lane >> 2)) * 64 + (w >> 2) * 32 + (lane & 3) * 8);
        }
        __syncthreads();
        f32x16 p[4];
#pragma unroll
        for (int t = 0; t < 4; ++t)
#pragma unroll
            for (int r = 0; r < 16; ++r) p[t][r] = 0.f;
#pragma unroll
        for (int jt = 0; jt < 2; ++jt) {
            const LAS unsigned char* kb = Kb + jt * 8192 + hi * 1024 + r32 * 16;
#pragma unroll
            for (int d0 = 0; d0 < 4; ++d0) {
                const bf16x8 k0 = *(const LAS bf16x8*)(kb + d0 * 2048), k1 = *(const LAS bf16x8*)(kb + d0 * 2048 + 512);
                p[2 * jt] = __builtin_amdgcn_mfma_f32_32x32x16_bf16(k0, qr[d0], p[2 * jt], 0, 0, 0);
                p[2 * jt + 1] = __builtin_amdgcn_mfma_f32_32x32x16_bf16(k1, qr[d0], p[2 * jt + 1], 0, 0, 0);
            }
        }
        float mx = -30000.f;
#pragma unroll
        for (int t = 0; t < 4; ++t)
#pragma unroll
            for (int r = 0; r < 16; ++r) { const int n = 32 * t + crow(r, hi); const int dist = tq - 16 * n - 31;
                const float v = (dist >= 0) ? p[t][r] + biasL[dist < 0 ? 0 : dist] : -30000.f; p[t][r] = v; mx = fmaxf(mx, v); }
        mx = fmaxf(hswap_max(mx), -10000.f);
        float l = 0.f;
#pragma unroll
        for (int t = 0; t < 4; ++t)
#pragma unroll
            for (int r = 0; r < 16; ++r) { p[t][r] = __builtin_amdgcn_exp2f(p[t][r] - mx); l += p[t][r]; }
        l = hswap_sum(l);
        const float inv = (l > 0.f) ? 1.f / l : 0.f;
#pragma unroll
        for (int t = 0; t < 4; ++t)
#pragma unroll
            for (int r = 0; r < 16; ++r) p[t][r] *= inv;
        float plast[16];
#pragma unroll
        for (int cg = 0; cg < 16; ++cg) { const float lastv = p[cg >> 2][4 * (cg & 3) + 3];
            auto rr = __builtin_amdgcn_permlane32_swap(__float_as_uint(lastv), __float_as_uint(lastv), false, false); plast[cg] = __uint_as_float(hi ? rr[0] : rr[1]); }
        LAS float* myimp = impb + (size_t)(hg * 64 + tsub * 32 + r32) * 32 + hi;
#pragma unroll
        for (int cg = 0; cg < 16; ++cg) { const int t = cg >> 2, c = cg & 3;
            const float s4 = (p[t][4 * c] + p[t][4 * c + 1]) + (p[t][4 * c + 2] + p[t][4 * c + 3]);
            const float extra = hi ? plast[cg] : (cg > 0 ? plast[cg > 0 ? cg - 1 : 0] : 0.f);
            myimp[2 * cg] = s4 + extra; }
        f32x16 o[2];
#pragma unroll
        for (int r = 0; r < 16; ++r) { o[0][r] = 0.f; o[1][r] = 0.f; }
        const LAS unsigned char* vrd0 = Vb + ((lane >> 4) & 1) * 32 + (lane & 3) * 8 + (4 * hi + ((lane & 15) >> 2)) * 64;
#pragma unroll
        for (int jt = 0; jt < 2; ++jt) {
            u32x4 pw[4];
#pragma unroll
            for (int e = 0; e < 4; ++e) { pw[0][e] = cvtpk(p[2 * jt][2 * e], p[2 * jt][2 * e + 1]); pw[1][e] = cvtpk(p[2 * jt][8 + 2 * e], p[2 * jt][8 + 2 * e + 1]);
                pw[2][e] = cvtpk(p[2 * jt + 1][2 * e], p[2 * jt + 1][2 * e + 1]); pw[3][e] = cvtpk(p[2 * jt + 1][8 + 2 * e], p[2 * jt + 1][8 + 2 * e + 1]); }
#pragma unroll
            for (int d0 = 0; d0 < 2; ++d0)
#pragma unroll
                for (int ks = 0; ks < 4; ++ks) {
                    const s16x4 lo = __builtin_bit_cast(s16x4, __builtin_amdgcn_ds_read_tr16_b64_v4i16((LAS v4i16_t*)(vrd0 + jt * 8192 + d0 * 4096 + ks * 1024)));
                    const s16x4 hh = __builtin_bit_cast(s16x4, __builtin_amdgcn_ds_read_tr16_b64_v4i16((LAS v4i16_t*)(vrd0 + jt * 8192 + d0 * 4096 + ks * 1024 + 512)));
                    const bf16x8 vf = (bf16x8){lo[0], lo[1], lo[2], lo[3], hh[0], hh[1], hh[2], hh[3]};
                    o[d0] = __builtin_amdgcn_mfma_f32_32x32x16_bf16(__builtin_bit_cast(bf16x8, pw[ks]), vf, o[d0], 0, 0, 0);
                }
        }
        if (hi == 0) wsf[64 + r32] = sigm(sm[(size_t)(tb + tq) * 32 + h]);
        LDS_WAIT();
#pragma unroll
        for (int r = 0; r < 16; ++r) { const float gt = wsf[64 + crow(r, hi)]; osum[0][r] = gt * o[0][r]; osum[1][r] = gt * o[1][r]; }
        __syncthreads();
#pragma unroll 1
        for (int it = 0; it < 4; ++it) {
            const int tok = w * 8 + it * 2 + hi, j = r32;
            float v = (impb[(size_t)(0 * 64 + tok) * 32 + j] + impb[(size_t)(1 * 64 + tok) * 32 + j]) + (impb[(size_t)(2 * 64 + tok) * 32 + j] + impb[(size_t)(3 * 64 + tok) * 32 + j]);
            if (j == 0 || j == qt || j == qt - 1) v = 1e6f; else if (j > qt) v = -1e6f;
            wsf[lane] = v;
            LDS_WAIT();
            int cnt = 0;
#pragma unroll
            for (int i = 0; i < 32; ++i) { const float vi = wsf[hi * 32 + i]; cnt += ((vi > v) || (vi == v && i < j)) ? 1 : 0; }
            const unsigned long long bal = __ballot(cnt < 8);
            if (r32 == 0) selm[tok] = (u32)(bal >> (hi * 32));
            LDS_WAIT();
        }
        __syncthreads();
    }
    u32 mk = selm[tsub * 32 + r32];
    if (PROBE != 0) { const u32 ref = ((const u32*)(ws + WS_SEL))[(tb + tq) * 2 + g];
        if (PROBE == 2 && hg == 0 && hi == 0 && ref != mk) atomicAdd((float*)(ws + WS_DBG), 100.f / 32768.f);
        mk = ref; }
    const float* smrow = sm + (size_t)(tb + t0 + tsub * 32) * 32 + h;
    { int t2 = tid; asm volatile("" : "+v"(t2)); fa_branch<2>(ws, lds, t2, tb, g, qt, h, 0xffffffffu, smrow + 16, osum); }
    { int t2 = tid; asm volatile("" : "+v"(t2)); fa_branch<1>(ws, lds, t2, tb, g, qt, h, mk, smrow + 8, osum); }
    { LAS bf16* stg = (LAS bf16*)(lds + w * 4096);
#pragma unroll
      for (int r = 0; r < 16; ++r)
#pragma unroll
          for (int d0 = 0; d0 < 2; ++d0) stg[crow(r, hi) * 64 + d0 * 32 + r32] = (bf16)f2bf(osum[d0][r]);
      LDS_WAIT();
      const bf16* za = (const bf16*)(ws + WS_ZA) + (size_t)(tb + t0 + tsub * 32 + (lane >> 3)) * 512 + h * 64 + (lane & 7) * 8;
      bf16* oa = (bf16*)(ws + WS_OA) + (size_t)(tb + t0 + tsub * 32 + (lane >> 3)) * 512 + h * 64 + (lane & 7) * 8;
      float dmax = 0.f;
#pragma unroll
      for (int i = 0; i < 4; ++i) {
          const u32x4 ov = *(const LAS u32x4*)(stg + (i * 8 + (lane >> 3)) * 64 + (lane & 7) * 8);
          const u32x4 zv = *(const u32x4*)(za + (size_t)i * 8 * 512);
          u32x4 rv;
#pragma unroll
          for (int e = 0; e < 4; ++e) rv[e] = pk2(bf2f(ov[e] & 0xffffu) * bf2f(zv[e] & 0xffffu), bf2f(ov[e] >> 16) * bf2f(zv[e] >> 16));
          if (PROBE == 0) *(u32x4*)(oa + (size_t)i * 8 * 512) = rv;
          else { const u32x4 old_ = *(const u32x4*)(oa + (size_t)i * 8 * 512);
#pragma unroll
              for (int e = 0; e < 4; ++e) { dmax = fmaxf(dmax, fabsf(bf2f(rv[e] & 0xffffu) - bf2f(old_[e] & 0xffffu))); dmax = fmaxf(dmax, fabsf(bf2f(rv[e] >> 16) - bf2f(old_[e] >> 16))); } }
      }
      if (PROBE == 1) atomicMax((unsigned*)(ws + WS_DBG), __float_as_uint(dmax));
      LDS_WAIT();
    }
    __syncthreads();
}
template <int PROBE>
__device__ __forceinline__ void fused_attn_phase(const Args& a, LAS unsigned char* lds, int tid) {
    for (int i = blockIdx.x; i < 256; i += gridDim.x) {
        const int bg = i >> 4, s = i & 15, g = bg & 1;
        LAS float* biasL = (LAS float*)(lds + FA_BIAS);
        for (int idx = tid; idx < 4 * 2048; idx += 512) biasL[idx] = a.in[9][rel_bucket(idx & 2047) * 8 + g * 4 + (idx >> 11)] * 1.4426950408889634f;
        __syncthreads();
#pragma unroll 1
        for (int uu = 0; uu < 2; ++uu) { int t2 = tid; asm volatile("" : "+v"(t2)); fused_attn_unit<PROBE>(a, lds, t2, bg >> 1, g, uu ? 31 - s : s); }
        __syncthreads();
    }
}

constexpr size_t DN_WN = 0, DN_QT = 16 * MiB, DN_KTT = 32 * MiB, DN_AQK = 48 * MiB;
constexpr size_t WS_UT = WS_XB, WS_GL = WS_GG;
constexpr int DA_RS = 132;
constexpr int DA_Q = 0, DA_K = 64 * DA_RS * 4, DA_V = 2 * 64 * DA_RS * 4, DA_L = 3 * 64 * DA_RS * 4, DA_GC = DA_L + 64 * 64 * 4, DA_BE = DA_GC + 256, DA_END = DA_BE + 256;
__device__ __forceinline__ void dn_stage_a_unit(const Args& a, LAS unsigned char* lds, int tid, int b, int h, int ci) {
    unsigned char* ws = a.ws;
    const int lane = tid & 63, w = tid >> 6;
    const int tb = b * SEQ, ts0 = ci * 64; const int chunk = (b * 4 + h) * 32 + ci;
    const bf16* qkvb = (const bf16*)(ws + WS_QKVB); const float* sm = (const float*)(ws + WS_SM);
    LAS float* qs = (LAS float*)(lds + DA_Q); LAS float* ks = (LAS float*)(lds + DA_K); LAS float* vs = (LAS float*)(lds + DA_V);
    LAS float* Ls = (LAS float*)(lds + DA_L); LAS float* gcs = (LAS float*)(lds + DA_GC); LAS float* bes = (LAS float*)(lds + DA_BE);
    {
        const float* conv_w = a.in[10];
#pragma unroll
        for (int part = 0; part < 3; ++part) {
            const int ch = part * 512 + h * 128 + 2 * lane;
            float cw0[4], cw1[4];
#pragma unroll
            for (int x = 0; x < 4; ++x) { cw0[x] = conv_w[x * 1536 + ch]; cw1[x] = conv_w[x * 1536 + ch + 1]; }
            float r0[11], r1[11];
#pragma unroll
            for (int i = 0; i < 11; ++i) { const int ts = ts0 + 8 * w - 3 + i;
                unsigned raw = 0u; if (ts >= 0) raw = *(const unsigned*)(qkvb + (size_t)(tb + ts) * 1536 + ch);
                r0[i] = bf2f(raw & 0xffffu); r1[i] = bf2f(raw >> 16); }
            LAS float* dst = (part == 0) ? qs : (part == 1) ? ks : vs;
#pragma unroll
            for (int i = 0; i < 8; ++i) {
                float a0 = 0.f, a1 = 0.f;
#pragma unroll
                for (int x = 0; x < 4; ++x) { a0 = fmaf(cw0[x], r0[i + x], a0); a1 = fmaf(cw1[x], r1[i + x], a1); }
                a0 = siluf_(a0); a1 = siluf_(a1);
                if (part < 2) { float ss = a0 * a0 + a1 * a1;
#pragma unroll
                    for (int o = 32; o > 0; o >>= 1) ss += wshfl_xor(ss, o, tid);
                    const float rn = 1.0f / sqrtf(ss + 1e-6f); a0 *= rn; a1 *= rn; }
                dst[(8 * w + i) * DA_RS + 2 * lane] = a0; dst[(8 * w + i) * DA_RS + 2 * lane + 1] = a1;
            }
        }
        if (w == 0) {
            const size_t row = (size_t)(tb + ts0 + lane);
            const float be = 1.f / (1.f + expf(-sm[row * 32 + 24 + h]));
            const float xx = sm[row * 32 + 28 + h] + a.in[12][h];
            const float sp = (xx > 20.f) ? xx : log1pf(expf(xx));
            float gc = -expf(a.in[11][h]) * sp;
#pragma unroll
            for (int o = 1; o < 64; o <<= 1) { const float up = __int_as_float(__builtin_amdgcn_ds_bpermute(((lane - o) & 63) << 2, __float_as_int(gc))); if (lane >= o) gc += up; }
            gcs[lane] = gc; bes[lane] = be;
            if (lane == 63) ((float*)(ws + WS_GL))[chunk] = expf(gc);
        }
    }
    __syncthreads();
    {
        const int c = tid >> 3, jg = tid & 7;
        float kk[8], qk[8];
#pragma unroll
        for (int jj = 0; jj < 8; ++jj) { kk[jj] = 0.f; qk[jj] = 0.f; }
        for (int d = 0; d < 128; d += 4) {
            const f32x4 kc = *(const LAS f32x4*)(ks + c * DA_RS + d), qc = *(const LAS f32x4*)(qs + c * DA_RS + d);
#pragma unroll
            for (int jj = 0; jj < 8; ++jj) { const f32x4 kj = *(const LAS f32x4*)(ks + (jg + 8 * jj) * DA_RS + d);
                kk[jj] += (kc.x * kj.x + kc.y * kj.y) + (kc.z * kj.z + kc.w * kj.w); qk[jj] += (qc.x * kj.x + qc.y * kj.y) + (qc.z * kj.z + qc.w * kj.w); }
        }
        const float gcc = gcs[c], bec = bes[c];
        bf16* aqk = (bf16*)((unsigned char*)a.out + DN_AQK) + (size_t)chunk * 4096 + c * 64;
#pragma unroll
        for (int jj = 0; jj < 8; ++jj) { const int j = jg + 8 * jj; const float dec = (j <= c) ? expf(gcc - gcs[j]) : 0.f;
            Ls[c * 64 + j] = (j < c) ? bec * kk[jj] * dec : 0.f;
            aqk[j] = (bf16)f2bf(qk[jj] * dec * 0.08838834764831845f); }
    }
    __syncthreads();
    {
        { const int c = tid >> 3, k0 = (tid & 7) * 16; const float f = 0.08838834764831845f * expf(gcs[c]);
          bf16* qt = (bf16*)((unsigned char*)a.out + DN_QT) + (size_t)chunk * 8192 + c * 128 + k0;
#pragma unroll
          for (int k = 0; k < 16; k += 8) { const f32x4 x0 = *(const LAS f32x4*)(qs + c * DA_RS + k0 + k), x1 = *(const LAS f32x4*)(qs + c * DA_RS + k0 + k + 4);
              u32x4 o; o.x = pk2(x0.x * f, x0.y * f); o.y = pk2(x0.z * f, x0.w * f); o.z = pk2(x1.x * f, x1.y * f); o.w = pk2(x1.z * f, x1.w * f); *(u32x4*)(qt + k) = o; } }
        { const int k = tid >> 2, c0 = (tid & 3) * 16; const float gl = gcs[63];
          bf16* ktt = (bf16*)((unsigned char*)a.out + DN_KTT) + (size_t)chunk * 8192 + k * 64 + c0;
#pragma unroll
          for (int c = 0; c < 16; c += 8) { float v[8];
#pragma unroll
              for (int e = 0; e < 8; ++e) v[e] = ks[(c0 + c + e) * DA_RS + k] * expf(gl - gcs[c0 + c + e]);
              u32x4 o; o.x = pk2(v[0], v[1]); o.y = pk2(v[2], v[3]); o.z = pk2(v[4], v[5]); o.w = pk2(v[6], v[7]); *(u32x4*)(ktt + c) = o; } }
    }
    __syncthreads();
    if (tid < 256) {
        LAS float* X = ((tid >= 128) ? vs : ks) + (tid & 127); const bool isv = tid >= 128;
#pragma unroll 1
        for (int c = 0; c < 64; ++c) {
            float acc0 = bes[c] * X[c * DA_RS]; if (!isv) acc0 *= expf(gcs[c]);
            float acc1 = 0.f, acc2 = 0.f, acc3 = 0.f;
            const LAS float* lr = Ls + c * 64;
            int jx = 0;
#pragma unroll 1
            for (; jx + 4 <= c; jx += 4) { const f32x4 lv = *(const LAS f32x4*)(lr + jx);
                acc0 = fmaf(-lv.x, X[(jx + 0) * DA_RS], acc0); acc1 = fmaf(-lv.y, X[(jx + 1) * DA_RS], acc1); acc2 = fmaf(-lv.z, X[(jx + 2) * DA_RS], acc2); acc3 = fmaf(-lv.w, X[(jx + 3) * DA_RS], acc3); }
            for (; jx < c; ++jx) acc0 = fmaf(-lr[jx], X[jx * DA_RS], acc0);
            X[c * DA_RS] = (acc0 + acc1) + (acc2 + acc3);
        }
    }
    __syncthreads();
    {
        { const int c = tid >> 3, k0 = (tid & 7) * 16; bf16* wn = (bf16*)((unsigned char*)a.out + DN_WN) + (size_t)chunk * 8192 + c * 128 + k0;
#pragma unroll
          for (int k = 0; k < 16; k += 8) { const f32x4 x0 = *(const LAS f32x4*)(ks + c * DA_RS + k0 + k), x1 = *(const LAS f32x4*)(ks + c * DA_RS + k0 + k + 4);
              u32x4 o; o.x = pk2(-x0.x, -x0.y); o.y = pk2(-x0.z, -x0.w); o.z = pk2(-x1.x, -x1.y); o.w = pk2(-x1.z, -x1.w); *(u32x4*)(wn + k) = o; } }
        { const int dv = tid & 127, c0 = (tid >> 7) * 16; float* ut = (float*)(ws + WS_UT) + (size_t)chunk * 8192 + dv * 64 + c0;
#pragma unroll
          for (int c = 0; c < 16; c += 4) *(f32x4*)(ut + c) = (f32x4){vs[(c0 + c) * DA_RS + dv], vs[(c0 + c + 1) * DA_RS + dv], vs[(c0 + c + 2) * DA_RS + dv], vs[(c0 + c + 3) * DA_RS + dv]}; }
    }
    __syncthreads();
}
__device__ __forceinline__ void dn_stage_a_phase(const Args& a, LAS unsigned char* lds, int tid) {
    for (int u = blockIdx.x; u < 1024; u += gridDim.x) { int t2 = tid; asm volatile("" : "+v"(t2)); dn_stage_a_unit(a, lds, t2, u >> 7, (u >> 5) & 3, u & 31); }
}
typedef float f32x4v __attribute__((ext_vector_type(4)));
constexpr int DB_ST = 0, DB_VN = 4096;
__device__ __forceinline__ void dn_scan_mfma_phase(const Args& a, LAS unsigned char* lds, int tid) {
    unsigned char* ws = a.ws;
    const int lane = tid & 63, w = __builtin_amdgcn_readfirstlane(tid >> 6), n = lane & 15, kq = lane >> 4;
    for (int u0 = blockIdx.x; u0 < 256; u0 += gridDim.x) {
        const int xcd = u0 & 7, idx = u0 >> 3, bh = xcd * 4 + (idx >> 3), sl = idx & 7, b = bh >> 2, h = bh & 3;
        const size_t chunk0 = (size_t)bh * 32;
        const bf16* WN = (const bf16*)((const unsigned char*)a.out + DN_WN) + chunk0 * 8192;
        const bf16* QT = (const bf16*)((const unsigned char*)a.out + DN_QT) + chunk0 * 8192;
        const bf16* KTT = (const bf16*)((const unsigned char*)a.out + DN_KTT) + chunk0 * 8192;
        const bf16* AQK = (const bf16*)((const unsigned char*)a.out + DN_AQK) + chunk0 * 4096;
        const float* UT = (const float*)(ws + WS_UT) + chunk0 * 8192 + (size_t)(sl * 16) * 64;
        const float* GL = (const float*)(ws + WS_GL) + chunk0;
        float* od = (float*)(ws + WS_OD) + (size_t)(b * SEQ) * 512 + h * 128 + sl * 16;
        for (int i = tid; i < (4096 + 2048) / 4; i += 512) ((LAS unsigned*)(lds + DB_ST))[i] = 0u;
        __syncthreads();
        f32x4v sacc[2]; sacc[0] = (f32x4v){0.f, 0.f, 0.f, 0.f}; sacc[1] = sacc[0];
        const int i = w;
        for (int c = 0; c < 32; ++c) {
            if (w < 4) {
                const bf16* wn = WN + (size_t)c * 8192 + (16 * i + n) * 128 + kq * 8;
                const bf16* qt = QT + (size_t)c * 8192 + (16 * i + n) * 128 + kq * 8;
                bf16x8 wf[4], qf[4], sf[4];
#pragma unroll
                for (int ks = 0; ks < 4; ++ks) { wf[ks] = *(const bf16x8*)(wn + ks * 32); qf[ks] = *(const bf16x8*)(qt + ks * 32); sf[ks] = *(const LAS bf16x8*)(lds + DB_ST + n * 256 + ks * 64 + kq * 16); }
                f32x4v vacc = *(const f32x4v*)(UT + (size_t)c * 8192 + n * 64 + 16 * i + 4 * kq);
                f32x4v oacc = (f32x4v){0.f, 0.f, 0.f, 0.f};
#pragma unroll
                for (int ks = 0; ks < 4; ++ks) { vacc = __builtin_amdgcn_mfma_f32_16x16x32_bf16(wf[ks], sf[ks], vacc, 0, 0, 0); oacc = __builtin_amdgcn_mfma_f32_16x16x32_bf16(qf[ks], sf[ks], oacc, 0, 0, 0); }
                u32x2 pv; pv.x = cvtpk(vacc[0], vacc[1]); pv.y = cvtpk(vacc[2], vacc[3]);
                *(LAS u32x2*)(lds + DB_VN + n * 128 + (16 * i + 4 * kq) * 2) = pv;
                LDS_WAIT();
                __syncthreads();
                bf16x8 vf[2];
#pragma unroll
                for (int k2 = 0; k2 < 2; ++k2) vf[k2] = *(const LAS bf16x8*)(lds + DB_VN + n * 128 + k2 * 64 + kq * 16);
                const bf16* aq = AQK + (size_t)c * 4096 + (16 * i + n) * 64 + kq * 8;
#pragma unroll
                for (int k2 = 0; k2 < 2; ++k2) oacc = __builtin_amdgcn_mfma_f32_16x16x32_bf16(*(const bf16x8*)(aq + k2 * 32), vf[k2], oacc, 0, 0, 0);
                float* op = od + (size_t)(c * 64 + 16 * i + 4 * kq) * 512 + n;
#pragma unroll
                for (int e = 0; e < 4; ++e) op[(size_t)e * 512] = oacc[e];
                const float gl = GL[c];
#pragma unroll
                for (int mt = 0; mt < 2; ++mt) { const int m = 2 * i + mt; const bf16* kt = KTT + (size_t)c * 8192 + (16 * m + n) * 64 + kq * 8;
                    sacc[mt] = sacc[mt] * gl;
#pragma unroll
                    for (int k2 = 0; k2 < 2; ++k2) sacc[mt] = __builtin_amdgcn_mfma_f32_16x16x32_bf16(*(const bf16x8*)(kt + k2 * 32), vf[k2], sacc[mt], 0, 0, 0);
                    u32x2 ps; ps.x = cvtpk(sacc[mt][0], sacc[mt][1]); ps.y = cvtpk(sacc[mt][2], sacc[mt][3]);
                    *(LAS u32x2*)(lds + DB_ST + n * 256 + (16 * m + 4 * kq) * 2) = ps; }
                LDS_WAIT();
                __syncthreads();
            } else { __syncthreads(); __syncthreads(); }
        }
    }
}

__device__ __forceinline__ void dn_scan_phase(const Args& a, LAS unsigned char* lds, int tid) {
    if (tid >= 64) return;
    unsigned char* ws = a.ws; const int lane = tid, kq = lane >> 4, vc = lane & 15;
    const bf16* qn = (const bf16*)a.out; const bf16* kn = qn + (size_t)T * 512; const bf16* vv = kn + (size_t)T * 512;
    const float* gg = (const float*)(ws + WS_GG); const float* bb = (const float*)(ws + WS_BB);
    float* od = (float*)(ws + WS_OD);
    LAS unsigned char* kbuf = lds; LAS unsigned char* qbuf = lds + 16384; LAS unsigned char* vbuf = lds + 32768;
    for (int u = blockIdx.x; u < 256; u += gridDim.x) {
        const int b = u >> 5, h = (u >> 3) & 3, vb = u & 7;
        float S[32];
#pragma unroll
        for (int k = 0; k < 32; ++k) S[k] = 0.f;
        for (int c = 0; c < 32; ++c) {
            const int t0 = b * SEQ + c * 64;
#pragma unroll 4
            for (int i = 0; i < 16; ++i) { const int p = i * 64 + lane, row = p >> 4, ch = p & 15;
                *(LAS u32x4*)(kbuf + row * 256 + ch * 16) = *(const u32x4*)(kn + (size_t)(t0 + row) * 512 + h * 128 + ch * 8);
                *(LAS u32x4*)(qbuf + row * 256 + ch * 16) = *(const u32x4*)(qn + (size_t)(t0 + row) * 512 + h * 128 + ch * 8); }
#pragma unroll
            for (int i = 0; i < 2; ++i) { const int p = i * 64 + lane, row = p >> 1, ch = p & 1;
                *(LAS u32x4*)(vbuf + row * 32 + ch * 16) = *(const u32x4*)(vv + (size_t)(t0 + row) * 512 + h * 128 + vb * 16 + ch * 8); }
            const float gl = gg[(t0 + lane) * 4 + h], bl = bb[(t0 + lane) * 4 + h];
            LDS_WAIT();
            for (int s = 0; s < 64; ++s) {
                const float alpha = expf(__int_as_float(__builtin_amdgcn_readlane(__float_as_int(gl), s)));
                const float beta = __int_as_float(__builtin_amdgcn_readlane(__float_as_int(bl), s));
                const float v = bf2f(*(const LAS bf16*)(vbuf + s * 32 + vc * 2));
                float kk[32];
#pragma unroll
                for (int k8 = 0; k8 < 4; ++k8) { const u32x4 w = *(const LAS u32x4*)(kbuf + s * 256 + kq * 64 + k8 * 16);
                    kk[k8 * 8 + 0] = bf2f(w.x & 0xffffu); kk[k8 * 8 + 1] = bf2f(w.x >> 16); kk[k8 * 8 + 2] = bf2f(w.y & 0xffffu); kk[k8 * 8 + 3] = bf2f(w.y >> 16);
                    kk[k8 * 8 + 4] = bf2f(w.z & 0xffffu); kk[k8 * 8 + 5] = bf2f(w.z >> 16); kk[k8 * 8 + 6] = bf2f(w.w & 0xffffu); kk[k8 * 8 + 7] = bf2f(w.w >> 16); }
                float kS = 0.f;
#pragma unroll
                for (int k = 0; k < 32; ++k) { S[k] *= alpha; kS = fmaf(kk[k], S[k], kS); }
                kS += wshfl_xor(kS, 16, tid); kS += wshfl_xor(kS, 32, tid);
                const float vn = beta * (v - kS);
                float o = 0.f;
#pragma unroll
                for (int k8 = 0; k8 < 4; ++k8) { const u32x4 wq = *(const LAS u32x4*)(qbuf + s * 256 + kq * 64 + k8 * 16);
                    const float qq[8] = {bf2f(wq.x & 0xffffu), bf2f(wq.x >> 16), bf2f(wq.y & 0xffffu), bf2f(wq.y >> 16), bf2f(wq.z & 0xffffu), bf2f(wq.z >> 16), bf2f(wq.w & 0xffffu), bf2f(wq.w >> 16)};
#pragma unroll
                    for (int e = 0; e < 8; ++e) { S[k8 * 8 + e] = fmaf(kk[k8 * 8 + e], vn, S[k8 * 8 + e]); o = fmaf(qq[e], S[k8 * 8 + e], o); } }
                o += wshfl_xor(o, 16, tid); o += wshfl_xor(o, 32, tid);
                if (kq == 0) od[(size_t)(t0 + s) * 512 + h * 128 + vb * 16 + vc] = o * 0.08838834764831845f;
            }
            LDS_WAIT();
        }
    }
}

__device__ __forceinline__ void dn_out_phase(const Args& a, LAS unsigned char* lds, int tid) {
    unsigned char* ws = a.ws; const float* od = (const float*)(ws + WS_OD); const bf16* zb = (const bf16*)(ws + WS_ZB); const float* norm_w = a.in[13];
    bf16* ob = (bf16*)a.out;
    LAS float* red = (LAS float*)lds;
    const int h = tid >> 7, d = tid & 127, wave = tid >> 6; const float nw = norm_w[d];
    for (int t = blockIdx.x; t < T; t += gridDim.x) {
        const size_t o = (size_t)t * 512 + h * 128 + d;
        const float v = od[o]; float s = v * v;
#pragma unroll
        for (int off = 32; off > 0; off >>= 1) s += wshfl_xor(s, off, tid);
        if ((tid & 63) == 0) red[wave] = s;
        __syncthreads();
        s = (red[h * 2] + red[h * 2 + 1]) * (1.f / 128.f);
        ob[o] = (bf16)f2bf(v * (1.0f / sqrtf(s + 1e-6f)) * nw * bf2f(zb[o]));
        __syncthreads();
    }
}

__device__ __forceinline__ void final_ln_phase(const Args& a, int tid) {
    const int lane = tid & 63, wave = tid >> 6; const int gw = blockIdx.x * 8 + wave, NGW = gridDim.x * 8;
    const float* ln_g = a.in[19]; const float* ln_b = a.in[20];
    f32x4 gv[4], bv[4];
#pragma unroll
    for (int j = 0; j < 4; ++j) { gv[j] = ((const f32x4*)ln_g)[lane + 64 * j]; bv[j] = ((const f32x4*)ln_b)[lane + 64 * j]; }
    for (int m = gw; m < T; m += NGW) {
        f32x4* xr = (f32x4*)(a.out + (size_t)m * 1024) + lane;
        f32x4 v[4]; float s = 0.f;
#pragma unroll
        for (int j = 0; j < 4; ++j) { v[j] = xr[64 * j]; s += (v[j].x + v[j].y) + (v[j].z + v[j].w); }
#pragma unroll
        for (int o = 1; o < 64; o <<= 1) s += wshfl_xor(s, o, tid);
        const float mean = s * (1.f / 1024.f); float s2 = 0.f;
#pragma unroll
        for (int j = 0; j < 4; ++j) { v[j] = v[j] - mean; s2 += (v[j].x * v[j].x + v[j].y * v[j].y) + (v[j].z * v[j].z + v[j].w * v[j].w); }
#pragma unroll
        for (int o = 1; o < 64; o <<= 1) s2 += wshfl_xor(s2, o, tid);
        const float rstd = 1.0f / sqrtf(s2 * (1.f / 1024.f) + 1e-5f);
#pragma unroll
        for (int j = 0; j < 4; ++j) xr[64 * j] = v[j] * rstd * gv[j] + bv[j];
    }
}

__global__ void __launch_bounds__(512, 2) mega_fwd(Args a) {
    extern __shared__ __attribute__((aligned(16))) unsigned char lds_raw[];
    LAS unsigned char* lds = (LAS unsigned char*)lds_raw;
    cg::grid_group grid = cg::this_grid();
    int tid = threadIdx.x; const int G = gridDim.x;
    unsigned char* ws = a.ws;
#ifdef PROBE_TS
    unsigned long long ts_prev = __builtin_amdgcn_s_memrealtime(); int ts_n = 0; float ts_val = 0.f;
#define STAMP() do { const unsigned long long t_ = __builtin_amdgcn_s_memrealtime(); if (ts_n == PROBE_TS) ts_val = (float)(t_ - ts_prev) * 1e-3f; ts_prev = t_; ++ts_n; } while (0)
#else
#define STAMP() do {} while (0)
#endif
#define FRESH_TID() do { tid = threadIdx.x; asm volatile("" : "+v"(tid)); } while (0)

    FRESH_TID();
    p0_prologue(a, lds, tid);
    grid.sync(); STAMP();
    { pg8::Gemm g{(const pg8::bf16_t*)(ws + WS_XB), (const pg8::bf16_t*)(ws + WS_WIN), T, 6144, 1024}; pg8::StaticOrder S; S.init(T, 6144, G, (int)blockIdx.x);
      EpiProj E{ws}; pg8::gemm_phase<EpiProj, pg8::StaticOrder, true, true>(lds, g, S, E); }
    grid.sync(); STAMP();
#if !defined(PROBE_FUSED)
#ifdef DN_SEQ
    FRESH_TID(); dn_prep_phase(a, lds, tid);
#else
    FRESH_TID(); dn_stage_a_phase(a, lds, tid);
#endif
    __syncthreads();
    FRESH_TID(); cmp_gemm1_phase(a, lds, tid);
    grid.sync(); STAMP();
    FRESH_TID(); cmp_gemm2_phase(a, lds, tid);
    __syncthreads();
#ifdef DN_SEQ
    FRESH_TID(); dn_scan_phase(a, lds, tid);
#else
    FRESH_TID(); dn_scan_mfma_phase(a, lds, tid);
#endif
    grid.sync(); STAMP();
    FRESH_TID(); fused_attn_phase<0>(a, lds, tid);
    __syncthreads();
    FRESH_TID(); dn_out_phase(a, lds, tid);
    grid.sync(); STAMP();
#else
    FRESH_TID(); dn_prep_phase(a, lds, tid);
    __syncthreads();
    FRESH_TID(); cmp_gemm1_phase(a, lds, tid);
    __syncthreads();
    FRESH_TID(); attn_mfma_phase<2, false>(a, lds, tid);
    grid.sync();
    FRESH_TID(); cmp_gemm2_phase(a, lds, tid);
    __syncthreads();
    FRESH_TID(); dn_scan_phase(a, lds, tid);
    grid.sync();
    FRESH_TID(); attn_simple_phase<0>(a, lds, tid);
    grid.sync();
    FRESH_TID(); attn_mfma_phase<1, false>(a, lds, tid);
    grid.sync();
    FRESH_TID(); fused_attn_phase<PROBE_FUSED>(a, lds, tid);
    __syncthreads();
    FRESH_TID(); dn_out_phase(a, lds, tid);
    grid.sync();
#endif
    { pg8::Gemm g{(const pg8::bf16_t*)(ws + WS_OA), (const pg8::bf16_t*)(ws + WS_WA), T, 1024, 512}; pg8::StaticOrder S; S.init(T, 1024, G, (int)blockIdx.x);
      EpiYA E{(const bf16*)(ws + WS_GM), (float*)(ws + WS_PARTA)}; pg8::gemm_phase<EpiYA, pg8::StaticOrder, true, true>(lds, g, S, E); }
    { pg8::Gemm g{(const pg8::bf16_t*)a.out, (const pg8::bf16_t*)(ws + WS_WB), T, 1024, 512}; pg8::StaticOrder S; S.init(T, 1024, G, (int)blockIdx.x);
      EpiYB E{(const bf16*)(ws + WS_GM), (const float*)(ws + WS_PARTA), (bf16*)(ws + WS_M)}; pg8::gemm_phase<EpiYB, pg8::StaticOrder, true, true>(lds, g, S, E); }
    grid.sync(); STAMP();
    { pg8::Gemm g{(const pg8::bf16_t*)(ws + WS_M), (const pg8::bf16_t*)(ws + WS_WOUT), T, 1024, 1024}; pg8::StaticOrder S; S.init(T, 1024, G, (int)blockIdx.x);
      EpiH E{a.in[0], (float*)(ws + WS_H), (bf16*)(ws + WS_HB)}; pg8::gemm_phase<EpiH, pg8::StaticOrder, true, true>(lds, g, S, E); }
    { pg8::Gemm g{(const pg8::bf16_t*)(ws + WS_PB), (const pg8::bf16_t*)(ws + WS_WPLE), T, 1024, 256}; pg8::StaticOrder S; S.init(T, 1024, G, (int)blockIdx.x);
      EpiPE E{(float*)(ws + WS_PE)}; pg8::gemm_phase<EpiPE, pg8::StaticOrder, true, true>(lds, g, S, E); }
    grid.sync(); STAMP();
    { pg8::Gemm g{(const pg8::bf16_t*)(ws + WS_HB), (const pg8::bf16_t*)(ws + WS_WPG), T, 1024, 1024}; pg8::StaticOrder S; S.init(T, 1024, G, (int)blockIdx.x);
      EpiGate E{(const float*)(ws + WS_H), (const float*)(ws + WS_PE), a.out}; pg8::gemm_phase<EpiGate, pg8::StaticOrder, true, true>(lds, g, S, E); }
    grid.sync(); STAMP();
    FRESH_TID(); final_ln_phase(a, tid);
#if defined(PROBE_WIN) || defined(PROBE_SEL) || defined(PROBE_FUSED)
    if (blockIdx.x == 0 && threadIdx.x == 0) a.out[0] += *(const float*)(ws + WS_DBG) * (PROBE_SCALE);
#endif
#ifdef PROBE_TS
    STAMP();
    if (blockIdx.x == 0 && threadIdx.x == 0) a.out[0] += ts_val;
#endif
}

extern "C" void kernel_launch(void* const* d_in, const int* in_sizes, int n_in, void* d_out, int out_size, void* d_ws, size_t ws_size, hipStream_t stream) {
    static int grid = 0;
    if (grid == 0) {
        if (n_in != 21 || out_size != T * DM || ws_size < WS_END) { fprintf(stderr, "kernel_launch: unexpected shapes (n_in %d out %d ws %zu)\n", n_in, out_size, ws_size); grid = -1; return; }
        int dev = 0, cus = 0, per_cu = 0;
        hipGetDevice(&dev); hipDeviceGetAttribute(&cus, hipDeviceAttributeMultiprocessorCount, dev);
        hipFuncSetAttribute((const void*)mega_fwd, hipFuncAttributeMaxDynamicSharedMemorySize, LDS_BYTES);
        hipOccupancyMaxActiveBlocksPerMultiprocessor(&per_cu, (const void*)mega_fwd, 512, LDS_BYTES);
        if (per_cu < 1) { fprintf(stderr, "kernel_launch: occupancy query says %d blocks/CU\n", per_cu); per_cu = 1; }
        grid = cus;
        (void)hipGetLastError();
    }
    if (grid < 0) return;
    Args a{};
    for (int i = 0; i < 21; ++i) a.in[i] = (const float*)d_in[i];
    a.out = (float*)d_out; a.ws = (unsigned char*)d_ws;
    void* args[] = {&a};
    hipError_t e = hipLaunchCooperativeKernel((const void*)mega_fwd, dim3(grid), dim3(512), args, LDS_BYTES, stream);
    if (e != hipSuccess) fprintf(stderr, "cooperative launch failed: %s (grid %d)\n", hipGetErrorString(e), grid);
}
```

```cpp
#include <hip/hip_runtime.h>
#include <hip/hip_cooperative_groups.h>
#include <cstdio>
#include <cstdint>
#include <cmath>
namespace cg = cooperative_groups;
namespace pg8 {
#define PG8_LAS __attribute__((address_space(3)))
typedef unsigned short bf16_t;
typedef short bf16x8 __attribute__((ext_vector_type(8)));
typedef float f32x4 __attribute__((ext_vector_type(4)));
typedef unsigned u32x4 __attribute__((ext_vector_type(4)));
constexpr int BM = 256, BK = 64, HALF = 128, HTB = HALF * BK * 2  , STAGE_BYTES = 8 * HTB, NXCD = 8, WGM = 8;

__host__ __device__ __forceinline__ int lds_byte(int r, int c) { const int st = (r >> 4) * 2 + (c >> 5), rr = r & 15, cc = c & 31, ob = rr * 64 + cc * 2; return st * 1024 + (ob ^ (((ob >> 9) & 1) << 5)); }
__host__ __device__ __forceinline__ void stage_rc(int b, int& R, int& C) { const int st = b / 1024, sb = b % 1024, swz = sb ^ (((sb >> 9) & 1) << 5); R = (st >> 1) * 16 + swz / 64; C = (st & 1) * 32 + (swz % 64) / 2; }
__host__ __device__ __forceinline__ int perm32(int rho) { const int n = rho >> 4, i = rho & 15; return 8 * (i >> 2) + 4 * n + (i & 3); }

struct Unit { int pm, pn; };
struct Gemm { const bf16_t* A; const bf16_t* Bt; int M, N, K; };

struct StaticOrder {
    int nM, nN, nwg, G, c;
    __host__ __device__ void init(int M, int N, int G_, int c_) { nM = M / BM; nN = N / BM; nwg = nM * nN; G = G_; c = c_; }
    __host__ __device__ bool next(int i, Unit& u) const {
        const long L = (long)i * G + c; if (L >= nwg) return false;
        int wgid = (int)L; { const int q = nwg / NXCD, r = nwg % NXCD, xcd = wgid % NXCD, off = wgid / NXCD; wgid = (xcd < r ? xcd * (q + 1) : r * (q + 1) + (xcd - r) * q) + off; }
        const int nig = WGM * nN, gid = wgid / nig, fm = gid * WGM, gsz = (nM - fm) < WGM ? (nM - fm) : WGM;
        u.pm = fm + ((wgid % nig) % gsz); u.pn = (wgid % nig) / gsz; return true;
    }
    __device__ __forceinline__ void a_ready(const Unit&) const {}
    __device__ __forceinline__ void done(const Unit&) const {}
};

__device__ __forceinline__ unsigned cvt_pk_bf16(float lo, float hi) { unsigned r; asm volatile("v_cvt_pk_bf16_f32 %0, %1, %2" : "=v"(r) : "v"(lo), "v"(hi)); return r; }
typedef float f32x2 __attribute__((ext_vector_type(2)));
template <class Epi, class Sched, bool ALIGN_EPI = false, bool SP2 = false>
__device__ __forceinline__ void gemm_phase(PG8_LAS unsigned char* lds, const Gemm g, const Sched& S, const Epi& E) {
    int tid_ = threadIdx.x; asm volatile("" : "+v"(tid_)); const int tid = tid_, wid = __builtin_amdgcn_readfirstlane(tid >> 6), lane = tid & 63, wr = wid >> 2, wc = wid & 3, fr = lane & 15, fq = lane >> 4;
    const int K = g.K, nt = K / BK;
    unsigned voffA[2], voffB[2];
#pragma unroll
    for (int i = 0; i < 2; ++i) { int R, C; stage_rc(tid * 16 + i * 8192, R, C); const int Rb = Epi::PERM ? ((R & ~31) + perm32(R & 31)) : R;
        voffA[i] = (unsigned)(R * K + C) * 2u; voffB[i] = (unsigned)(Rb * K + C) * 2u; }
    const size_t kstep = (size_t)(BK * 2);
    const size_t hstep = (size_t)HALF * K * 2;
    const size_t tstep = 2 * hstep;
    const unsigned ldsw = (unsigned)wid * 1024u;
    const int aoff = lds_byte(wr * 64 + fr, fq * 8), boff = lds_byte(wc * 32 + fr, fq * 8);
#define PG8_SA(b, h) (((b) * 2 + (h)) * HTB)
#define PG8_SB(b, h) ((4 + (b) * 2 + (h)) * HTB)
#define PG8_STAGE(bufoff, gbase, voff) do { _Pragma("unroll") for (int _i = 0; _i < 2; ++_i) \
        __builtin_amdgcn_global_load_lds((const unsigned*)((const char*)(gbase) + (voff)[_i]), (PG8_LAS unsigned*)(lds + (bufoff) + ldsw + _i * 8192), 16, 0, 0); } while (0)
#define PG8_LDA(dst, b, h) do { _Pragma("unroll") for (int m = 0; m < 4; ++m) _Pragma("unroll") for (int k = 0; k < 2; ++k) dst[m][k] = *(const PG8_LAS bf16x8*)(lds + PG8_SA(b, h) + aoff + m * 2048 + k * 1024); } while (0)
#define PG8_LDB(dst, b, h) do { _Pragma("unroll") for (int n = 0; n < 2; ++n) _Pragma("unroll") for (int k = 0; k < 2; ++k) dst[n][k] = *(const PG8_LAS bf16x8*)(lds + PG8_SB(b, h) + boff + n * 2048 + k * 1024); } while (0)
#define PG8_MMA(ai, bj, At, Bt) do { __builtin_amdgcn_s_setprio(1); _Pragma("unroll") for (int m = 0; m < 4; ++m) _Pragma("unroll") for (int n = 0; n < 2; ++n) _Pragma("unroll") for (int k = 0; k < 2; ++k) \
        acc[ai][bj][m][n] = __builtin_amdgcn_mfma_f32_16x16x32_bf16(Bt[n][k], At[m][k], acc[ai][bj][m][n], 0, 0, 0); __builtin_amdgcn_s_setprio(0); } while (0)
#define PG8_WAIT_V(n) asm volatile("s_waitcnt vmcnt(" #n ")" ::: "memory")
#define PG8_WAIT_L(n) asm volatile("s_waitcnt lgkmcnt(" #n ")" ::: "memory")
#define PG8_BAR __builtin_amdgcn_s_barrier()
#define PG8_SCHED __builtin_amdgcn_sched_barrier(0)
    Unit cur, nxt; int ui = 0;
    if (!S.next(0, cur)) return;
    f32x4 acc[2][2][4][2];
#pragma unroll
    for (int a = 0; a < 2; ++a)
#pragma unroll
        for (int b = 0; b < 2; ++b)
#pragma unroll
            for (int m = 0; m < 4; ++m)
#pragma unroll
                for (int n = 0; n < 2; ++n) acc[a][b][m][n] = (f32x4){0.f, 0.f, 0.f, 0.f};
    bf16x8 At[4][2], B0[2][2], B1[2][2];
    const char* cA = (const char*)g.A + (size_t)cur.pm * tstep; const char* cB = (const char*)g.Bt + (size_t)cur.pn * tstep;
    S.a_ready(cur);
    if constexpr (SP2) {
        PG8_STAGE(PG8_SB(0, 0), cB, voffB); PG8_STAGE(PG8_SB(0, 1), cB + hstep, voffB); PG8_STAGE(PG8_SA(0, 0), cA, voffA); PG8_STAGE(PG8_SA(0, 1), cA + hstep, voffA);
        if (wr == 1) PG8_BAR;
        PG8_WAIT_V(2); PG8_BAR;
        PG8_STAGE(PG8_SB(1, 0), cB + kstep, voffB); PG8_STAGE(PG8_SA(1, 0), cA + kstep, voffA); PG8_STAGE(PG8_SB(1, 1), cB + hstep + kstep, voffB);
        PG8_WAIT_V(6); PG8_BAR;
    } else {
        PG8_STAGE(PG8_SB(0, 0), cB, voffB); PG8_STAGE(PG8_SA(0, 0), cA, voffA); PG8_STAGE(PG8_SB(0, 1), cB + hstep, voffB); PG8_STAGE(PG8_SA(0, 1), cA + hstep, voffA);
        if (wr == 1) PG8_BAR;
        PG8_WAIT_V(4); PG8_BAR;
        PG8_STAGE(PG8_SB(1, 0), cB + kstep, voffB); PG8_STAGE(PG8_SA(1, 0), cA + kstep, voffA); PG8_STAGE(PG8_SB(1, 1), cB + hstep + kstep, voffB);
        PG8_WAIT_V(6); PG8_BAR;
    }
    for (;;) {
        const bool has_next = S.next(ui + 1, nxt);
        const char* nA = has_next ? (const char*)g.A + (size_t)nxt.pm * tstep : cA; const char* nB = has_next ? (const char*)g.Bt + (size_t)nxt.pn * tstep : cB;
        for (int t = 0; t < nt; t += 2) {
            const bool last = (t == nt - 2);
            const char* a1 = cA + (size_t)(t + 1) * kstep;
            const char* a2 = last ? nA : cA + (size_t)(t + 2) * kstep; const char* b2 = last ? nB : cB + (size_t)(t + 2) * kstep;
            const char* a3 = a2 + kstep; const char* b3 = b2 + kstep;
            if (last && has_next) S.a_ready(nxt);
            if constexpr (SP2) {
            PG8_LDB(B0, 0, 0); PG8_LDB(B1, 0, 1); PG8_SCHED; PG8_LDA(At, 0, 0); PG8_STAGE(PG8_SA(1, 1), a1 + hstep, voffA);
            PG8_WAIT_V(8); PG8_WAIT_L(0); PG8_BAR; PG8_MMA(0, 0, At, B0); PG8_MMA(0, 1, At, B1); PG8_BAR; PG8_SCHED;
            PG8_LDA(At, 0, 1); PG8_STAGE(PG8_SB(0, 0), b2, voffB); PG8_STAGE(PG8_SB(0, 1), b2 + hstep, voffB); PG8_STAGE(PG8_SA(0, 0), a2, voffA);
            PG8_WAIT_V(8); PG8_WAIT_L(0); PG8_BAR; PG8_MMA(1, 0, At, B0); PG8_MMA(1, 1, At, B1); PG8_BAR; PG8_SCHED;
            PG8_LDB(B0, 1, 0); PG8_LDB(B1, 1, 1); PG8_SCHED; PG8_LDA(At, 1, 0); PG8_STAGE(PG8_SA(0, 1), a2 + hstep, voffA);
            PG8_WAIT_V(8); PG8_WAIT_L(0); PG8_BAR; PG8_MMA(0, 0, At, B0); PG8_MMA(0, 1, At, B1); PG8_BAR; PG8_SCHED;
            PG8_LDA(At, 1, 1); PG8_STAGE(PG8_SB(1, 0), b3, voffB); PG8_STAGE(PG8_SB(1, 1), b3 + hstep, voffB); PG8_STAGE(PG8_SA(1, 0), a3, voffA);
            PG8_WAIT_V(8); PG8_WAIT_L(0); PG8_BAR; PG8_MMA(1, 0, At, B0); PG8_MMA(1, 1, At, B1); PG8_BAR; PG8_SCHED;
            } else {
            PG8_LDB(B0, 0, 0); PG8_SCHED; PG8_LDA(At, 0, 0); PG8_STAGE(PG8_SA(1, 1), a1 + hstep, voffA);
            PG8_WAIT_L(8); PG8_BAR; PG8_WAIT_L(0); PG8_MMA(0, 0, At, B0); PG8_BAR; PG8_SCHED;
            PG8_LDB(B1, 0, 1); PG8_STAGE(PG8_SB(0, 0), b2, voffB);
            PG8_BAR; PG8_WAIT_L(0); PG8_MMA(0, 1, At, B1); PG8_BAR;
            PG8_LDA(At, 0, 1); PG8_STAGE(PG8_SA(0, 0), a2, voffA);
            PG8_BAR; PG8_WAIT_L(0); PG8_MMA(1, 0, At, B0); PG8_BAR; PG8_SCHED;
            PG8_STAGE(PG8_SB(0, 1), b2 + hstep, voffB);
            PG8_WAIT_V(6); PG8_BAR; PG8_MMA(1, 1, At, B1); PG8_BAR;
            PG8_LDB(B0, 1, 0); PG8_SCHED; PG8_LDA(At, 1, 0); PG8_STAGE(PG8_SA(0, 1), a2 + hstep, voffA);
            PG8_WAIT_L(8); PG8_BAR; PG8_WAIT_L(0); PG8_MMA(0, 0, At, B0); PG8_BAR; PG8_SCHED;
            PG8_LDB(B1, 1, 1); PG8_STAGE(PG8_SB(1, 0), b3, voffB);
            PG8_BAR; PG8_WAIT_L(0); PG8_MMA(0, 1, At, B1); PG8_BAR;
            PG8_LDA(At, 1, 1); PG8_STAGE(PG8_SA(1, 0), a3, voffA);
            PG8_BAR; PG8_WAIT_L(0); PG8_MMA(1, 0, At, B0); PG8_BAR; PG8_SCHED;
            PG8_STAGE(PG8_SB(1, 1), b3 + hstep, voffB);
            PG8_WAIT_V(6); PG8_BAR; PG8_MMA(1, 1, At, B1); PG8_BAR;
            }
        }
        if constexpr (ALIGN_EPI) { if (wr == 0) PG8_BAR; }
        if constexpr (!Epi::AFTER_DRAIN) { E(acc, cur, wr, wc, fr, fq); S.done(cur); }
        if (!has_next) break;
#pragma unroll
        for (int a = 0; a < 2; ++a)
#pragma unroll
            for (int b = 0; b < 2; ++b)
#pragma unroll
                for (int m = 0; m < 4; ++m)
#pragma unroll
                    for (int n = 0; n < 2; ++n) acc[a][b][m][n] = (f32x4){0.f, 0.f, 0.f, 0.f};
        cur = nxt; cA = nA; cB = nB; ++ui;
        if constexpr (ALIGN_EPI) { if (wr == 1) PG8_BAR; }
    }
    PG8_WAIT_V(0);
    if constexpr (!ALIGN_EPI) { if (wr == 0) PG8_BAR; }
    PG8_BAR;
    if constexpr (Epi::AFTER_DRAIN) { E.fused(acc, cur, wr, wc, fr, fq, lds, wid, lane); S.done(cur); }
#undef PG8_SA
#undef PG8_SB
#undef PG8_STAGE
#undef PG8_LDA
#undef PG8_LDB
#undef PG8_MMA
#undef PG8_WAIT_V
#undef PG8_WAIT_L
#undef PG8_BAR
#undef PG8_SCHED
}
}

constexpr int T = 16384, SEQ = 2048, DM = 1024;
constexpr float ALPHA = 1.189207115002721f;
typedef unsigned short bf16;
typedef unsigned u32;
typedef unsigned u32x4 __attribute__((ext_vector_type(4)));
typedef unsigned u32x2 __attribute__((ext_vector_type(2)));
typedef float f32x4 __attribute__((ext_vector_type(4)));
typedef short bf16x8 __attribute__((ext_vector_type(8)));
#define LAS __attribute__((address_space(3)))
constexpr size_t MiB = (size_t)1 << 20;
constexpr size_t WS_WIN = 1 * MiB, WS_W1K = 13 * MiB, WS_W1V = 14 * MiB, WS_WA = 15 * MiB, WS_WB = 16 * MiB, WS_WOUT = 17 * MiB, WS_WPG = 19 * MiB, WS_WPLE = 21 * MiB;
constexpr size_t WS_PB = 22 * MiB, WS_SM = 30 * MiB, WS_XB = 32 * MiB, WS_Q = 64 * MiB, WS_KV = 80 * MiB, WS_ZA = 104 * MiB, WS_QKVB = 120 * MiB, WS_ZB = 168 * MiB, WS_GM = 184 * MiB;
constexpr size_t WS_HID = 248 * MiB, WS_KC = 250 * MiB, WS_VC = 250 * MiB + 512 * 1024, WS_SEL = 251 * MiB, WS_GG = 251 * MiB + 256 * 1024, WS_BB = 251 * MiB + 512 * 1024, WS_TBL = 252 * MiB, WS_DBG = 254 * MiB, WS_C1 = 254 * MiB + 8192, WS_KCB = 254 * MiB + 65536, WS_VCB = 254 * MiB + 65536 + 262144, WS_END = 255 * MiB;
constexpr size_t WS_OACC = WS_XB, WS_OD = WS_QKVB, WS_OA = WS_QKVB + 32 * MiB, WS_PARTA = 32 * MiB, WS_M = 96 * MiB, WS_H = 32 * MiB, WS_HB = 128 * MiB, WS_PE = 184 * MiB;
constexpr int LDS_BYTES = 147456;
constexpr int NDI = 28;

__device__ __forceinline__ float bf2f(unsigned v) { return __uint_as_float(v << 16); }
__device__ __forceinline__ unsigned f2bf(float f) { unsigned u = __float_as_uint(f); return (u + 0x7fffu + ((u >> 16) & 1u)) >> 16; }
__device__ __forceinline__ unsigned pk2(float lo, float hi) { return f2bf(lo) | (f2bf(hi) << 16); }
__device__ __forceinline__ float fexp(float x) { return __builtin_amdgcn_exp2f(x * 1.4426950408889634f); }
__device__ __forceinline__ float sigm(float x) { return __builtin_amdgcn_rcpf(1.f + fexp(-x)); }
__device__ __forceinline__ float siluf_(float x) { return x * sigm(x); }
__device__ __forceinline__ int rel_bucket(int n) {
    if (n < 16) return n < 0 ? 0 : n;
    return 16 + (n >= 21) + (n >= 27) + (n >= 35) + (n >= 46) + (n >= 59) + (n >= 77) + (n >= 99) + (n >= 128) + (n >= 166) + (n >= 216) + (n >= 280) + (n >= 363) + (n >= 470) + (n >= 609) + (n >= 790);
}
#define LDS_WAIT() asm volatile("s_waitcnt lgkmcnt(0)" ::: "memory")
typedef float f32x16 __attribute__((ext_vector_type(16)));
typedef short s16x4 __attribute__((ext_vector_type(4)));
__device__ __forceinline__ int crow(int r, int hi) { return (r & 3) + 8 * (r >> 2) + 4 * hi; }
__device__ __forceinline__ float wshfl_xor(float v, int o, int tid) { return __int_as_float(__builtin_amdgcn_ds_bpermute(((tid ^ o) & 63) << 2, __float_as_int(v))); }

#if defined(PROBE_FUSED)
#define PROBE_SCALE ((PROBE_FUSED) == 2 ? 1.f : 1000.f)
#else
#define PROBE_SCALE 1000.f
#endif
struct Args { const float* in[21]; float* out; unsigned char* ws; };

__device__ __forceinline__ int win_srccol(int r) {
    if (r < 1280) return r;
    if (r < 3328) return r + 24;
    if (r < 5888) return r + 32;
    if (r < 5912) return 1280 + (r - 5888);
    if (r < 5916) return 3352 + (r - 5912);
    if (r < 5920) return 3356 + (r - 5916);
    return -1;
}
template <bool REMAP>
__device__ __forceinline__ void transpose_item(const float* __restrict__ W, int K, int N, bf16* __restrict__ WT, LAS float* scr, int k0, int n0, int lane) {
    const int sc = REMAP ? win_srccol(n0 + (lane & 31)) : n0 + (lane & 31);
#pragma unroll 8
    for (int i = 0; i < 32; ++i) { const int kk = 2 * i + (lane >> 5); scr[kk * 33 + (lane & 31)] = (sc >= 0) ? W[(size_t)(k0 + kk) * N + sc] : 0.f; }
    LDS_WAIT();
    const int c = lane & 7;
#pragma unroll
    for (int j = 0; j < 4; ++j) { const int n = (lane >> 3) + 8 * j; const LAS float* s = scr + (8 * c) * 33 + n;
        u32x4 o; o.x = pk2(s[0 * 33], s[1 * 33]); o.y = pk2(s[2 * 33], s[3 * 33]); o.z = pk2(s[4 * 33], s[5 * 33]); o.w = pk2(s[6 * 33], s[7 * 33]);
        *(u32x4*)(WT + (size_t)(n0 + n) * K + k0 + 8 * c) = o; }
    LDS_WAIT();
}
__device__ __forceinline__ void p0_prologue(const Args& a, LAS unsigned char* lds, int tid) {
    const int lane = tid & 63, wave = tid >> 6;
    LAS float* scr = (LAS float*)(lds + wave * 8704);
    const int gw = blockIdx.x * 8 + wave, NGW = gridDim.x * 8;
    unsigned char* ws = a.ws;
    constexpr int I_WIN = 16 * 192, I_W1 = 32 * 8, I_WAB = 8 * 32, I_WSQ = 16 * 32, I_WPLE = 4 * 32;
    constexpr int NITEMS = I_WIN + 2 * I_W1 + 2 * I_WAB + 2 * I_WSQ + I_WPLE;
    for (int it = gw; it < NITEMS; it += NGW) {
        int r = it;
        if (r < I_WIN) { transpose_item<true>(a.in[2], 1024, 5920, (bf16*)(ws + WS_WIN), scr, (r / 192) * 64, (r % 192) * 32, lane); continue; } r -= I_WIN;
        if (r < I_W1) { transpose_item<false>(a.in[5], 2048, 256, (bf16*)(ws + WS_W1K), scr, (r / 8) * 64, (r % 8) * 32, lane); continue; } r -= I_W1;
        if (r < I_W1) { transpose_item<false>(a.in[7], 2048, 256, (bf16*)(ws + WS_W1V), scr, (r / 8) * 64, (r % 8) * 32, lane); continue; } r -= I_W1;
        if (r < I_WAB) { transpose_item<false>(a.in[14], 512, 1024, (bf16*)(ws + WS_WA), scr, (r / 32) * 64, (r % 32) * 32, lane); continue; } r -= I_WAB;
        if (r < I_WAB) { transpose_item<false>(a.in[15], 512, 1024, (bf16*)(ws + WS_WB), scr, (r / 32) * 64, (r % 32) * 32, lane); continue; } r -= I_WAB;
        if (r < I_WSQ) { transpose_item<false>(a.in[16], 1024, 1024, (bf16*)(ws + WS_WOUT), scr, (r / 32) * 64, (r % 32) * 32, lane); continue; } r -= I_WSQ;
        if (r < I_WSQ) { transpose_item<false>(a.in[18], 1024, 1024, (bf16*)(ws + WS_WPG), scr, (r / 32) * 64, (r % 32) * 32, lane); continue; } r -= I_WSQ;
        transpose_item<false>(a.in[17], 256, 1024, (bf16*)(ws + WS_WPLE), scr, (r / 32) * 64, (r % 32) * 32, lane);
    }
    const float* x = a.in[0]; bf16* xb = (bf16*)(ws + WS_XB);
    for (int m = gw; m < T; m += NGW) {
        const f32x4* xr = (const f32x4*)(x + (size_t)m * 1024) + lane; u32x2* o = (u32x2*)(xb + (size_t)m * 1024) + lane;
#pragma unroll
        for (int j = 0; j < 4; ++j) { const f32x4 v = xr[64 * j]; u32x2 w; w.x = pk2(v.x, v.y); w.y = pk2(v.z, v.w); o[64 * j] = w; }
    }
    const float* p = a.in[1]; bf16* pb = (bf16*)(ws + WS_PB);
    for (int m = gw; m < T; m += NGW) {
        const f32x4 v = ((const f32x4*)(p + (size_t)m * 256))[lane]; u32x2 w; w.x = pk2(v.x, v.y); w.y = pk2(v.z, v.w); ((u32x2*)(pb + (size_t)m * 256))[lane] = w;
    }
    { const float* rel_bias = a.in[9]; bf16* tbl = (bf16*)(ws + WS_TBL);
      for (int idx = blockIdx.x * 512 + tid; idx < 2 * NDI * 8 * 2 * 2 * 64 * 8; idx += gridDim.x * 512) {
          const int j = idx & 7, ln = (idx >> 3) & 63, half = (idx >> 9) & 1, sx = (idx >> 10) & 1, h = (idx >> 11) & 7, rest = idx >> 14, di = rest % NDI, type = rest / NDI;
          const int kj = 32 * half + (ln & 31), qi = 16 * sx + 8 * (ln >> 5) + j, dist = 32 * di + qi - kj;
          const float v = (dist < 0 || (type == 1 && dist >= 512)) ? -30000.f : rel_bias[rel_bucket(dist) * 8 + h] * 1.4426950408889634f;
          tbl[idx] = (bf16)f2bf(v); } }
    if (blockIdx.x == 0 && tid == 0) *(float*)(ws + WS_DBG) = 0.f;
    for (int o = blockIdx.x * 512 + tid; o < 2 * 256 * 8; o += gridDim.x * 512) {
        const int which = o >> 11, n = (o >> 3) & 255, part = o & 7; const float* pos = a.in[3 + which]; const float* w1 = a.in[which ? 7 : 5];
        float acc = 0.f;
        for (int e = part * 256; e < part * 256 + 256; ++e) acc = fmaf(pos[e], w1[(size_t)e * 256 + n], acc);
        acc += wshfl_xor(acc, 1, tid); acc += wshfl_xor(acc, 2, tid); acc += wshfl_xor(acc, 4, tid);
        if (part == 0) ((float*)(ws + WS_C1))[which * 256 + n] = acc;
    }
}

struct EpiProj {
    static constexpr bool PERM = true, AFTER_DRAIN = false;
    unsigned char* ws;
    __device__ __forceinline__ void operator()(const pg8::f32x4 (&acc)[2][2][4][2], const pg8::Unit& u, int wr, int wc, int fr, int fq) const {
        const int pn = u.pn; const int row0 = u.pm * 256 + wr * 64 + fr;
        if (pn == 23) {
            if (wc == 0) { float* sm = (float*)(ws + WS_SM);
#pragma unroll
                for (int ai = 0; ai < 2; ++ai)
#pragma unroll
                    for (int m = 0; m < 4; ++m) { float* o = sm + (size_t)(row0 + ai * 128 + m * 16) * 32 + 8 * fq; *(f32x4*)o = acc[ai][0][m][0]; *(f32x4*)(o + 4) = acc[ai][0][m][1]; } }
            return;
        }
        int kind, ldc, colt; size_t boff;
        if (pn < 2) { kind = 1; boff = WS_Q; ldc = 512; colt = pn * 256; }
        else if (pn < 5) { kind = 0; boff = WS_KV; ldc = 768; colt = (pn - 2) * 256; }
        else if (pn < 7) { kind = 2; boff = WS_ZA; ldc = 512; colt = (pn - 5) * 256; }
        else if (pn < 13) { kind = 0; boff = WS_QKVB; ldc = 1536; colt = (pn - 7) * 256; }
        else if (pn < 15) { kind = 2; boff = WS_ZB; ldc = 512; colt = (pn - 13) * 256; }
        else { kind = 3; boff = WS_GM; ldc = 2048; colt = (pn - 15) * 256; }
        bf16* base = (bf16*)(ws + boff); const int col0 = colt + wc * 32 + 8 * fq;
#pragma unroll
        for (int ai = 0; ai < 2; ++ai)
#pragma unroll
            for (int m = 0; m < 4; ++m) { bf16* rowp = base + (size_t)(row0 + ai * 128 + m * 16) * ldc + col0;
#pragma unroll
                for (int bj = 0; bj < 2; ++bj) { float v[8];
#pragma unroll
                    for (int e = 0; e < 4; ++e) { v[e] = acc[ai][bj][m][0][e]; v[4 + e] = acc[ai][bj][m][1][e]; }
                    if (kind == 1) {
#pragma unroll
                        for (int e = 0; e < 8; ++e) v[e] *= 0.18033688011112042f;
                    } else if (kind == 2) {
#pragma unroll
                        for (int e = 0; e < 8; ++e) v[e] = siluf_(v[e]);
                    } else if (kind == 3) {
#pragma unroll
                        for (int e = 0; e < 8; ++e) v[e] = sigm(v[e]);
                    }
                    u32x4 w; w.x = pk2(v[0], v[1]); w.y = pk2(v[2], v[3]); w.z = pk2(v[4], v[5]); w.w = pk2(v[6], v[7]);
                    *(u32x4*)(rowp + bj * 128) = w; } }
    }
};
struct EpiYA {
    static constexpr bool PERM = true, AFTER_DRAIN = false;
    const bf16* gm; float* part;
    __device__ __forceinline__ void operator()(const pg8::f32x4 (&acc)[2][2][4][2], const pg8::Unit& u, int wr, int wc, int fr, int fq) const {
        const int row0 = u.pm * 256 + wr * 64 + fr, col0 = u.pn * 256 + wc * 32 + 8 * fq;
#pragma unroll
        for (int ai = 0; ai < 2; ++ai)
#pragma unroll
            for (int m = 0; m < 4; ++m)
#pragma unroll
                for (int bj = 0; bj < 2; ++bj) { const size_t r = row0 + ai * 128 + m * 16; const int c = col0 + bj * 128;
                    const u32x4 g = *(const u32x4*)(gm + r * 2048 + c);
                    f32x4 o0, o1;
                    o0.x = acc[ai][bj][m][0].x * bf2f(g.x & 0xffffu); o0.y = acc[ai][bj][m][0].y * bf2f(g.x >> 16); o0.z = acc[ai][bj][m][0].z * bf2f(g.y & 0xffffu); o0.w = acc[ai][bj][m][0].w * bf2f(g.y >> 16);
                    o1.x = acc[ai][bj][m][1].x * bf2f(g.z & 0xffffu); o1.y = acc[ai][bj][m][1].y * bf2f(g.z >> 16); o1.z = acc[ai][bj][m][1].z * bf2f(g.w & 0xffffu); o1.w = acc[ai][bj][m][1].w * bf2f(g.w >> 16);
                    float* o = part + r * 1024 + c; *(f32x4*)o = o0; *(f32x4*)(o + 4) = o1; }
    }
};
struct EpiYB {
    static constexpr bool PERM = true, AFTER_DRAIN = false;
    const bf16* gm; const float* part; bf16* mo;
    __device__ __forceinline__ void operator()(const pg8::f32x4 (&acc)[2][2][4][2], const pg8::Unit& u, int wr, int wc, int fr, int fq) const {
        const int row0 = u.pm * 256 + wr * 64 + fr, col0 = u.pn * 256 + wc * 32 + 8 * fq;
#pragma unroll
        for (int ai = 0; ai < 2; ++ai)
#pragma unroll
            for (int m = 0; m < 4; ++m)
#pragma unroll
                for (int bj = 0; bj < 2; ++bj) { const size_t r = row0 + ai * 128 + m * 16; const int c = col0 + bj * 128;
                    const u32x4 g = *(const u32x4*)(gm + r * 2048 + 1024 + c);
                    const float* pp = part + r * 1024 + c; const f32x4 p0 = *(const f32x4*)pp, p1 = *(const f32x4*)(pp + 4);
                    f32x4 o0, o1;
                    o0.x = p0.x + acc[ai][bj][m][0].x * bf2f(g.x & 0xffffu); o0.y = p0.y + acc[ai][bj][m][0].y * bf2f(g.x >> 16); o0.z = p0.z + acc[ai][bj][m][0].z * bf2f(g.y & 0xffffu); o0.w = p0.w + acc[ai][bj][m][0].w * bf2f(g.y >> 16);
                    o1.x = p1.x + acc[ai][bj][m][1].x * bf2f(g.z & 0xffffu); o1.y = p1.y + acc[ai][bj][m][1].y * bf2f(g.z >> 16); o1.z = p1.z + acc[ai][bj][m][1].z * bf2f(g.w & 0xffffu); o1.w = p1.w + acc[ai][bj][m][1].w * bf2f(g.w >> 16);
                    u32x4 w; w.x = pk2(o0.x, o0.y); w.y = pk2(o0.z, o0.w); w.z = pk2(o1.x, o1.y); w.w = pk2(o1.z, o1.w);
                    *(u32x4*)(mo + r * 1024 + c) = w; }
    }
};
struct EpiH {
    static constexpr bool PERM = true, AFTER_DRAIN = false;
    const float* x; float* h; bf16* hb;
    __device__ __forceinline__ void operator()(const pg8::f32x4 (&acc)[2][2][4][2], const pg8::Unit& u, int wr, int wc, int fr, int fq) const {
        const int row0 = u.pm * 256 + wr * 64 + fr, col0 = u.pn * 256 + wc * 32 + 8 * fq;
#pragma unroll
        for (int ai = 0; ai < 2; ++ai)
#pragma unroll
            for (int m = 0; m < 4; ++m)
#pragma unroll
                for (int bj = 0; bj < 2; ++bj) { const size_t off = (size_t)(row0 + ai * 128 + m * 16) * 1024 + col0 + bj * 128;
                    const f32x4 x0 = *(const f32x4*)(x + off), x1 = *(const f32x4*)(x + off + 4);
                    const f32x4 o0 = x0 * ALPHA + acc[ai][bj][m][0], o1 = x1 * ALPHA + acc[ai][bj][m][1];
                    *(f32x4*)(h + off) = o0; *(f32x4*)(h + off + 4) = o1;
                    u32x4 w; w.x = pk2(o0.x, o0.y); w.y = pk2(o0.z, o0.w); w.z = pk2(o1.x, o1.y); w.w = pk2(o1.z, o1.w);
                    *(u32x4*)(hb + off) = w; }
    }
};
struct EpiPE {
    static constexpr bool PERM = true, AFTER_DRAIN = false;
    float* pe;
    __device__ __forceinline__ void operator()(const pg8::f32x4 (&acc)[2][2][4][2], const pg8::Unit& u, int wr, int wc, int fr, int fq) const {
        const int row0 = u.pm * 256 + wr * 64 + fr, col0 = u.pn * 256 + wc * 32 + 8 * fq;
#pragma unroll
        for (int ai = 0; ai < 2; ++ai)
#pragma unroll
            for (int m = 0; m < 4; ++m)
#pragma unroll
                for (int bj = 0; bj < 2; ++bj) { const size_t off = (size_t)(row0 + ai * 128 + m * 16) * 1024 + col0 + bj * 128;
                    *(f32x4*)(pe + off) = acc[ai][bj][m][0]; *(f32x4*)(pe + off + 4) = acc[ai][bj][m][1]; }
    }
};
struct EpiGate {
    static constexpr bool PERM = true, AFTER_DRAIN = false;
    const float* h; const float* pe; float* out;
    __device__ __forceinline__ void operator()(const pg8::f32x4 (&acc)[2][2][4][2], const pg8::Unit& u, int wr, int wc, int fr, int fq) const {
        const int row0 = u.pm * 256 + wr * 64 + fr, col0 = u.pn * 256 + wc * 32 + 8 * fq;
#pragma unroll
        for (int ai = 0; ai < 2; ++ai)
#pragma unroll
            for (int m = 0; m < 4; ++m)
#pragma unroll
                for (int bj = 0; bj < 2; ++bj) { const size_t off = (size_t)(row0 + ai * 128 + m * 16) * 1024 + col0 + bj * 128;
                    const f32x4 h0 = *(const f32x4*)(h + off), h1 = *(const f32x4*)(h + off + 4), p0 = *(const f32x4*)(pe + off), p1 = *(const f32x4*)(pe + off + 4);
                    f32x4 o0, o1;
                    o0.x = h0.x + sigm(acc[ai][bj][m][0].x) * p0.x; o0.y = h0.y + sigm(acc[ai][bj][m][0].y) * p0.y; o0.z = h0.z + sigm(acc[ai][bj][m][0].z) * p0.z; o0.w = h0.w + sigm(acc[ai][bj][m][0].w) * p0.w;
                    o1.x = h1.x + sigm(acc[ai][bj][m][1].x) * p1.x; o1.y = h1.y + sigm(acc[ai][bj][m][1].y) * p1.y; o1.z = h1.z + sigm(acc[ai][bj][m][1].z) * p1.z; o1.w = h1.w + sigm(acc[ai][bj][m][1].w) * p1.w;
                    *(f32x4*)(out + off) = o0; *(f32x4*)(out + off + 4) = o1; }
    }
};

template <class LA, class LB, class ST>
__device__ __forceinline__ void sgemm_tile64(LAS float* As, LAS float* Bs, int K, int tid, LA loadA4, LB loadB4, ST store4) {
    const int tx = tid & 15, ty = (tid >> 4) & 15;
    float acc[4][4];
#pragma unroll
    for (int i = 0; i < 4; ++i)
#pragma unroll
        for (int j = 0; j < 4; ++j) acc[i][j] = 0.f;
    const int arow = (tid >> 2) & 63, akq = (tid & 3) * 4, bk = (tid >> 4) & 15, bnq = (tid & 15) * 4;
    for (int k0 = 0; k0 < K; k0 += 16) {
        if (tid < 256) {
            const f32x4 av = loadA4(arow, k0 + akq), bv = loadB4(k0 + bk, bnq);
            As[(akq + 0) * 68 + arow] = av.x; As[(akq + 1) * 68 + arow] = av.y; As[(akq + 2) * 68 + arow] = av.z; As[(akq + 3) * 68 + arow] = av.w;
            *(LAS f32x4*)&Bs[bk * 68 + bnq] = bv;
        }
        __syncthreads();
        if (tid < 256) {
#pragma unroll
            for (int k = 0; k < 16; ++k) {
                const f32x4 av = *(const LAS f32x4*)&As[k * 68 + ty * 4], bv = *(const LAS f32x4*)&Bs[k * 68 + tx * 4];
#pragma unroll
                for (int i = 0; i < 4; ++i)
#pragma unroll
                    for (int j = 0; j < 4; ++j) acc[i][j] = fmaf(av[i], bv[j], acc[i][j]);
            }
        }
        __syncthreads();
    }
    if (tid < 256) {
#pragma unroll
        for (int i = 0; i < 4; ++i) store4(ty * 4 + i, tx * 4, (f32x4){acc[i][0], acc[i][1], acc[i][2], acc[i][3]});
    }
}

__device__ __forceinline__ void dn_prep_phase(const Args& a, LAS unsigned char* lds, int tid) {
    unsigned char* ws = a.ws;
    const bf16* qkvb = (const bf16*)(ws + WS_QKVB); const float* sm = (const float*)(ws + WS_SM);
    const float* conv_w = a.in[10]; const float* a_log = a.in[11]; const float* dt_bias = a.in[12];
    bf16* qn = (bf16*)a.out; bf16* kn = qn + (size_t)T * 512; bf16* vv = kn + (size_t)T * 512;
    float* gg = (float*)(ws + WS_GG); float* bb = (float*)(ws + WS_BB);
    LAS float* red = (LAS float*)lds;
    const int h = tid >> 7, d = tid & 127, wave = tid >> 6;
    float cw[3][4];
#pragma unroll
    for (int part = 0; part < 3; ++part)
#pragma unroll
        for (int w = 0; w < 4; ++w) cw[part][w] = conv_w[w * 1536 + part * 512 + h * 128 + d];
    for (int t = blockIdx.x; t < T; t += gridDim.x) {
        const int ts = t & (SEQ - 1);
        float val[3];
#pragma unroll
        for (int part = 0; part < 3; ++part) { const int c = part * 512 + h * 128 + d; float acc = 0.f;
#pragma unroll
            for (int w = 0; w < 4; ++w) if (ts + w - 3 >= 0) acc = fmaf(cw[part][w], bf2f(qkvb[(size_t)(t + w - 3) * 1536 + c]), acc);
            val[part] = siluf_(acc); }
        float sq = val[0] * val[0], sk = val[1] * val[1];
#pragma unroll
        for (int o = 32; o > 0; o >>= 1) { sq += wshfl_xor(sq, o, tid); sk += wshfl_xor(sk, o, tid); }
        if ((tid & 63) == 0) { red[wave * 2] = sq; red[wave * 2 + 1] = sk; }
        __syncthreads();
        sq = red[(h * 2) * 2] + red[(h * 2 + 1) * 2]; sk = red[(h * 2) * 2 + 1] + red[(h * 2 + 1) * 2 + 1];
        const size_t o = (size_t)t * 512 + h * 128 + d;
        qn[o] = (bf16)f2bf(val[0] * (1.0f / sqrtf(sq + 1e-6f)));
        kn[o] = (bf16)f2bf(val[1] * (1.0f / sqrtf(sk + 1e-6f)));
        vv[o] = (bf16)f2bf(val[2]);
        if (d == 0) {
            bb[t * 4 + h] = 1.f / (1.f + expf(-sm[(size_t)t * 32 + 24 + h]));
            const float xx = sm[(size_t)t * 32 + 28 + h] + dt_bias[h];
            const float sp = (xx > 20.f) ? xx : log1pf(expf(xx));
            gg[t * 4 + h] = -expf(a_log[h]) * sp;
        }
        __syncthreads();
    }
}

__device__ __forceinline__ void cmp_gemm1_phase(const Args& a, LAS unsigned char* lds, int tid) {
    unsigned char* ws = a.ws; const bf16* kv = (const bf16*)(ws + WS_KV); bf16* hid = (bf16*)(ws + WS_HID);
    LAS float* As = (LAS float*)lds; LAS float* Bs = As + 16 * 68;
    for (int u = blockIdx.x; u < 256; u += gridDim.x) {
        const int which = u >> 7, mt = (u >> 2) & 31, nt = u & 3;
        const float* pos = a.in[3 + which]; const float* w1 = a.in[which ? 7 : 5];
        const int col0 = which * 128;
        auto la = [&](int r, int k) -> f32x4 {
            const int row = mt * 64 + r, g = row & 1, bn = row >> 1, b = bn >> 7, n = bn & 127, j = k >> 6, d = k & 63;
            const u32x2 w = *(const u32x2*)(kv + (size_t)(b * SEQ + 16 * n + j) * 768 + col0 + g * 64 + d);
            const f32x4 pv = *(const f32x4*)(pos + j * 64 + d);
            return (f32x4){bf2f(w.x & 0xffffu) + pv.x, bf2f(w.x >> 16) + pv.y, bf2f(w.y & 0xffffu) + pv.z, bf2f(w.y >> 16) + pv.w};
        };
        auto lb = [&](int k, int c) -> f32x4 { return *(const f32x4*)(w1 + (size_t)k * 256 + nt * 64 + c); };
        auto st = [&](int r, int c, f32x4 v) {
            float o[4];
#pragma unroll
            for (int e = 0; e < 4; ++e) { const float x = v[e]; o[e] = 0.5f * x * (1.f + tanhf(0.7978845608028654f * (x + 0.044715f * x * x * x))); }
            u32x2 w; w.x = pk2(o[0], o[1]); w.y = pk2(o[2], o[3]);
            *(u32x2*)(hid + ((size_t)which * 2048 + mt * 64 + r) * 256 + nt * 64 + c) = w;
        };
        sgemm_tile64(As, Bs, 2048, tid, la, lb, st);
    }
}
constexpr int CG_RS = 272;
__device__ __forceinline__ void cmp_gemm1_mfma_phase(const Args& a, LAS unsigned char* lds, int tid) {
    unsigned char* ws = a.ws; const bf16* kv = (const bf16*)(ws + WS_KV); bf16* hid = (bf16*)(ws + WS_HID);
    const int lane = tid & 63, w = __builtin_amdgcn_readfirstlane(tid >> 6), r32 = lane & 31, hk = lane >> 5;
    const int wm = w & 1, wn = (w >> 1) & 1, wk = w >> 2;
    for (int u = blockIdx.x; u < 256; u += gridDim.x) {
        const int which = u >> 7, mt = (u >> 2) & 31, nt = u & 3;
        const bf16* w1t = (const bf16*)(ws + (which ? WS_W1V : WS_W1K));
        const unsigned char* asrc[2]; const unsigned char* bsrc[2]; int dsto[2];
#pragma unroll
        for (int i = 0; i < 2; ++i) { const int p = tid + 512 * i, row = p >> 4, ch = p & 15;
            const int r = mt * 64 + row, g = r & 1, bn = r >> 1, b = bn >> 7, nb = bn & 127;
            asrc[i] = (const unsigned char*)(kv + (size_t)(b * SEQ + 16 * nb + (ch >> 3)) * 768 + which * 128 + g * 64 + (ch & 7) * 8);
            bsrc[i] = (const unsigned char*)(w1t + (size_t)(nt * 64 + row) * 2048 + ch * 8);
            dsto[i] = row * CG_RS + ch * 16; }
        u32x4 ar[2], br[2];
#pragma unroll
        for (int i = 0; i < 2; ++i) { ar[i] = *(const u32x4*)(asrc[i]); br[i] = *(const u32x4*)(bsrc[i]); }
#pragma unroll
        for (int i = 0; i < 2; ++i) { *(LAS u32x4*)(lds + dsto[i]) = ar[i]; *(LAS u32x4*)(lds + 2 * 64 * CG_RS + dsto[i]) = br[i]; }
        __syncthreads();
        f32x16 acc;
#pragma unroll
        for (int r = 0; r < 16; ++r) acc[r] = 0.f;
        for (int t = 0; t < 16; ++t) {
            const int cur = t & 1;
            if (t < 15) {
#pragma unroll
                for (int i = 0; i < 2; ++i) { ar[i] = *(const u32x4*)(asrc[i] + (size_t)(t + 1) * 3072); br[i] = *(const u32x4*)(bsrc[i] + (size_t)(t + 1) * 256); } }
            const LAS unsigned char* ab = lds + cur * 64 * CG_RS + (wm * 32 + r32) * CG_RS + (wk * 64 + hk * 8) * 2;
            const LAS unsigned char* bb = lds + (2 + cur) * 64 * CG_RS + (wn * 32 + r32) * CG_RS + (wk * 64 + hk * 8) * 2;
#pragma unroll
            for (int ks = 0; ks < 4; ++ks) acc = __builtin_amdgcn_mfma_f32_32x32x16_bf16(*(const LAS bf16x8*)(ab + ks * 32), *(const LAS bf16x8*)(bb + ks * 32), acc, 0, 0, 0);
            if (t < 15) {
#pragma unroll
                for (int i = 0; i < 2; ++i) { *(LAS u32x4*)(lds + (cur ^ 1) * 64 * CG_RS + dsto[i]) = ar[i]; *(LAS u32x4*)(lds + (2 + (cur ^ 1)) * 64 * CG_RS + dsto[i]) = br[i]; } }
            __syncthreads();
        }
        LAS float* red = (LAS float*)lds + (wm * 2 + wn) * 1024;
        if (wk == 1) {
#pragma unroll
            for (int r = 0; r < 16; ++r) red[r * 64 + lane] = acc[r]; }
        __syncthreads();
        if (wk == 0) {
            const int n = nt * 64 + wn * 32 + r32; const float c1 = ((const float*)(ws + WS_C1))[which * 256 + n];
#pragma unroll
            for (int r = 0; r < 16; ++r) { const float x = acc[r] + red[r * 64 + lane] + c1;
                const float y = 0.5f * x * (1.f + tanhf(0.7978845608028654f * (x + 0.044715f * x * x * x)));
                hid[((size_t)which * 2048 + mt * 64 + wm * 32 + crow(r, hk)) * 256 + n] = (bf16)f2bf(y); }
        }
        __syncthreads();
    }
}
__device__ __forceinline__ void cmp_gemm2_phase(const Args& a, LAS unsigned char* lds, int tid) {
    unsigned char* ws = a.ws; const bf16* hid = (const bf16*)(ws + WS_HID);
    LAS float* As = (LAS float*)lds; LAS float* Bs = As + 16 * 68;
    for (int u = blockIdx.x; u < 64; u += gridDim.x) {
        const int which = u >> 5, mt = u & 31;
        const float* w2 = a.in[which ? 8 : 6]; float* outp = (float*)(ws + (which ? WS_VC : WS_KC));
        auto la = [&](int r, int k) -> f32x4 { const u32x2 w = *(const u32x2*)(hid + ((size_t)which * 2048 + mt * 64 + r) * 256 + k);
            return (f32x4){bf2f(w.x & 0xffffu), bf2f(w.x >> 16), bf2f(w.y & 0xffffu), bf2f(w.y >> 16)}; };
        auto lb = [&](int k, int c) -> f32x4 { return *(const f32x4*)(w2 + (size_t)k * 64 + c); };
        bf16* outb = (bf16*)(ws + (which ? WS_VCB : WS_KCB));
        auto st = [&](int r, int c, f32x4 v) { *(f32x4*)(outp + (size_t)(mt * 64 + r) * 64 + c) = v;
            const int row = mt * 64 + r, gg_ = row & 1, bn = row >> 1, bb_ = bn >> 7, n = bn & 127;
            u32x2 wv; wv.x = (n == 127) ? 0u : pk2(v.x, v.y); wv.y = (n == 127) ? 0u : pk2(v.z, v.w);
            *(u32x2*)(outb + ((size_t)((bb_ * 2 + gg_) * 128 + n)) * 64 + c) = wv; };
        sgemm_tile64(As, Bs, 256, tid, la, lb, st);
    }
}

template <int MODE>
__device__ __forceinline__ void attn_simple_phase(const Args& a, LAS unsigned char* lds, int tid) {
    constexpr int NK = (MODE == 0) ? 127 : 512;
    unsigned char* ws = a.ws;
    const bf16* Q = (const bf16*)(ws + WS_Q); const bf16* KV = (const bf16*)(ws + WS_KV); const float* sm = (const float*)(ws + WS_SM);
    const float* kc = (const float*)(ws + WS_KC); const float* vc = (const float*)(ws + WS_VC);
    const float* rel_bias = a.in[9];
    float* oacc = (float*)(ws + WS_OACC); u32* sel = (u32*)(ws + WS_SEL);
    const bf16* za = (const bf16*)(ws + WS_ZA); bf16* oa = (bf16*)(ws + WS_OA);
    const int sb = tid >> 8, stid = tid & 255;
    LAS float* qs = (LAS float*)(lds + sb * 12288);
    LAS float* sc = qs + 256;
    LAS int* blk = (LAS int*)(sc + 2048);
    LAS float* imp = (LAS float*)(blk + 8);
    const int NU = T * 2, G2 = gridDim.x * 2;
    for (int u0 = 0; u0 < NU; u0 += G2) {
        const int u = u0 + blockIdx.x * 2 + sb; const bool act = u < NU;
        const int t = act ? (u >> 1) : 0, g = u & 1, ts = t & (SEQ - 1), tb = t - ts;
        qs[stid] = bf2f(Q[(size_t)t * 512 + (g * 4 + (stid >> 6)) * 64 + (stid & 63)]);
        if (MODE == 1 && stid == 0) { u32 mk = sel[t * 2 + g]; int k = 0; for (int j = 0; j < 32; ++j) if ((mk >> j) & 1u) { if (k < 8) blk[k] = j; ++k; } for (; k < 8; ++k) blk[k] = 0; }
        __syncthreads();
        for (int i = stid; i < NK; i += 256) {
            int dist, kpos; bool valid; const bf16* kb = nullptr; const float* kf = nullptr;
            if (MODE == 0) { dist = ts - (16 * i + 31); valid = dist >= 0; kf = kc + (size_t)((((tb >> 11) * 128) + i) * 2 + g) * 64; }
            else if (MODE == 1) { kpos = blk[i >> 6] * 64 + (i & 63); dist = ts - kpos; valid = dist >= 0; kb = KV + (size_t)(tb + kpos) * 768 + 256 + g * 64; }
            else { kpos = ts - 511 + i; dist = 511 - i; valid = kpos >= 0; kb = KV + (size_t)(tb + (kpos < 0 ? 0 : kpos)) * 768 + 512 + g * 64; }
            float s0 = 0.f, s1 = 0.f, s2 = 0.f, s3 = 0.f;
            if (valid) {
#pragma unroll 2
                for (int d = 0; d < 64; d += 8) {
                    float kk[8];
                    if (MODE == 0) { const f32x4 k0 = *(const f32x4*)(kf + d), k1 = *(const f32x4*)(kf + d + 4); kk[0] = k0.x; kk[1] = k0.y; kk[2] = k0.z; kk[3] = k0.w; kk[4] = k1.x; kk[5] = k1.y; kk[6] = k1.z; kk[7] = k1.w; }
                    else { const u32x4 w = *(const u32x4*)(kb + d); kk[0] = bf2f(w.x & 0xffffu); kk[1] = bf2f(w.x >> 16); kk[2] = bf2f(w.y & 0xffffu); kk[3] = bf2f(w.y >> 16); kk[4] = bf2f(w.z & 0xffffu); kk[5] = bf2f(w.z >> 16); kk[6] = bf2f(w.w & 0xffffu); kk[7] = bf2f(w.w >> 16); }
#pragma unroll
                    for (int e = 0; e < 8; ++e) { s0 = fmaf(kk[e], qs[d + e], s0); s1 = fmaf(kk[e], qs[64 + d + e], s1); s2 = fmaf(kk[e], qs[128 + d + e], s2); s3 = fmaf(kk[e], qs[192 + d + e], s3); }
                }
                const float* rb = rel_bias + rel_bucket(dist) * 8 + g * 4;
                s0 += rb[0] * 1.4426950408889634f; s1 += rb[1] * 1.4426950408889634f; s2 += rb[2] * 1.4426950408889634f; s3 += rb[3] * 1.4426950408889634f;
            } else { s0 = s1 = s2 = s3 = -1e30f; }
            sc[i] = s0; sc[512 + i] = s1; sc[1024 + i] = s2; sc[1536 + i] = s3;
        }
        __syncthreads();
        {
            const int w = stid >> 6, lane = stid & 63; LAS float* row = sc + w * 512;
            float mx = -1e30f;
            for (int i = lane; i < NK; i += 64) mx = fmaxf(mx, row[i]);
#pragma unroll
            for (int o = 32; o > 0; o >>= 1) mx = fmaxf(mx, wshfl_xor(mx, o, tid));
            float sum = 0.f;
            for (int i = lane; i < NK; i += 64) { const float s = row[i]; const float e = (s > -1e29f) ? exp2f(s - mx) : 0.f; row[i] = e; sum += e; }
#pragma unroll
            for (int o = 32; o > 0; o >>= 1) sum += wshfl_xor(sum, o, tid);
            const float inv = (sum > 0.f) ? 1.f / sum : 0.f;
            for (int i = lane; i < NK; i += 64) row[i] *= inv;
        }
        __syncthreads();
        {
            const int hg = stid >> 6, d = stid & 63; const LAS float* row = sc + hg * 512;
            float acc = 0.f;
            for (int i = 0; i < NK; ++i) {
                const float p = row[i];
                if (p != 0.f) {
                    float v;
                    if (MODE == 0) v = vc[(size_t)((((tb >> 11) * 128) + i) * 2 + g) * 64 + d];
                    else if (MODE == 1) v = bf2f(KV[(size_t)(tb + blk[i >> 6] * 64 + (i & 63)) * 768 + 384 + g * 64 + d]);
                    else v = bf2f(KV[(size_t)(tb + ts - 511 + i) * 768 + 640 + g * 64 + d]);
                    acc = fmaf(p, v, acc);
                }
            }
            if (act) {
                const int h = g * 4 + hg; const size_t o = (size_t)t * 512 + h * 64 + d;
                const float gate = 1.f / (1.f + expf(-sm[(size_t)t * 32 + (MODE == 0 ? 0 : MODE == 1 ? 8 : 16) + h]));
                if (MODE == 2) oacc[o] = gate * acc;
                else if (MODE == 0) oacc[o] += gate * acc;
                else oa[o] = (bf16)f2bf((oacc[o] + gate * acc) * bf2f(za[o]));
            }
        }
        if (MODE == 0) {
            if (stid < 32) {
                const int j = stid; float s = 0.f;
                for (int n = 4 * j - 1; n <= 4 * j + 3; ++n) if (n >= 0 && n < 127) s += (sc[n] + sc[512 + n]) + (sc[1024 + n] + sc[1536 + n]);
                const int cur = ts >> 6;
                if (j == 0 || j == cur || j == cur - 1) s = 1e6f; else if (j > cur) s = -1e6f;
                imp[j] = s;
            }
            __syncthreads();
            if (stid == 0 && act) {
                u32 taken = 0u;
                for (int k = 0; k < 8; ++k) { int best = -1; float bv = 0.f;
                    for (int j = 0; j < 32; ++j) if (!((taken >> j) & 1u)) { const float x = imp[j]; if (best < 0 || x > bv) { best = j; bv = x; } }
                    taken |= 1u << best; }
                sel[t * 2 + g] = taken;
            }
        }
        __syncthreads();
    }
}

__device__ __forceinline__ unsigned cvtpk(float lo, float hi) { typedef float f2 __attribute__((ext_vector_type(2))); typedef __bf16 b2 __attribute__((ext_vector_type(2))); f2 v = {lo, hi}; b2 b = __builtin_convertvector(v, b2); return __builtin_bit_cast(unsigned, b); }
__device__ __forceinline__ float hswap_max(float v) { auto rr = __builtin_amdgcn_permlane32_swap(__float_as_uint(v), __float_as_uint(v), false, false); return fmaxf(__uint_as_float(rr[0]), __uint_as_float(rr[1])); }
__device__ __forceinline__ float hswap_sum(float v) { auto rr = __builtin_amdgcn_permlane32_swap(__float_as_uint(v), __float_as_uint(v), false, false); return __uint_as_float(rr[0]) + __uint_as_float(rr[1]); }
template <int MODE, bool PROBE>
__device__ __forceinline__ void attn_mfma_unit(const Args& a, LAS unsigned char* lds, int tid, int b, int g, int qt) {
    typedef short v4i16_t __attribute__((ext_vector_type(4)));
    unsigned char* ws = a.ws;
    const int lane = tid & 63, w = __builtin_amdgcn_readfirstlane(tid >> 6), r32 = lane & 31, hi = lane >> 5;
    const int hg = w >> 1, tsub = w & 1, h = g * 4 + hg;
    const int tb = b * SEQ, t0 = qt * 64, tq = t0 + tsub * 32 + r32;
    const bf16* Q = (const bf16*)(ws + WS_Q); const bf16* KV = (const bf16*)(ws + WS_KV);
    const int kcol = (MODE == 1 ? 256 : 512) + g * 64, vcol = kcol + 128;
    bf16x8 qr[4];
#pragma unroll
    for (int d0 = 0; d0 < 4; ++d0) qr[d0] = *(const bf16x8*)(Q + (size_t)(tb + tq) * 512 + h * 64 + d0 * 16 + hi * 8);
    bf16x8 oh[2];
#pragma unroll
    for (int sx = 0; sx < 2; ++sx)
#pragma unroll
        for (int j = 0; j < 8; ++j) oh[sx][j] = (16 * sx + 8 * hi + j == r32) ? (short)0x3F80 : (short)0;
    const int j0 = (MODE == 2) ? (qt > 8 ? qt - 8 : 0) : 0, j1 = qt;
    const bf16* ksrc = KV + (size_t)(tb + lane) * 768 + kcol + w * 8;
    const bf16* vsrc = KV + (size_t)(tb + 16 * (w & 3) + (lane >> 2)) * 768 + vcol + (w >> 2) * 32 + (lane & 3) * 8;
    LAS unsigned char* Kb = lds; LAS unsigned char* Vb = lds + 16384; LAS float* wsf = (LAS float*)(lds + 32768) + w * 64;
    const unsigned char* tblb = ws + WS_TBL + (size_t)((MODE == 2 ? NDI : 0) * 8 + h) * 4096 + lane * 16;
    u32 mk = 0xffffffffu; if (MODE == 1) mk = ((const u32*)(ws + WS_SEL))[(tb + tq) * 2 + g];
    u32x4 kreg = *(const u32x4*)(ksrc + (size_t)j0 * 64 * 768), vreg = *(const u32x4*)(vsrc + (size_t)j0 * 64 * 768);
    *(LAS u32x4*)(Kb + w * 1024 + lane * 16) = kreg; *(LAS u32x4*)(Vb + w * 1024 + lane * 16) = vreg;
    __syncthreads();
    float m = -1e30f, l = 0.f; f32x16 o[2];
#pragma unroll
    for (int r = 0; r < 16; ++r) { o[0][r] = 0.f; o[1][r] = 0.f; }
    const LAS unsigned char* vrd0 = Vb + ((lane >> 4) & 1) * 32 + (lane & 3) * 8 + (4 * hi + ((lane & 15) >> 2)) * 64;
    for (int jt = j0; jt <= j1; ++jt) {
        const int cur = (jt - j0) & 1;
        if (jt < j1) { kreg = *(const u32x4*)(ksrc + (size_t)(jt + 1) * 64 * 768); vreg = *(const u32x4*)(vsrc + (size_t)(jt + 1) * 64 * 768); }
        int di = 2 * (qt - jt) + tsub; if (di > NDI - 1) di = NDI - 1;
        const unsigned char* tp = tblb + (size_t)di * 32768;
        const bf16x8 tf00 = *(const bf16x8*)(tp), tf01 = *(const bf16x8*)(tp + 1024), tf10 = *(const bf16x8*)(tp + 2048), tf11 = *(const bf16x8*)(tp + 3072);
        const float cinit = (MODE == 1 && !((mk >> jt) & 1u)) ? -30000.f : 0.f;
        f32x16 p0, p1;
#pragma unroll
        for (int r = 0; r < 16; ++r) p0[r] = cinit;
        p1 = __builtin_amdgcn_mfma_f32_32x32x16_bf16(tf01, oh[0], p0, 0, 0, 0);
        p0 = __builtin_amdgcn_mfma_f32_32x32x16_bf16(tf00, oh[0], p0, 0, 0, 0);
        p0 = __builtin_amdgcn_mfma_f32_32x32x16_bf16(tf10, oh[1], p0, 0, 0, 0);
        p1 = __builtin_amdgcn_mfma_f32_32x32x16_bf16(tf11, oh[1], p1, 0, 0, 0);
        const LAS unsigned char* kb = Kb + cur * 8192 + hi * 1024 + r32 * 16;
#pragma unroll
        for (int d0 = 0; d0 < 4; ++d0) {
            const bf16x8 k0 = *(const LAS bf16x8*)(kb + d0 * 2048), k1 = *(const LAS bf16x8*)(kb + d0 * 2048 + 512);
            p0 = __builtin_amdgcn_mfma_f32_32x32x16_bf16(k0, qr[d0], p0, 0, 0, 0);
            p1 = __builtin_amdgcn_mfma_f32_32x32x16_bf16(k1, qr[d0], p1, 0, 0, 0);
        }
        float rm = fmaxf(p0[0], p1[0]);
#pragma unroll
        for (int r = 1; r < 16; ++r) rm = fmaxf(rm, fmaxf(p0[r], p1[r]));
        rm = hswap_max(rm);
        const float mn = fmaxf(m, rm);
        if (__any(mn > m)) {
            const float sc = __builtin_amdgcn_exp2f(m - mn); l *= sc; m = mn;
            if (hi == 0) wsf[r32] = sc;
            LDS_WAIT();
#pragma unroll
            for (int r = 0; r < 16; ++r) { const float f = wsf[crow(r, hi)]; o[0][r] *= f; o[1][r] *= f; }
            LDS_WAIT();
        }
        float sacc = 0.f;
#pragma unroll
        for (int r = 0; r < 16; ++r) { p0[r] = __builtin_amdgcn_exp2f(p0[r] - m); p1[r] = __builtin_amdgcn_exp2f(p1[r] - m); sacc += p0[r] + p1[r]; }
        l += sacc;
        u32x4 pw[4];
#pragma unroll
        for (int e = 0; e < 4; ++e) { pw[0][e] = cvtpk(p0[2 * e], p0[2 * e + 1]); pw[1][e] = cvtpk(p0[8 + 2 * e], p0[8 + 2 * e + 1]); pw[2][e] = cvtpk(p1[2 * e], p1[2 * e + 1]); pw[3][e] = cvtpk(p1[8 + 2 * e], p1[8 + 2 * e + 1]); }
        const LAS unsigned char* vrd = vrd0 + cur * 8192;
#pragma unroll
        for (int d0 = 0; d0 < 2; ++d0)
#pragma unroll
            for (int ks = 0; ks < 4; ++ks) {
                const s16x4 lo = __builtin_bit_cast(s16x4, __builtin_amdgcn_ds_read_tr16_b64_v4i16((LAS v4i16_t*)(vrd + d0 * 4096 + ks * 1024)));
                const s16x4 hh = __builtin_bit_cast(s16x4, __builtin_amdgcn_ds_read_tr16_b64_v4i16((LAS v4i16_t*)(vrd + d0 * 4096 + ks * 1024 + 512)));
                const bf16x8 vf = (bf16x8){lo[0], lo[1], lo[2], lo[3], hh[0], hh[1], hh[2], hh[3]};
                o[d0] = __builtin_amdgcn_mfma_f32_32x32x16_bf16(__builtin_bit_cast(bf16x8, pw[ks]), vf, o[d0], 0, 0, 0);
            }
        if (jt < j1) { *(LAS u32x4*)(Kb + (cur ^ 1) * 8192 + w * 1024 + lane * 16) = kreg; *(LAS u32x4*)(Vb + (cur ^ 1) * 8192 + w * 1024 + lane * 16) = vreg; }
        __syncthreads();
    }
    l = hswap_sum(l);
    if (hi == 0) wsf[32 + r32] = l;
    LDS_WAIT();
    const float* sm = (const float*)(ws + WS_SM); float* oacc = (float*)(ws + WS_OACC);
    const bf16* za = (const bf16*)(ws + WS_ZA); bf16* oa = (bf16*)(ws + WS_OA);
    float dmax = 0.f;
#pragma unroll
    for (int r = 0; r < 16; ++r) {
        const int qi = crow(r, hi); const size_t row = (size_t)(tb + t0 + tsub * 32 + qi);
        const float rl = __builtin_amdgcn_rcpf(wsf[32 + qi]);
        const float gate = sigm(sm[row * 32 + (MODE == 1 ? 8 : 16) + h]);
#pragma unroll
        for (int d0 = 0; d0 < 2; ++d0) { const size_t oo = row * 512 + h * 64 + d0 * 32 + r32; const float val = gate * o[d0][r] * rl;
            if (PROBE) dmax = fmaxf(dmax, (MODE == 2) ? fabsf(val - oacc[oo]) : fabsf((oacc[oo] + val) * bf2f(za[oo]) - bf2f(oa[oo])));
            else if (MODE == 2) oacc[oo] = val;
            else oa[oo] = (bf16)f2bf((oacc[oo] + val) * bf2f(za[oo])); }
    }
    LDS_WAIT();
    if (PROBE) atomicMax((unsigned*)(ws + WS_DBG), __float_as_uint(dmax));
}
template <int MODE, bool PROBE>
__device__ __forceinline__ void attn_mfma_phase(const Args& a, LAS unsigned char* lds, int tid) {
    for (int i = blockIdx.x; i < 256; i += gridDim.x) {
        const int bg = i >> 4, s = i & 15;
        attn_mfma_unit<MODE, PROBE>(a, lds, tid, bg >> 1, bg & 1, s);
        attn_mfma_unit<MODE, PROBE>(a, lds, tid, bg >> 1, bg & 1, 31 - s);
    }
}

constexpr int FA_KB = 0, FA_VB = 16384, FA_WSF = 32768, FA_SELM = 36864, FA_IMP = 37376, FA_BIAS = 70144, FA_END = 102912;
template <int MODE>
__device__ __forceinline__ void fa_branch(const unsigned char* ws, LAS unsigned char* lds, int tid, int tb, int g, int qt, int h, u32 mk, const float* smg, f32x16 (&osum)[2]) {
    typedef short v4i16_t __attribute__((ext_vector_type(4)));
    const int lane = tid & 63, w = __builtin_amdgcn_readfirstlane(tid >> 6), r32 = lane & 31, hi = lane >> 5, tsub = w & 1;
    const bf16* KV = (const bf16*)(ws + WS_KV);
    const int kcol = (MODE == 1 ? 256 : 512) + g * 64, vcol = kcol + 128;
    const int j0 = (MODE == 2) ? (qt > 8 ? qt - 8 : 0) : 0, j1 = qt;
    bf16x8 qr[4];
    { const bf16* Q = (const bf16*)(ws + WS_Q) + (size_t)(tb + qt * 64 + tsub * 32 + r32) * 512 + h * 64 + hi * 8;
#pragma unroll
      for (int d0 = 0; d0 < 4; ++d0) qr[d0] = *(const bf16x8*)(Q + d0 * 16); }
    bf16x8 oh[2];
#pragma unroll
    for (int sx = 0; sx < 2; ++sx)
#pragma unroll
        for (int j = 0; j < 8; ++j) oh[sx][j] = (16 * sx + 8 * hi + j == r32) ? (short)0x3F80 : (short)0;
    const bf16* ksrc = KV + (size_t)(tb + lane) * 768 + kcol + w * 8;
    const bf16* vsrc = KV + (size_t)(tb + 16 * (w & 3) + (lane >> 2)) * 768 + vcol + (w >> 2) * 32 + (lane & 3) * 8;
    LAS unsigned char* Kb = lds + FA_KB; LAS unsigned char* Vb = lds + FA_VB; LAS float* wsf = (LAS float*)(lds + FA_WSF) + w * 128;
    const unsigned char* tblb = ws + WS_TBL + (size_t)((MODE == 2 ? NDI : 0) * 8 + h) * 4096 + lane * 16;
    u32x4 kreg = *(const u32x4*)(ksrc + (size_t)j0 * 64 * 768), vreg = *(const u32x4*)(vsrc + (size_t)j0 * 64 * 768);
    *(LAS u32x4*)(Kb + w * 1024 + lane * 16) = kreg; *(LAS u32x4*)(Vb + w * 1024 + lane * 16) = vreg;
    __syncthreads();
    float m = -1e30f, l = 0.f; f32x16 o[2];
#pragma unroll
    for (int r = 0; r < 16; ++r) { o[0][r] = 0.f; o[1][r] = 0.f; }
    const LAS unsigned char* vrd0 = Vb + ((lane >> 4) & 1) * 32 + (lane & 3) * 8 + (4 * hi + ((lane & 15) >> 2)) * 64;
    for (int jt = j0; jt <= j1; ++jt) {
        const int cur = (jt - j0) & 1;
        if (jt < j1) { kreg = *(const u32x4*)(ksrc + (size_t)(jt + 1) * 64 * 768); vreg = *(const u32x4*)(vsrc + (size_t)(jt + 1) * 64 * 768); }
        int di = 2 * (qt - jt) + tsub; if (di > NDI - 1) di = NDI - 1;
        const unsigned char* tp = tblb + (size_t)di * 32768;
        const bf16x8 tf00 = *(const bf16x8*)(tp), tf01 = *(const bf16x8*)(tp + 1024), tf10 = *(const bf16x8*)(tp + 2048), tf11 = *(const bf16x8*)(tp + 3072);
        const float cinit = (MODE == 1 && !((mk >> jt) & 1u)) ? -30000.f : 0.f;
        f32x16 p0, p1;
#pragma unroll
        for (int r = 0; r < 16; ++r) p0[r] = cinit;
        p1 = __builtin_amdgcn_mfma_f32_32x32x16_bf16(tf01, oh[0], p0, 0, 0, 0);
        p0 = __builtin_amdgcn_mfma_f32_32x32x16_bf16(tf00, oh[0], p0, 0, 0, 0);
        p0 = __builtin_amdgcn_mfma_f32_32x32x16_bf16(tf10, oh[1], p0, 0, 0, 0);
        p1 = __builtin_amdgcn_mfma_f32_32x32x16_bf16(tf11, oh[1], p1, 0, 0, 0);
        const LAS unsigned char* kb = Kb + cur * 8192 + hi * 1024 + r32 * 16;
#pragma unroll
        for (int d0 = 0; d0 < 4; ++d0) {
            const bf16x8 k0 = *(const LAS bf16x8*)(kb + d0 * 2048), k1 = *(const LAS bf16x8*)(kb + d0 * 2048 + 512);
            p0 = __builtin_amdgcn_mfma_f32_32x32x16_bf16(k0, qr[d0], p0, 0, 0, 0);
            p1 = __builtin_amdgcn_mfma_f32_32x32x16_bf16(k1, qr[d0], p1, 0, 0, 0);
        }
        float rm = fmaxf(p0[0], p1[0]);
#pragma unroll
        for (int r = 1; r < 16; ++r) rm = fmaxf(rm, fmaxf(p0[r], p1[r]));
        rm = hswap_max(rm);
        const float mn = fmaxf(m, rm);
        if (__any(mn > m)) {
            const float sc = __builtin_amdgcn_exp2f(m - mn); l *= sc; m = mn;
            if (hi == 0) wsf[r32] = sc;
            LDS_WAIT();
#pragma unroll
            for (int r = 0; r < 16; ++r) { const float f = wsf[crow(r, hi)]; o[0][r] *= f; o[1][r] *= f; }
            LDS_WAIT();
        }
        float sacc = 0.f;
#pragma unroll
        for (int r = 0; r < 16; ++r) { p0[r] = __builtin_amdgcn_exp2f(p0[r] - m); p1[r] = __builtin_amdgcn_exp2f(p1[r] - m); sacc += p0[r] + p1[r]; }
        l += sacc;
        u32x4 pw[4];
#pragma unroll
        for (int e = 0; e < 4; ++e) { pw[0][e] = cvtpk(p0[2 * e], p0[2 * e + 1]); pw[1][e] = cvtpk(p0[8 + 2 * e], p0[8 + 2 * e + 1]); pw[2][e] = cvtpk(p1[2 * e], p1[2 * e + 1]); pw[3][e] = cvtpk(p1[8 + 2 * e], p1[8 + 2 * e + 1]); }
        const LAS unsigned char* vrd = vrd0 + cur * 8192;
#pragma unroll
        for (int d0 = 0; d0 < 2; ++d0)
#pragma unroll
            for (int ks = 0; ks < 4; ++ks) {
                const s16x4 lo = __builtin_bit_cast(s16x4, __builtin_amdgcn_ds_read_tr16_b64_v4i16((LAS v4i16_t*)(vrd + d0 * 4096 + ks * 1024)));
                const s16x4 hh = __builtin_bit_cast(s16x4, __builtin_amdgcn_ds_read_tr16_b64_v4i16((LAS v4i16_t*)(vrd + d0 * 4096 + ks * 1024 + 512)));
                const bf16x8 vf = (bf16x8){lo[0], lo[1], lo[2], lo[3], hh[0], hh[1], hh[2], hh[3]};
                o[d0] = __builtin_amdgcn_mfma_f32_32x32x16_bf16(__builtin_bit_cast(bf16x8, pw[ks]), vf, o[d0], 0, 0, 0);
            }
        if (jt < j1) { *(LAS u32x4*)(Kb + (cur ^ 1) * 8192 + w * 1024 + lane * 16) = kreg; *(LAS u32x4*)(Vb + (cur ^ 1) * 8192 + w * 1024 + lane * 16) = vreg; }
        __syncthreads();
    }
    l = hswap_sum(l);
    if (hi == 0) wsf[32 + r32] = sigm(smg[(size_t)r32 * 32]) * __builtin_amdgcn_rcpf(l);
    LDS_WAIT();
#pragma unroll
    for (int r = 0; r < 16; ++r) { const float f = wsf[32 + crow(r, hi)]; osum[0][r] = fmaf(f, o[0][r], osum[0][r]); osum[1][r] = fmaf(f, o[1][r], osum[1][r]); }
    LDS_WAIT();
}
template <int PROBE>
__device__ __forceinline__ void fused_attn_unit(const Args& a, LAS unsigned char* lds, int tid, int b, int g, int qt) {
    typedef short v4i16_t __attribute__((ext_vector_type(4)));
    unsigned char* ws = a.ws;
    const int lane = tid & 63, w = __builtin_amdgcn_readfirstlane(tid >> 6), r32 = lane & 31, hi = lane >> 5;
    const int hg = w >> 1, tsub = w & 1, h = g * 4 + hg;
    const int tb = b * SEQ, t0 = qt * 64, tq = t0 + tsub * 32 + r32;
    const bf16* Q = (const bf16*)(ws + WS_Q); const float* sm = (const float*)(ws + WS_SM);
    LAS unsigned char* Kb = lds + FA_KB; LAS unsigned char* Vb = lds + FA_VB; LAS float* wsf = (LAS float*)(lds + FA_WSF) + w * 128;
    LAS u32* selm = (LAS u32*)(lds + FA_SELM); LAS float* impb = (LAS float*)(lds + FA_IMP); const LAS float* biasL = (const LAS float*)(lds + FA_BIAS) + hg * 2048;
    f32x16 osum[2];
    {
        bf16x8 qr[4];
#pragma unroll
        for (int d0 = 0; d0 < 4; ++d0) qr[d0] = *(const bf16x8*)(Q + (size_t)(tb + tq) * 512 + h * 64 + d0 * 16 + hi * 8);
        const bf16* kcb = (const bf16*)(ws + WS_KCB) + (size_t)(b * 2 + g) * 128 * 64; const bf16* vcb = (const bf16*)(ws + WS_VCB) + (size_t)(b * 2 + g) * 128 * 64;
#pragma unroll
        for (int jt = 0; jt < 2; ++jt) {
            *(LAS u32x4*)(Kb + jt * 8192 + w * 1024 + lane * 16) = *(const u32x4*)(kcb + (size_t)(jt * 64 + lane) * 64 + w * 8);
            *(LAS u32x4*)(Vb + jt * 8192 + w * 1024 + lane * 16) = *(const u32x4*)(vcb + (size_t)(jt * 64 + 16 * (w & 3) + (lane >> 2)) * 64 + (w >> 2) * 32 + (lane & 3) * 8);
        }
        __syncthreads();
        f32x16 p[4];
#pragma unroll
        for (int t = 0; t < 4; ++t)
#pragma unroll
            for (int r = 0; r < 16; ++r) p[t][r] = 0.f;
#pragma unroll
        for (int jt = 0; jt < 2; ++jt) {
            const LAS unsigned char* kb = Kb + jt * 8192 + hi * 1024 + r32 * 16;
#pragma unroll
            for (int d0 = 0; d0 < 4; ++d0) {
                const bf16x8 k0 = *(const LAS bf16x8*)(kb + d0 * 2048), k1 = *(const LAS bf16x8*)(kb + d0 * 2048 + 512);
                p[2 * jt] = __builtin_amdgcn_mfma_f32_32x32x16_bf16(k0, qr[d0], p[2 * jt], 0, 0, 0);
                p[2 * jt + 1] = __builtin_amdgcn_mfma_f32_32x32x16_bf16(k1, qr[d0], p[2 * jt + 1], 0, 0, 0);
            }
        }
        float mx = -30000.f;
#pragma unroll
        for (int t = 0; t < 4; ++t)
#pragma unroll
            for (int r = 0; r < 16; ++r) { const int n = 32 * t + crow(r, hi); const int dist = tq - 16 * n - 31;
                const float v = (dist >= 0) ? p[t][r] + biasL[dist < 0 ? 0 : dist] : -30000.f; p[t][r] = v; mx = fmaxf(mx, v); }
        mx = fmaxf(hswap_max(mx), -10000.f);
        float l = 0.f;
#pragma unroll
        for (int t = 0; t < 4; ++t)
#pragma unroll
            for (int r = 0; r < 16; ++r) { p[t][r] = __builtin_amdgcn_exp2f(p[t][r] - mx); l += p[t][r]; }
        l = hswap_sum(l);
        const float inv = (l > 0.f) ? 1.f / l : 0.f;
#pragma unroll
        for (int t = 0; t < 4; ++t)
#pragma unroll
            for (int r = 0; r < 16; ++r) p[t][r] *= inv;
        float plast[16];
#pragma unroll
        for (int cg = 0; cg < 16; ++cg) { const float lastv = p[cg >> 2][4 * (cg & 3) + 3];
            auto rr = __builtin_amdgcn_permlane32_swap(__float_as_uint(lastv), __float_as_uint(lastv), false, false); plast[cg] = __uint_as_float(hi ? rr[0] : rr[1]); }
        LAS float* myimp = impb + (size_t)(hg * 64 + tsub * 32 + r32) * 32 + hi;
#pragma unroll
        for (int cg = 0; cg < 16; ++cg) { const int t = cg >> 2, c = cg & 3;
            const float s4 = (p[t][4 * c] + p[t][4 * c + 1]) + (p[t][4 * c + 2] + p[t][4 * c + 3]);
            const float extra = hi ? plast[cg] : (cg > 0 ? plast[cg > 0 ? cg - 1 : 0] : 0.f);
            myimp[2 * cg] = s4 + extra; }
        f32x16 o[2];
#pragma unroll
        for (int r = 0; r < 16; ++r) { o[0][r] = 0.f; o[1][r] = 0.f; }
        const LAS unsigned char* vrd0 = Vb + ((lane >> 4) & 1) * 32 + (lane & 3) * 8 + (4 * hi + ((lane & 15) >> 2)) * 64;
#pragma unroll
        for (int jt = 0; jt < 2; ++jt) {
            u32x4 pw[4];
#pragma unroll
            for (int e = 0; e < 4; ++e) { pw[0][e] = cvtpk(p[2 * jt][2 * e], p[2 * jt][2 * e + 1]); pw[1][e] = cvtpk(p[2 * jt][8 + 2 * e], p[2 * jt][8 + 2 * e + 1]);
                pw[2][e] = cvtpk(p[2 * jt + 1][2 * e], p[2 * jt + 1][2 * e + 1]); pw[3][e] = cvtpk(p[2 * jt + 1][8 + 2 * e], p[2 * jt + 1][8 + 2 * e + 1]); }
#pragma unroll
            for (int d0 = 0; d0 < 2; ++d0)
#pragma unroll
                for (int ks = 0; ks < 4; ++ks) {
                    const s16x4 lo = __builtin_bit_cast(s16x4, __builtin_amdgcn_ds_read_tr16_b64_v4i16((LAS v4i16_t*)(vrd0 + jt * 8192 + d0 * 4096 + ks * 1024)));
                    const s16x4 hh = __builtin_bit_cast(s16x4, __builtin_amdgcn_ds_read_tr16_b64_v4i16((LAS v4i16_t*)(vrd0 + jt * 8192 + d0 * 4096 + ks * 1024 + 512)));
                    const bf16x8 vf = (bf16x8){lo[0], lo[1], lo[2], lo[3], hh[0], hh[1], hh[2], hh[3]};
                    o[d0] = __builtin_amdgcn_mfma_f32_32x32x16_bf16(__builtin_bit_cast(bf16x8, pw[ks]), vf, o[d0], 0, 0, 0);
                }
        }
        if (hi == 0) wsf[64 + r32] = sigm(sm[(size_t)(tb + tq) * 32 + h]);
        LDS_WAIT();
#pragma unroll
        for (int r = 0; r < 16; ++r) { const float gt = wsf[64 + crow(r, hi)]; osum[0][r] = gt * o[0][r]; osum[1][r] = gt * o[1][r]; }
        __syncthreads();
#pragma unroll 1
        for (int it = 0; it < 4; ++it) {
            const int tok = w * 8 + it * 2 + hi, j = r32;
            float v = (impb[(size_t)(0 * 64 + tok) * 32 + j] + impb[(size_t)(1 * 64 + tok) * 32 + j]) + (impb[(size_t)(2 * 64 + tok) * 32 + j] + impb[(size_t)(3 * 64 + tok) * 32 + j]);
            if (j == 0 || j == qt || j == qt - 1) v = 1e6f; else if (j > qt) v = -1e6f;
            wsf[lane] = v;
            LDS_WAIT();
            int cnt = 0;
#pragma unroll
            for (int i = 0; i < 32; ++i) { const float vi = wsf[hi * 32 + i]; cnt += ((vi > v) || (vi == v && i < j)) ? 1 : 0; }
            const unsigned long long bal = __ballot(cnt < 8);
            if (r32 == 0) selm[tok] = (u32)(bal >> (hi * 32));
            LDS_WAIT();
        }
        __syncthreads();
    }
    u32 mk = selm[tsub * 32 + r32];
    if (PROBE != 0) { const u32 ref = ((const u32*)(ws + WS_SEL))[(tb + tq) * 2 + g];
        if (PROBE == 2 && hg == 0 && hi == 0 && ref != mk) atomicAdd((float*)(ws + WS_DBG), 100.f / 32768.f);
        mk = ref; }
    const float* smrow = sm + (size_t)(tb + t0 + tsub * 32) * 32 + h;
    { int t2 = tid; asm volatile("" : "+v"(t2)); fa_branch<2>(ws, lds, t2, tb, g, qt, h, 0xffffffffu, smrow + 16, osum); }
    { int t2 = tid; asm volatile("" : "+v"(t2)); fa_branch<1>(ws, lds, t2, tb, g, qt, h, mk, smrow + 8, osum); }
    { LAS bf16* stg = (LAS bf16*)(lds + w * 4096);
#pragma unroll
      for (int r = 0; r < 16; ++r)
#pragma unroll
          for (int d0 = 0; d0 < 2; ++d0) stg[crow(r, hi) * 64 + d0 * 32 + r32] = (bf16)f2bf(osum[d0][r]);
      LDS_WAIT();
      const bf16* za = (const bf16*)(ws + WS_ZA) + (size_t)(tb + t0 + tsub * 32 + (lane >> 3)) * 512 + h * 64 + (lane & 7) * 8;
      bf16* oa = (bf16*)(ws + WS_OA) + (size_t)(tb + t0 + tsub * 32 + (lane >> 3)) * 512 + h * 64 + (lane & 7) * 8;
      float dmax = 0.f;
#pragma unroll
      for (int i = 0; i < 4; ++i) {
          const u32x4 ov = *(const LAS u32x4*)(stg + (i * 8 + (lane >> 3)) * 64 + (lane & 7) * 8);
          const u32x4 zv = *(const u32x4*)(za + (size_t)i * 8 * 512);
          u32x4 rv;
#pragma unroll
          for (int e = 0; e < 4; ++e) rv[e] = pk2(bf2f(ov[e] & 0xffffu) * bf2f(zv[e] & 0xffffu), bf2f(ov[e] >> 16) * bf2f(zv[e] >> 16));
          if (PROBE == 0) *(u32x4*)(oa + (size_t)i * 8 * 512) = rv;
          else { const u32x4 old_ = *(const u32x4*)(oa + (size_t)i * 8 * 512);
#pragma unroll
              for (int e = 0; e < 4; ++e) { dmax = fmaxf(dmax, fabsf(bf2f(rv[e] & 0xffffu) - bf2f(old_[e] & 0xffffu))); dmax = fmaxf(dmax, fabsf(bf2f(rv[e] >> 16) - bf2f(old_[e] >> 16))); } }
      }
      if (PROBE == 1) atomicMax((unsigned*)(ws + WS_DBG), __float_as_uint(dmax));
      LDS_WAIT();
    }
    __syncthreads();
}
template <int PROBE>
__device__ __forceinline__ void fused_attn_phase(const Args& a, LAS unsigned char* lds, int tid) {
    for (int i = blockIdx.x; i < 256; i += gridDim.x) {
        const int bg = i >> 4, s = i & 15, g = bg & 1;
        LAS float* biasL = (LAS float*)(lds + FA_BIAS);
        for (int idx = tid; idx < 4 * 2048; idx += 512) biasL[idx] = a.in[9][rel_bucket(idx & 2047) * 8 + g * 4 + (idx >> 11)] * 1.4426950408889634f;
        __syncthreads();
#pragma unroll 1
        for (int uu = 0; uu < 2; ++uu) { int t2 = tid; asm volatile("" : "+v"(t2)); fused_attn_unit<PROBE>(a, lds, t2, bg >> 1, g, uu ? 31 - s : s); }
        __syncthreads();
    }
}

constexpr size_t DN_WN = 0, DN_QT = 16 * MiB, DN_KTT = 32 * MiB, DN_AQK = 48 * MiB;
constexpr size_t WS_UT = WS_XB, WS_GL = WS_GG;
constexpr int DA_RS = 132;
constexpr int DA_Q = 0, DA_K = 64 * DA_RS * 4, DA_V = 2 * 64 * DA_RS * 4, DA_L = 3 * 64 * DA_RS * 4, DA_GC = DA_L + 64 * 64 * 4, DA_BE = DA_GC + 256, DA_END = DA_BE + 256;
__device__ __forceinline__ void dn_stage_a_unit(const Args& a, LAS unsigned char* lds, int tid, int b, int h, int ci) {
    unsigned char* ws = a.ws;
    const int lane = tid & 63, w = tid >> 6;
    const int tb = b * SEQ, ts0 = ci * 64; const int chunk = (b * 4 + h) * 32 + ci;
    const bf16* qkvb = (const bf16*)(ws + WS_QKVB); const float* sm = (const float*)(ws + WS_SM);
    LAS float* qs = (LAS float*)(lds + DA_Q); LAS float* ks = (LAS float*)(lds + DA_K); LAS float* vs = (LAS float*)(lds + DA_V);
    LAS float* Ls = (LAS float*)(lds + DA_L); LAS float* gcs = (LAS float*)(lds + DA_GC); LAS float* bes = (LAS float*)(lds + DA_BE);
    {
        const float* conv_w = a.in[10];
#pragma unroll
        for (int part = 0; part < 3; ++part) {
            const int ch = part * 512 + h * 128 + 2 * lane;
            float cw0[4], cw1[4];
#pragma unroll
            for (int x = 0; x < 4; ++x) { cw0[x] = conv_w[x * 1536 + ch]; cw1[x] = conv_w[x * 1536 + ch + 1]; }
            float r0[11], r1[11];
#pragma unroll
            for (int i = 0; i < 11; ++i) { const int ts = ts0 + 8 * w - 3 + i;
                unsigned raw = 0u; if (ts >= 0) raw = *(const unsigned*)(qkvb + (size_t)(tb + ts) * 1536 + ch);
                r0[i] = bf2f(raw & 0xffffu); r1[i] = bf2f(raw >> 16); }
            LAS float* dst = (part == 0) ? qs : (part == 1) ? ks : vs;
#pragma unroll
            for (int i = 0; i < 8; ++i) {
                float a0 = 0.f, a1 = 0.f;
#pragma unroll
                for (int x = 0; x < 4; ++x) { a0 = fmaf(cw0[x], r0[i + x], a0); a1 = fmaf(cw1[x], r1[i + x], a1); }
                a0 = siluf_(a0); a1 = siluf_(a1);
                if (part < 2) { float ss = a0 * a0 + a1 * a1;
#pragma unroll
                    for (int o = 32; o > 0; o >>= 1) ss += wshfl_xor(ss, o, tid);
                    const float rn = 1.0f / sqrtf(ss + 1e-6f); a0 *= rn; a1 *= rn; }
                dst[(8 * w + i) * DA_RS + 2 * lane] = a0; dst[(8 * w + i) * DA_RS + 2 * lane + 1] = a1;
            }
        }
        if (w == 0) {
            const size_t row = (size_t)(tb + ts0 + lane);
            const float be = 1.f / (1.f + expf(-sm[row * 32 + 24 + h]));
            const float xx = sm[row * 32 + 28 + h] + a.in[12][h];
            const float sp = (xx > 20.f) ? xx : log1pf(expf(xx));
            float gc = -expf(a.in[11][h]) * sp;
#pragma unroll
            for (int o = 1; o < 64; o <<= 1) { const float up = __int_as_float(__builtin_amdgcn_ds_bpermute(((lane - o) & 63) << 2, __float_as_int(gc))); if (lane >= o) gc += up; }
            gcs[lane] = gc; bes[lane] = be;
            if (lane == 63) ((float*)(ws + WS_GL))[chunk] = expf(gc);
        }
    }
    __syncthreads();
    {
        const int n = lane & 15, kq = lane >> 4, ti = w >> 1;
        bf16x8 ak[4], aq[4];
#pragma unroll
        for (int sx = 0; sx < 4; ++sx) {
            const LAS float* kp = ks + (16 * ti + n) * DA_RS + 32 * sx + 8 * kq; const LAS float* qp = qs + (16 * ti + n) * DA_RS + 32 * sx + 8 * kq;
            const f32x4 k0 = *(const LAS f32x4*)kp, k1 = *(const LAS f32x4*)(kp + 4), q0 = *(const LAS f32x4*)qp, q1 = *(const LAS f32x4*)(qp + 4);
            u32x4 kw, qw; kw.x = cvtpk(k0.x, k0.y); kw.y = cvtpk(k0.z, k0.w); kw.z = cvtpk(k1.x, k1.y); kw.w = cvtpk(k1.z, k1.w);
            qw.x = cvtpk(q0.x, q0.y); qw.y = cvtpk(q0.z, q0.w); qw.z = cvtpk(q1.x, q1.y); qw.w = cvtpk(q1.z, q1.w);
            ak[sx] = __builtin_bit_cast(bf16x8, kw); aq[sx] = __builtin_bit_cast(bf16x8, qw); }
        bf16* aqk = (bf16*)((unsigned char*)a.out + DN_AQK) + (size_t)chunk * 4096;
#pragma unroll
        for (int tt = 0; tt < 2; ++tt) {
            const int tj = 2 * (w & 1) + tt;
            f32x4 kk = (f32x4){0.f, 0.f, 0.f, 0.f}, qk = kk;
            if (tj <= ti) {
#pragma unroll
                for (int sx = 0; sx < 4; ++sx) {
                    const LAS float* bp = ks + (16 * tj + n) * DA_RS + 32 * sx + 8 * kq;
                    const f32x4 b0 = *(const LAS f32x4*)bp, b1 = *(const LAS f32x4*)(bp + 4);
                    u32x4 bw; bw.x = cvtpk(b0.x, b0.y); bw.y = cvtpk(b0.z, b0.w); bw.z = cvtpk(b1.x, b1.y); bw.w = cvtpk(b1.z, b1.w);
                    const bf16x8 bf = __builtin_bit_cast(bf16x8, bw);
                    kk = __builtin_amdgcn_mfma_f32_16x16x32_bf16(ak[sx], bf, kk, 0, 0, 0);
                    qk = __builtin_amdgcn_mfma_f32_16x16x32_bf16(aq[sx], bf, qk, 0, 0, 0);
                }
            }
            const int jc = 16 * tj + n; const float gj = gcs[jc];
#pragma unroll
            for (int e = 0; e < 4; ++e) { const int c = 16 * ti + 4 * kq + e; const float dec = (jc <= c) ? expf(gcs[c] - gj) : 0.f;
                Ls[c * 64 + jc] = (jc < c) ? bes[c] * kk[e] * dec : 0.f;
                aqk[c * 64 + jc] = (bf16)f2bf(qk[e] * dec * 0.08838834764831845f); }
        }
    }
    {
        { const int c = tid >> 3, k0 = (tid & 7) * 16; const float f = 0.08838834764831845f * expf(gcs[c]);
          bf16* qt = (bf16*)((unsigned char*)a.out + DN_QT) + (size_t)chunk * 8192 + c * 128 + k0;
#pragma unroll
          for (int k = 0; k < 16; k += 8) { const f32x4 x0 = *(const LAS f32x4*)(qs + c * DA_RS + k0 + k), x1 = *(const LAS f32x4*)(qs + c * DA_RS + k0 + k + 4);
              u32x4 o; o.x = pk2(x0.x * f, x0.y * f); o.y = pk2(x0.z * f, x0.w * f); o.z = pk2(x1.x * f, x1.y * f); o.w = pk2(x1.z * f, x1.w * f); *(u32x4*)(qt + k) = o; } }
        { const int k = tid >> 2, c0 = (tid & 3) * 16; const float gl = gcs[63];
          bf16* ktt = (bf16*)((unsigned char*)a.out + DN_KTT) + (size_t)chunk * 8192 + k * 64 + c0;
#pragma unroll
          for (int c = 0; c < 16; c += 8) { float v[8];
#pragma unroll
              for (int e = 0; e < 8; ++e) v[e] = ks[(c0 + c + e) * DA_RS + k] * expf(gl - gcs[c0 + c + e]);
              u32x4 o; o.x = pk2(v[0], v[1]); o.y = pk2(v[2], v[3]); o.z = pk2(v[4], v[5]); o.w = pk2(v[6], v[7]); *(u32x4*)(ktt + c) = o; } }
    }
    __syncthreads();
    LAS float* Tm = (LAS float*)(lds + DA_END);
    LAS unsigned char* XT = lds + DA_Q;
    {
#pragma unroll
        for (int i = 0; i < 4; ++i) *(LAS u32x4*)(XT + (tid + 512 * i) * 16) = (u32x4){0u, 0u, 0u, 0u};
        if (w == 0) {
            const int blk = lane >> 4, col = lane & 15; const LAS float* Lb = Ls + (16 * blk) * 64 + 16 * blk;
            float x[16];
#pragma unroll
            for (int r = 0; r < 16; ++r) {
                float acc = (r == col) ? 1.f : 0.f;
#pragma unroll
                for (int s4 = 0; s4 < r; s4 += 4) { const f32x4 lv = *(const LAS f32x4*)(Lb + r * 64 + s4);
                    acc = fmaf(-lv.x, x[s4], acc); if (s4 + 1 < r) acc = fmaf(-lv.y, x[s4 + 1], acc); if (s4 + 2 < r) acc = fmaf(-lv.z, x[s4 + 2], acc); if (s4 + 3 < r) acc = fmaf(-lv.w, x[s4 + 3], acc); }
                x[r] = acc;
                Tm[(blk * 16 + r) * 16 + col] = acc - ((r == col) ? 1.f : 0.f);
            }
        }
    }
    __syncthreads();
    {
        const int n = lane & 15, kq = lane >> 4; const bool isv = w >= 4;
        const LAS float* src = isv ? vs : ks;
#pragma unroll
        for (int nt = 0; nt < 2; ++nt) {
            const int col = 32 * w + 16 * nt + n, colk = col & 127;
            LAS unsigned char* xt = XT + col * 128;
#pragma unroll
            for (int i = 0; i < 4; ++i) {
                f32x4 acc;
#pragma unroll
                for (int e = 0; e < 4; ++e) { const int c = 16 * i + 4 * kq + e; float r = bes[c] * src[c * DA_RS + colk]; if (!isv) r *= expf(gcs[c]); acc[e] = r; }
#pragma unroll
                for (int kb = 0; kb < 16 * i; kb += 32) {
                    const bool live = (kb + 8 * kq) < 16 * i;
                    const LAS float* lp = Ls + (16 * i + n) * 64 + kb + 8 * kq;
                    const f32x4 l0 = *(const LAS f32x4*)lp, l1 = *(const LAS f32x4*)(lp + 4);
                    u32x4 aw; aw.x = cvtpk(-l0.x, -l0.y); aw.y = cvtpk(-l0.z, -l0.w); aw.z = cvtpk(-l1.x, -l1.y); aw.w = cvtpk(-l1.z, -l1.w);
                    if (!live) aw = (u32x4){0u, 0u, 0u, 0u};
                    const bf16x8 bfr = *(const LAS bf16x8*)(xt + (kb + 8 * kq) * 2);
                    acc = __builtin_amdgcn_mfma_f32_16x16x32_bf16(__builtin_bit_cast(bf16x8, aw), bfr, acc, 0, 0, 0);
                }
                { const f32x4 tv = *(const LAS f32x4*)(Tm + (i * 16 + n) * 16 + 4 * kq);
                  u32x4 aw; aw.x = cvtpk(tv.x, tv.y); aw.y = cvtpk(tv.z, tv.w); aw.z = 0u; aw.w = 0u;
                  u32x4 bw; bw.x = cvtpk(acc[0], acc[1]); bw.y = cvtpk(acc[2], acc[3]); bw.z = 0u; bw.w = 0u;
                  acc = __builtin_amdgcn_mfma_f32_16x16x32_bf16(__builtin_bit_cast(bf16x8, aw), __builtin_bit_cast(bf16x8, bw), acc, 0, 0, 0); }
                if (i < 3) { u32x2 xw; xw.x = cvtpk(acc[0], acc[1]); xw.y = cvtpk(acc[2], acc[3]); *(LAS u32x2*)(xt + (16 * i + 4 * kq) * 2) = xw; LDS_WAIT(); }
                if (!isv) { bf16* wn = (bf16*)((unsigned char*)a.out + DN_WN) + (size_t)chunk * 8192 + (16 * i + 4 * kq) * 128 + colk;
#pragma unroll
                    for (int e = 0; e < 4; ++e) wn[e * 128] = (bf16)f2bf(-acc[e]); }
                else { float* ut = (float*)(ws + WS_UT) + (size_t)chunk * 8192 + colk * 64 + 16 * i + 4 * kq; *(f32x4*)ut = acc; }
            }
        }
    }
    __syncthreads();
}
__device__ __forceinline__ void dn_stage_a_phase(const Args& a, LAS unsigned char* lds, int tid) {
    for (int u = blockIdx.x; u < 1024; u += gridDim.x) { int t2 = tid; asm volatile("" : "+v"(t2)); dn_stage_a_unit(a, lds, t2, u >> 7, (u >> 5) & 3, u & 31); }
}
typedef float f32x4v __attribute__((ext_vector_type(4)));
constexpr int DB_ST = 0, DB_VN = 4096;
__device__ __forceinline__ void dn_scan_mfma_phase(const Args& a, LAS unsigned char* lds, int tid) {
    unsigned char* ws = a.ws;
    const int lane = tid & 63, w = __builtin_amdgcn_readfirstlane(tid >> 6), n = lane & 15, kq = lane >> 4;
    for (int u0 = blockIdx.x; u0 < 256; u0 += gridDim.x) {
        const int xcd = u0 & 7, idx = u0 >> 3, bh = xcd * 4 + (idx >> 3), sl = idx & 7, b = bh >> 2, h = bh & 3;
        const size_t chunk0 = (size_t)bh * 32;
        const bf16* WN = (const bf16*)((const unsigned char*)a.out + DN_WN) + chunk0 * 8192;
        const bf16* QT = (const bf16*)((const unsigned char*)a.out + DN_QT) + chunk0 * 8192;
        const bf16* KTT = (const bf16*)((const unsigned char*)a.out + DN_KTT) + chunk0 * 8192;
        const bf16* AQK = (const bf16*)((const unsigned char*)a.out + DN_AQK) + chunk0 * 4096;
        const float* UT = (const float*)(ws + WS_UT) + chunk0 * 8192 + (size_t)(sl * 16) * 64;
        const float* GL = (const float*)(ws + WS_GL) + chunk0;
        float* od = (float*)(ws + WS_OD) + (size_t)(b * SEQ) * 512 + h * 128 + sl * 16;
        for (int i = tid; i < (4096 + 2048) / 4; i += 512) ((LAS unsigned*)(lds + DB_ST))[i] = 0u;
        __syncthreads();
        f32x4v sacc[2]; sacc[0] = (f32x4v){0.f, 0.f, 0.f, 0.f}; sacc[1] = sacc[0];
        const int i = w;
        for (int c = 0; c < 32; ++c) {
            if (w < 4) {
                const bf16* wn = WN + (size_t)c * 8192 + (16 * i + n) * 128 + kq * 8;
                const bf16* qt = QT + (size_t)c * 8192 + (16 * i + n) * 128 + kq * 8;
                bf16x8 wf[4], qf[4], sf[4];
#pragma unroll
                for (int ks = 0; ks < 4; ++ks) { wf[ks] = *(const bf16x8*)(wn + ks * 32); qf[ks] = *(const bf16x8*)(qt + ks * 32); sf[ks] = *(const LAS bf16x8*)(lds + DB_ST + n * 256 + ks * 64 + kq * 16); }
                f32x4v vacc = *(const f32x4v*)(UT + (size_t)c * 8192 + n * 64 + 16 * i + 4 * kq);
                f32x4v oacc = (f32x4v){0.f, 0.f, 0.f, 0.f};
#pragma unroll
                for (int ks = 0; ks < 4; ++ks) { vacc = __builtin_amdgcn_mfma_f32_16x16x32_bf16(wf[ks], sf[ks], vacc, 0, 0, 0); oacc = __builtin_amdgcn_mfma_f32_16x16x32_bf16(qf[ks], sf[ks], oacc, 0, 0, 0); }
                u32x2 pv; pv.x = cvtpk(vacc[0], vacc[1]); pv.y = cvtpk(vacc[2], vacc[3]);
                *(LAS u32x2*)(lds + DB_VN + n * 128 + (16 * i + 4 * kq) * 2) = pv;
                LDS_WAIT();
                __syncthreads();
                bf16x8 vf[2];
#pragma unroll
                for (int k2 = 0; k2 < 2; ++k2) vf[k2] = *(const LAS bf16x8*)(lds + DB_VN + n * 128 + k2 * 64 + kq * 16);
                const bf16* aq = AQK + (size_t)c * 4096 + (16 * i + n) * 64 + kq * 8;
#pragma unroll
                for (int k2 = 0; k2 < 2; ++k2) oacc = __builtin_amdgcn_mfma_f32_16x16x32_bf16(*(const bf16x8*)(aq + k2 * 32), vf[k2], oacc, 0, 0, 0);
                float* op = od + (size_t)(c * 64 + 16 * i + 4 * kq) * 512 + n;
#pragma unroll
                for (int e = 0; e < 4; ++e) op[(size_t)e * 512] = oacc[e];
                const float gl = GL[c];
#pragma unroll
                for (int mt = 0; mt < 2; ++mt) { const int m = 2 * i + mt; const bf16* kt = KTT + (size_t)c * 8192 + (16 * m + n) * 64 + kq * 8;
                    sacc[mt] = sacc[mt] * gl;
#pragma unroll
                    for (int k2 = 0; k2 < 2; ++k2) sacc[mt] = __builtin_amdgcn_mfma_f32_16x16x32_bf16(*(const bf16x8*)(kt + k2 * 32), vf[k2], sacc[mt], 0, 0, 0);
                    u32x2 ps; ps.x = cvtpk(sacc[mt][0], sacc[mt][1]); ps.y = cvtpk(sacc[mt][2], sacc[mt][3]);
                    *(LAS u32x2*)(lds + DB_ST + n * 256 + (16 * m + 4 * kq) * 2) = ps; }
                LDS_WAIT();
                __syncthreads();
            } else { __syncthreads(); __syncthreads(); }
        }
    }
}

__device__ __forceinline__ void dn_scan_phase(const Args& a, LAS unsigned char* lds, int tid) {
    if (tid >= 64) return;
    unsigned char* ws = a.ws; const int lane = tid, kq = lane >> 4, vc = lane & 15;
    const bf16* qn = (const bf16*)a.out; const bf16* kn = qn + (size_t)T * 512; const bf16* vv = kn + (size_t)T * 512;
    const float* gg = (const float*)(ws + WS_GG); const float* bb = (const float*)(ws + WS_BB);
    float* od = (float*)(ws + WS_OD);
    LAS unsigned char* kbuf = lds; LAS unsigned char* qbuf = lds + 16384; LAS unsigned char* vbuf = lds + 32768;
    for (int u = blockIdx.x; u < 256; u += gridDim.x) {
        const int b = u >> 5, h = (u >> 3) & 3, vb = u & 7;
        float S[32];
#pragma unroll
        for (int k = 0; k < 32; ++k) S[k] = 0.f;
        for (int c = 0; c < 32; ++c) {
            const int t0 = b * SEQ + c * 64;
#pragma unroll 4
            for (int i = 0; i < 16; ++i) { const int p = i * 64 + lane, row = p >> 4, ch = p & 15;
                *(LAS u32x4*)(kbuf + row * 256 + ch * 16) = *(const u32x4*)(kn + (size_t)(t0 + row) * 512 + h * 128 + ch * 8);
                *(LAS u32x4*)(qbuf + row * 256 + ch * 16) = *(const u32x4*)(qn + (size_t)(t0 + row) * 512 + h * 128 + ch * 8); }
#pragma unroll
            for (int i = 0; i < 2; ++i) { const int p = i * 64 + lane, row = p >> 1, ch = p & 1;
                *(LAS u32x4*)(vbuf + row * 32 + ch * 16) = *(const u32x4*)(vv + (size_t)(t0 + row) * 512 + h * 128 + vb * 16 + ch * 8); }
            const float gl = gg[(t0 + lane) * 4 + h], bl = bb[(t0 + lane) * 4 + h];
            LDS_WAIT();
            for (int s = 0; s < 64; ++s) {
                const float alpha = expf(__int_as_float(__builtin_amdgcn_readlane(__float_as_int(gl), s)));
                const float beta = __int_as_float(__builtin_amdgcn_readlane(__float_as_int(bl), s));
                const float v = bf2f(*(const LAS bf16*)(vbuf + s * 32 + vc * 2));
                float kk[32];
#pragma unroll
                for (int k8 = 0; k8 < 4; ++k8) { const u32x4 w = *(const LAS u32x4*)(kbuf + s * 256 + kq * 64 + k8 * 16);
                    kk[k8 * 8 + 0] = bf2f(w.x & 0xffffu); kk[k8 * 8 + 1] = bf2f(w.x >> 16); kk[k8 * 8 + 2] = bf2f(w.y & 0xffffu); kk[k8 * 8 + 3] = bf2f(w.y >> 16);
                    kk[k8 * 8 + 4] = bf2f(w.z & 0xffffu); kk[k8 * 8 + 5] = bf2f(w.z >> 16); kk[k8 * 8 + 6] = bf2f(w.w & 0xffffu); kk[k8 * 8 + 7] = bf2f(w.w >> 16); }
                float kS = 0.f;
#pragma unroll
                for (int k = 0; k < 32; ++k) { S[k] *= alpha; kS = fmaf(kk[k], S[k], kS); }
                kS += wshfl_xor(kS, 16, tid); kS += wshfl_xor(kS, 32, tid);
                const float vn = beta * (v - kS);
                float o = 0.f;
#pragma unroll
                for (int k8 = 0; k8 < 4; ++k8) { const u32x4 wq = *(const LAS u32x4*)(qbuf + s * 256 + kq * 64 + k8 * 16);
                    const float qq[8] = {bf2f(wq.x & 0xffffu), bf2f(wq.x >> 16), bf2f(wq.y & 0xffffu), bf2f(wq.y >> 16), bf2f(wq.z & 0xffffu), bf2f(wq.z >> 16), bf2f(wq.w & 0xffffu), bf2f(wq.w >> 16)};
#pragma unroll
                    for (int e = 0; e < 8; ++e) { S[k8 * 8 + e] = fmaf(kk[k8 * 8 + e], vn, S[k8 * 8 + e]); o = fmaf(qq[e], S[k8 * 8 + e], o); } }
                o += wshfl_xor(o, 16, tid); o += wshfl_xor(o, 32, tid);
                if (kq == 0) od[(size_t)(t0 + s) * 512 + h * 128 + vb * 16 + vc] = o * 0.08838834764831845f;
            }
            LDS_WAIT();
        }
    }
}

__device__ __forceinline__ void dn_out_phase(const Args& a, LAS unsigned char* lds, int tid) {
    unsigned char* ws = a.ws; const float* od = (const float*)(ws + WS_OD); const bf16* zb = (const bf16*)(ws + WS_ZB); const float* norm_w = a.in[13];
    bf16* ob = (bf16*)a.out;
    LAS float* red = (LAS float*)lds;
    const int h = tid >> 7, d = tid & 127, wave = tid >> 6; const float nw = norm_w[d];
    for (int t = blockIdx.x; t < T; t += gridDim.x) {
        const size_t o = (size_t)t * 512 + h * 128 + d;
        const float v = od[o]; float s = v * v;
#pragma unroll
        for (int off = 32; off > 0; off >>= 1) s += wshfl_xor(s, off, tid);
        if ((tid & 63) == 0) red[wave] = s;
        __syncthreads();
        s = (red[h * 2] + red[h * 2 + 1]) * (1.f / 128.f);
        ob[o] = (bf16)f2bf(v * (1.0f / sqrtf(s + 1e-6f)) * nw * bf2f(zb[o]));
        __syncthreads();
    }
}

__device__ __forceinline__ void final_ln_phase(const Args& a, int tid) {
    const int lane = tid & 63, wave = tid >> 6; const int gw = blockIdx.x * 8 + wave, NGW = gridDim.x * 8;
    const float* ln_g = a.in[19]; const float* ln_b = a.in[20];
    f32x4 gv[4], bv[4];
#pragma unroll
    for (int j = 0; j < 4; ++j) { gv[j] = ((const f32x4*)ln_g)[lane + 64 * j]; bv[j] = ((const f32x4*)ln_b)[lane + 64 * j]; }
    for (int m = gw; m < T; m += NGW) {
        f32x4* xr = (f32x4*)(a.out + (size_t)m * 1024) + lane;
        f32x4 v[4]; float s = 0.f;
#pragma unroll
        for (int j = 0; j < 4; ++j) { v[j] = xr[64 * j]; s += (v[j].x + v[j].y) + (v[j].z + v[j].w); }
#pragma unroll
        for (int o = 1; o < 64; o <<= 1) s += wshfl_xor(s, o, tid);
        const float mean = s * (1.f / 1024.f); float s2 = 0.f;
#pragma unroll
        for (int j = 0; j < 4; ++j) { v[j] = v[j] - mean; s2 += (v[j].x * v[j].x + v[j].y * v[j].y) + (v[j].z * v[j].z + v[j].w * v[j].w); }
#pragma unroll
        for (int o = 1; o < 64; o <<= 1) s2 += wshfl_xor(s2, o, tid);
        const float rstd = 1.0f / sqrtf(s2 * (1.f / 1024.f) + 1e-5f);
#pragma unroll
        for (int j = 0; j < 4; ++j) xr[64 * j] = v[j] * rstd * gv[j] + bv[j];
    }
}

__global__ void __launch_bounds__(512, 2) mega_fwd(Args a) {
    extern __shared__ __attribute__((aligned(16))) unsigned char lds_raw[];
    LAS unsigned char* lds = (LAS unsigned char*)lds_raw;
    cg::grid_group grid = cg::this_grid();
    int tid = threadIdx.x; const int G = gridDim.x;
    unsigned char* ws = a.ws;
#ifdef PROBE_TS
    unsigned long long ts_prev = __builtin_amdgcn_s_memrealtime(); int ts_n = 0; float ts_val = 0.f;
#define STAMP() do { const unsigned long long t_ = __builtin_amdgcn_s_memrealtime(); if (ts_n == PROBE_TS) ts_val = (float)(t_ - ts_prev) * 1e-3f; ts_prev = t_; ++ts_n; } while (0)
#else
#define STAMP() do {} while (0)
#endif
#define FRESH_TID() do { tid = threadIdx.x; asm volatile("" : "+v"(tid)); } while (0)

    FRESH_TID();
    p0_prologue(a, lds, tid);
    grid.sync(); STAMP();
    { pg8::Gemm g{(const pg8::bf16_t*)(ws + WS_XB), (const pg8::bf16_t*)(ws + WS_WIN), T, 6144, 1024}; pg8::StaticOrder S; S.init(T, 6144, G, (int)blockIdx.x);
      EpiProj E{ws}; pg8::gemm_phase<EpiProj, pg8::StaticOrder, true, true>(lds, g, S, E); }
    grid.sync(); STAMP();
#if !defined(PROBE_FUSED)
#ifdef DN_SEQ
    FRESH_TID(); dn_prep_phase(a, lds, tid);
#else
    FRESH_TID(); dn_stage_a_phase(a, lds, tid);
#endif
    __syncthreads();
#ifdef SIMPLE_G1
    FRESH_TID(); cmp_gemm1_phase(a, lds, tid);
#else
    FRESH_TID(); cmp_gemm1_mfma_phase(a, lds, tid);
#endif
    grid.sync(); STAMP();
    FRESH_TID(); cmp_gemm2_phase(a, lds, tid);
    __syncthreads();
#ifdef DN_SEQ
    FRESH_TID(); dn_scan_phase(a, lds, tid);
#else
    FRESH_TID(); dn_scan_mfma_phase(a, lds, tid);
#endif
    grid.sync(); STAMP();
    FRESH_TID(); fused_attn_phase<0>(a, lds, tid);
    __syncthreads();
    FRESH_TID(); dn_out_phase(a, lds, tid);
    grid.sync(); STAMP();
#else
    FRESH_TID(); dn_prep_phase(a, lds, tid);
    __syncthreads();
    FRESH_TID(); cmp_gemm1_phase(a, lds, tid);
    __syncthreads();
    FRESH_TID(); attn_mfma_phase<2, false>(a, lds, tid);
    grid.sync();
    FRESH_TID(); cmp_gemm2_phase(a, lds, tid);
    __syncthreads();
    FRESH_TID(); dn_scan_phase(a, lds, tid);
    grid.sync();
    FRESH_TID(); attn_simple_phase<0>(a, lds, tid);
    grid.sync();
    FRESH_TID(); attn_mfma_phase<1, false>(a, lds, tid);
    grid.sync();
    FRESH_TID(); fused_attn_phase<PROBE_FUSED>(a, lds, tid);
    __syncthreads();
    FRESH_TID(); dn_out_phase(a, lds, tid);
    grid.sync();
#endif
    { pg8::Gemm g{(const pg8::bf16_t*)(ws + WS_OA), (const pg8::bf16_t*)(ws + WS_WA), T, 1024, 512}; pg8::StaticOrder S; S.init(T, 1024, G, (int)blockIdx.x);
      EpiYA E{(const bf16*)(ws + WS_GM), (float*)(ws + WS_PARTA)}; pg8::gemm_phase<EpiYA, pg8::StaticOrder, true, true>(lds, g, S, E); }
    { pg8::Gemm g{(const pg8::bf16_t*)a.out, (const pg8::bf16_t*)(ws + WS_WB), T, 1024, 512}; pg8::StaticOrder S; S.init(T, 1024, G, (int)blockIdx.x);
      EpiYB E{(const bf16*)(ws + WS_GM), (const float*)(ws + WS_PARTA), (bf16*)(ws + WS_M)}; pg8::gemm_phase<EpiYB, pg8::StaticOrder, true, true>(lds, g, S, E); }
    grid.sync(); STAMP();
    { pg8::Gemm g{(const pg8::bf16_t*)(ws + WS_M), (const pg8::bf16_t*)(ws + WS_WOUT), T, 1024, 1024}; pg8::StaticOrder S; S.init(T, 1024, G, (int)blockIdx.x);
      EpiH E{a.in[0], (float*)(ws + WS_H), (bf16*)(ws + WS_HB)}; pg8::gemm_phase<EpiH, pg8::StaticOrder, true, true>(lds, g, S, E); }
    { pg8::Gemm g{(const pg8::bf16_t*)(ws + WS_PB), (const pg8::bf16_t*)(ws + WS_WPLE), T, 1024, 256}; pg8::StaticOrder S; S.init(T, 1024, G, (int)blockIdx.x);
      EpiPE E{(float*)(ws + WS_PE)}; pg8::gemm_phase<EpiPE, pg8::StaticOrder, true, true>(lds, g, S, E); }
    grid.sync(); STAMP();
    { pg8::Gemm g{(const pg8::bf16_t*)(ws + WS_HB), (const pg8::bf16_t*)(ws + WS_WPG), T, 1024, 1024}; pg8::StaticOrder S; S.init(T, 1024, G, (int)blockIdx.x);
      EpiGate E{(const float*)(ws + WS_H), (const float*)(ws + WS_PE), a.out}; pg8::gemm_phase<EpiGate, pg8::StaticOrder, true, true>(lds, g, S, E); }
    grid.sync(); STAMP();
    FRESH_TID(); final_ln_phase(a, tid);
#if defined(PROBE_WIN) || defined(PROBE_SEL) || defined(PROBE_FUSED)
    if (blockIdx.x == 0 && threadIdx.x == 0) a.out[0] += *(const float*)(ws + WS_DBG) * (PROBE_SCALE);
#endif
#ifdef PROBE_TS
    STAMP();
    if (blockIdx.x == 0 && threadIdx.x == 0) a.out[0] += ts_val;
#endif
}

extern "C" void kernel_launch(void* const* d_in, const int* in_sizes, int n_in, void* d_out, int out_size, void* d_ws, size_t ws_size, hipStream_t stream) {
    static int grid = 0;
    if (grid == 0) {
        if (n_in != 21 || out_size != T * DM || ws_size < WS_END) { fprintf(stderr, "kernel_launch: unexpected shapes (n_in %d out %d ws %zu)\n", n_in, out_size, ws_size); grid = -1; return; }
        int dev = 0, cus = 0, per_cu = 0;
        hipGetDevice(&dev); hipDeviceGetAttribute(&cus, hipDeviceAttributeMultiprocessorCount, dev);
        hipFuncSetAttribute((const void*)mega_fwd, hipFuncAttributeMaxDynamicSharedMemorySize, LDS_BYTES);
        hipOccupancyMaxActiveBlocksPerMultiprocessor(&per_cu, (const void*)mega_fwd, 512, LDS_BYTES);
        if (per_cu < 1) { fprintf(stderr, "kernel_launch: occupancy query says %d blocks/CU\n", per_cu); per_cu = 1; }
        grid = cus;
        (void)hipGetLastError();
    }
    if (grid < 0) return;
    Args a{};
    for (int i = 0; i < 21; ++i) a.in[i] = (const float*)d_in[i];
    a.out = (float*)d_out; a.ws = (unsigned char*)d_ws;
    void* args[] = {&a};
    hipError_t e = hipLaunchCooperativeKernel((const void*)mega_fwd, dim3(grid), dim3(512), args, LDS_BYTES, stream);
    if (e != hipSuccess) fprintf(stderr, "cooperative launch failed: %s (grid %d)\n", hipGetErrorString(e), grid);
}
```

```cpp
#include <hip/hip_runtime.h>
#include <hip/hip_cooperative_groups.h>
#include <cstdio>
#include <cstdint>
#include <cmath>
namespace cg = cooperative_groups;
namespace pg8 {
#define PG8_LAS __attribute__((address_space(3)))
typedef unsigned short bf16_t;
typedef short bf16x8 __attribute__((ext_vector_type(8)));
typedef float f32x4 __attribute__((ext_vector_type(4)));
typedef unsigned u32x4 __attribute__((ext_vector_type(4)));
constexpr int BM = 256, BK = 64, HALF = 128, HTB = HALF * BK * 2  , STAGE_BYTES = 8 * HTB, NXCD = 8, WGM = 8;

__host__ __device__ __forceinline__ int lds_byte(int r, int c) { const int st = (r >> 4) * 2 + (c >> 5), rr = r & 15, cc = c & 31, ob = rr * 64 + cc * 2; return st * 1024 + (ob ^ (((ob >> 9) & 1) << 5)); }
__host__ __device__ __forceinline__ void stage_rc(int b, int& R, int& C) { const int st = b / 1024, sb = b % 1024, swz = sb ^ (((sb >> 9) & 1) << 5); R = (st >> 1) * 16 + swz / 64; C = (st & 1) * 32 + (swz % 64) / 2; }
__host__ __device__ __forceinline__ int perm32(int rho) { const int n = rho >> 4, i = rho & 15; return 8 * (i >> 2) + 4 * n + (i & 3); }

struct Unit { int pm, pn; };
struct Gemm { const bf16_t* A; const bf16_t* Bt; int M, N, K; };

struct StaticOrder {
    int nM, nN, nwg, G, c;
    __host__ __device__ void init(int M, int N, int G_, int c_) { nM = M / BM; nN = N / BM; nwg = nM * nN; G = G_; c = c_; }
    __host__ __device__ bool next(int i, Unit& u) const {
        const long L = (long)i * G + c; if (L >= nwg) return false;
        int wgid = (int)L; { const int q = nwg / NXCD, r = nwg % NXCD, xcd = wgid % NXCD, off = wgid / NXCD; wgid = (xcd < r ? xcd * (q + 1) : r * (q + 1) + (xcd - r) * q) + off; }
        const int nig = WGM * nN, gid = wgid / nig, fm = gid * WGM, gsz = (nM - fm) < WGM ? (nM - fm) : WGM;
        u.pm = fm + ((wgid % nig) % gsz); u.pn = (wgid % nig) / gsz; return true;
    }
    __device__ __forceinline__ void a_ready(const Unit&) const {}
    __device__ __forceinline__ void done(const Unit&) const {}
};

__device__ __forceinline__ unsigned cvt_pk_bf16(float lo, float hi) { unsigned r; asm volatile("v_cvt_pk_bf16_f32 %0, %1, %2" : "=v"(r) : "v"(lo), "v"(hi)); return r; }
typedef float f32x2 __attribute__((ext_vector_type(2)));
template <class Epi, class Sched, bool ALIGN_EPI = false, bool SP2 = false>
__device__ __forceinline__ void gemm_phase(PG8_LAS unsigned char* lds, const Gemm g, const Sched& S, const Epi& E) {
    int tid_ = threadIdx.x; asm volatile("" : "+v"(tid_)); const int tid = tid_, wid = __builtin_amdgcn_readfirstlane(tid >> 6), lane = tid & 63, wr = wid >> 2, wc = wid & 3, fr = lane & 15, fq = lane >> 4;
    const int K = g.K, nt = K / BK;
    unsigned voffA[2], voffB[2];
#pragma unroll
    for (int i = 0; i < 2; ++i) { int R, C; stage_rc(tid * 16 + i * 8192, R, C); const int Rb = Epi::PERM ? ((R & ~31) + perm32(R & 31)) : R;
        voffA[i] = (unsigned)(R * K + C) * 2u; voffB[i] = (unsigned)(Rb * K + C) * 2u; }
    const size_t kstep = (size_t)(BK * 2);
    const size_t hstep = (size_t)HALF * K * 2;
    const size_t tstep = 2 * hstep;
    const unsigned ldsw = (unsigned)wid * 1024u;
    const int aoff = lds_byte(wr * 64 + fr, fq * 8), boff = lds_byte(wc * 32 + fr, fq * 8);
#define PG8_SA(b, h) (((b) * 2 + (h)) * HTB)
#define PG8_SB(b, h) ((4 + (b) * 2 + (h)) * HTB)
#define PG8_STAGE(bufoff, gbase, voff) do { _Pragma("unroll") for (int _i = 0; _i < 2; ++_i) \
        __builtin_amdgcn_global_load_lds((const unsigned*)((const char*)(gbase) + (voff)[_i]), (PG8_LAS unsigned*)(lds + (bufoff) + ldsw + _i * 8192), 16, 0, 0); } while (0)
#define PG8_LDA(dst, b, h) do { _Pragma("unroll") for (int m = 0; m < 4; ++m) _Pragma("unroll") for (int k = 0; k < 2; ++k) dst[m][k] = *(const PG8_LAS bf16x8*)(lds + PG8_SA(b, h) + aoff + m * 2048 + k * 1024); } while (0)
#define PG8_LDB(dst, b, h) do { _Pragma("unroll") for (int n = 0; n < 2; ++n) _Pragma("unroll") for (int k = 0; k < 2; ++k) dst[n][k] = *(const PG8_LAS bf16x8*)(lds + PG8_SB(b, h) + boff + n * 2048 + k * 1024); } while (0)
#define PG8_MMA(ai, bj, At, Bt) do { __builtin_amdgcn_s_setprio(1); _Pragma("unroll") for (int m = 0; m < 4; ++m) _Pragma("unroll") for (int n = 0; n < 2; ++n) _Pragma("unroll") for (int k = 0; k < 2; ++k) \
        acc[ai][bj][m][n] = __builtin_amdgcn_mfma_f32_16x16x32_bf16(Bt[n][k], At[m][k], acc[ai][bj][m][n], 0, 0, 0); __builtin_amdgcn_s_setprio(0); } while (0)
#define PG8_WAIT_V(n) asm volatile("s_waitcnt vmcnt(" #n ")" ::: "memory")
#define PG8_WAIT_L(n) asm volatile("s_waitcnt lgkmcnt(" #n ")" ::: "memory")
#define PG8_BAR __builtin_amdgcn_s_barrier()
#define PG8_SCHED __builtin_amdgcn_sched_barrier(0)
    Unit cur, nxt; int ui = 0;
    if (!S.next(0, cur)) return;
    f32x4 acc[2][2][4][2];
#pragma unroll
    for (int a = 0; a < 2; ++a)
#pragma unroll
        for (int b = 0; b < 2; ++b)
#pragma unroll
            for (int m = 0; m < 4; ++m)
#pragma unroll
                for (int n = 0; n < 2; ++n) acc[a][b][m][n] = (f32x4){0.f, 0.f, 0.f, 0.f};
    bf16x8 At[4][2], B0[2][2], B1[2][2];
    const char* cA = (const char*)g.A + (size_t)cur.pm * tstep; const char* cB = (const char*)g.Bt + (size_t)cur.pn * tstep;
    S.a_ready(cur);
    if constexpr (SP2) {
        PG8_STAGE(PG8_SB(0, 0), cB, voffB); PG8_STAGE(PG8_SB(0, 1), cB + hstep, voffB); PG8_STAGE(PG8_SA(0, 0), cA, voffA); PG8_STAGE(PG8_SA(0, 1), cA + hstep, voffA);
        if (wr == 1) PG8_BAR;
        PG8_WAIT_V(2); PG8_BAR;
        PG8_STAGE(PG8_SB(1, 0), cB + kstep, voffB); PG8_STAGE(PG8_SA(1, 0), cA + kstep, voffA); PG8_STAGE(PG8_SB(1, 1), cB + hstep + kstep, voffB);
        PG8_WAIT_V(6); PG8_BAR;
    } else {
        PG8_STAGE(PG8_SB(0, 0), cB, voffB); PG8_STAGE(PG8_SA(0, 0), cA, voffA); PG8_STAGE(PG8_SB(0, 1), cB + hstep, voffB); PG8_STAGE(PG8_SA(0, 1), cA + hstep, voffA);
        if (wr == 1) PG8_BAR;
        PG8_WAIT_V(4); PG8_BAR;
        PG8_STAGE(PG8_SB(1, 0), cB + kstep, voffB); PG8_STAGE(PG8_SA(1, 0), cA + kstep, voffA); PG8_STAGE(PG8_SB(1, 1), cB + hstep + kstep, voffB);
        PG8_WAIT_V(6); PG8_BAR;
    }
    for (;;) {
        const bool has_next = S.next(ui + 1, nxt);
        const char* nA = has_next ? (const char*)g.A + (size_t)nxt.pm * tstep : cA; const char* nB = has_next ? (const char*)g.Bt + (size_t)nxt.pn * tstep : cB;
        for (int t = 0; t < nt; t += 2) {
            const bool last = (t == nt - 2);
            const char* a1 = cA + (size_t)(t + 1) * kstep;
            const char* a2 = last ? nA : cA + (size_t)(t + 2) * kstep; const char* b2 = last ? nB : cB + (size_t)(t + 2) * kstep;
            const char* a3 = a2 + kstep; const char* b3 = b2 + kstep;
            if (last && has_next) S.a_ready(nxt);
            if constexpr (SP2) {
            PG8_LDB(B0, 0, 0); PG8_LDB(B1, 0, 1); PG8_SCHED; PG8_LDA(At, 0, 0); PG8_STAGE(PG8_SA(1, 1), a1 + hstep, voffA);
            PG8_WAIT_V(8); PG8_WAIT_L(0); PG8_BAR; PG8_MMA(0, 0, At, B0); PG8_MMA(0, 1, At, B1); PG8_BAR; PG8_SCHED;
            PG8_LDA(At, 0, 1); PG8_STAGE(PG8_SB(0, 0), b2, voffB); PG8_STAGE(PG8_SB(0, 1), b2 + hstep, voffB); PG8_STAGE(PG8_SA(0, 0), a2, voffA);
            PG8_WAIT_V(8); PG8_WAIT_L(0); PG8_BAR; PG8_MMA(1, 0, At, B0); PG8_MMA(1, 1, At, B1); PG8_BAR; PG8_SCHED;
            PG8_LDB(B0, 1, 0); PG8_LDB(B1, 1, 1); PG8_SCHED; PG8_LDA(At, 1, 0); PG8_STAGE(PG8_SA(0, 1), a2 + hstep, voffA);
            PG8_WAIT_V(8); PG8_WAIT_L(0); PG8_BAR; PG8_MMA(0, 0, At, B0); PG8_MMA(0, 1, At, B1); PG8_BAR; PG8_SCHED;
            PG8_LDA(At, 1, 1); PG8_STAGE(PG8_SB(1, 0), b3, voffB); PG8_STAGE(PG8_SB(1, 1), b3 + hstep, voffB); PG8_STAGE(PG8_SA(1, 0), a3, voffA);
            PG8_WAIT_V(8); PG8_WAIT_L(0); PG8_BAR; PG8_MMA(1, 0, At, B0); PG8_MMA(1, 1, At, B1); PG8_BAR; PG8_SCHED;
            } else {
            PG8_LDB(B0, 0, 0); PG8_SCHED; PG8_LDA(At, 0, 0); PG8_STAGE(PG8_SA(1, 1), a1 + hstep, voffA);
            PG8_WAIT_L(8); PG8_BAR; PG8_WAIT_L(0); PG8_MMA(0, 0, At, B0); PG8_BAR; PG8_SCHED;
            PG8_LDB(B1, 0, 1); PG8_STAGE(PG8_SB(0, 0), b2, voffB);
            PG8_BAR; PG8_WAIT_L(0); PG8_MMA(0, 1, At, B1); PG8_BAR;
            PG8_LDA(At, 0, 1); PG8_STAGE(PG8_SA(0, 0), a2, voffA);
            PG8_BAR; PG8_WAIT_L(0); PG8_MMA(1, 0, At, B0); PG8_BAR; PG8_SCHED;
            PG8_STAGE(PG8_SB(0, 1), b2 + hstep, voffB);
            PG8_WAIT_V(6); PG8_BAR; PG8_MMA(1, 1, At, B1); PG8_BAR;
            PG8_LDB(B0, 1, 0); PG8_SCHED; PG8_LDA(At, 1, 0); PG8_STAGE(PG8_SA(0, 1), a2 + hstep, voffA);
            PG8_WAIT_L(8); PG8_BAR; PG8_WAIT_L(0); PG8_MMA(0, 0, At, B0); PG8_BAR; PG8_SCHED;
            PG8_LDB(B1, 1, 1); PG8_STAGE(PG8_SB(1, 0), b3, voffB);
            PG8_BAR; PG8_WAIT_L(0); PG8_MMA(0, 1, At, B1); PG8_BAR;
            PG8_LDA(At, 1, 1); PG8_STAGE(PG8_SA(1, 0), a3, voffA);
            PG8_BAR; PG8_WAIT_L(0); PG8_MMA(1, 0, At, B0); PG8_BAR; PG8_SCHED;
            PG8_STAGE(PG8_SB(1, 1), b3 + hstep, voffB);
            PG8_WAIT_V(6); PG8_BAR; PG8_MMA(1, 1, At, B1); PG8_BAR;
            }
        }
        if constexpr (ALIGN_EPI) { if (wr == 0) PG8_BAR; }
        if constexpr (!Epi::AFTER_DRAIN) { E(acc, cur, wr, wc, fr, fq); S.done(cur); }
        if (!has_next) break;
#pragma unroll
        for (int a = 0; a < 2; ++a)
#pragma unroll
            for (int b = 0; b < 2; ++b)
#pragma unroll
                for (int m = 0; m < 4; ++m)
#pragma unroll
                    for (int n = 0; n < 2; ++n) acc[a][b][m][n] = (f32x4){0.f, 0.f, 0.f, 0.f};
        cur = nxt; cA = nA; cB = nB; ++ui;
        if constexpr (ALIGN_EPI) { if (wr == 1) PG8_BAR; }
    }
    PG8_WAIT_V(0);
    if constexpr (!ALIGN_EPI) { if (wr == 0) PG8_BAR; }
    PG8_BAR;
    if constexpr (Epi::AFTER_DRAIN) { E.fused(acc, cur, wr, wc, fr, fq, lds, wid, lane); S.done(cur); }
#undef PG8_SA
#undef PG8_SB
#undef PG8_STAGE
#undef PG8_LDA
#undef PG8_LDB
#undef PG8_MMA
#undef PG8_WAIT_V
#undef PG8_WAIT_L
#undef PG8_BAR
#undef PG8_SCHED
}
}

constexpr int T = 16384, SEQ = 2048, DM = 1024;
constexpr float ALPHA = 1.189207115002721f;
typedef unsigned short bf16;
typedef unsigned u32;
typedef unsigned u32x4 __attribute__((ext_vector_type(4)));
typedef unsigned u32x2 __attribute__((ext_vector_type(2)));
typedef float f32x4 __attribute__((ext_vector_type(4)));
typedef short bf16x8 __attribute__((ext_vector_type(8)));
#define LAS __attribute__((address_space(3)))
constexpr size_t MiB = (size_t)1 << 20;
constexpr size_t WS_WIN = 1 * MiB, WS_W1K = 13 * MiB, WS_W1V = 14 * MiB, WS_WA = 15 * MiB, WS_WB = 16 * MiB, WS_WOUT = 17 * MiB, WS_WPG = 19 * MiB, WS_WPLE = 21 * MiB;
constexpr size_t WS_PB = 22 * MiB, WS_SM = 30 * MiB, WS_XB = 32 * MiB, WS_Q = 64 * MiB, WS_KV = 80 * MiB, WS_ZA = 104 * MiB, WS_QKVB = 120 * MiB, WS_ZB = 168 * MiB, WS_GM = 184 * MiB;
constexpr size_t WS_HID = 248 * MiB, WS_KC = 250 * MiB, WS_VC = 250 * MiB + 512 * 1024, WS_SEL = 251 * MiB, WS_GG = 251 * MiB + 256 * 1024, WS_BB = 251 * MiB + 512 * 1024, WS_TBL = 252 * MiB, WS_DBG = 254 * MiB, WS_C1 = 254 * MiB + 8192, WS_KCB = 254 * MiB + 65536, WS_VCB = 254 * MiB + 65536 + 262144, WS_END = 255 * MiB;
constexpr size_t WS_OACC = WS_XB, WS_OD = WS_QKVB, WS_OA = WS_QKVB + 32 * MiB, WS_PARTA = 32 * MiB, WS_M = 96 * MiB, WS_H = 32 * MiB, WS_HB = 128 * MiB, WS_PE = 184 * MiB;
constexpr int LDS_BYTES = 147456;
constexpr int NDI = 28;

__device__ __forceinline__ float bf2f(unsigned v) { return __uint_as_float(v << 16); }
__device__ __forceinline__ unsigned f2bf(float f) { unsigned u = __float_as_uint(f); return (u + 0x7fffu + ((u >> 16) & 1u)) >> 16; }
__device__ __forceinline__ unsigned pk2(float lo, float hi) { return f2bf(lo) | (f2bf(hi) << 16); }
__device__ __forceinline__ float fexp(float x) { return __builtin_amdgcn_exp2f(x * 1.4426950408889634f); }
__device__ __forceinline__ float sigm(float x) { return __builtin_amdgcn_rcpf(1.f + fexp(-x)); }
__device__ __forceinline__ float siluf_(float x) { return x * sigm(x); }
__device__ __forceinline__ int rel_bucket(int n) {
    if (n < 16) return n < 0 ? 0 : n;
    return 16 + (n >= 21) + (n >= 27) + (n >= 35) + (n >= 46) + (n >= 59) + (n >= 77) + (n >= 99) + (n >= 128) + (n >= 166) + (n >= 216) + (n >= 280) + (n >= 363) + (n >= 470) + (n >= 609) + (n >= 790);
}
#define LDS_WAIT() asm volatile("s_waitcnt lgkmcnt(0)" ::: "memory")
typedef float f32x16 __attribute__((ext_vector_type(16)));
typedef short s16x4 __attribute__((ext_vector_type(4)));
__device__ __forceinline__ int crow(int r, int hi) { return (r & 3) + 8 * (r >> 2) + 4 * hi; }
__device__ __forceinline__ float wshfl_xor(float v, int o, int tid) { return __int_as_float(__builtin_amdgcn_ds_bpermute(((tid ^ o) & 63) << 2, __float_as_int(v))); }

#if defined(PROBE_FUSED)
#define PROBE_SCALE ((PROBE_FUSED) == 2 ? 1.f : 1000.f)
#else
#define PROBE_SCALE 1000.f
#endif
struct Args { const float* in[21]; float* out; unsigned char* ws; };

__device__ __forceinline__ int win_srccol(int r) {
    if (r < 1280) return r;
    if (r < 3328) return r + 24;
    if (r < 5888) return r + 32;
    if (r < 5912) return 1280 + (r - 5888);
    if (r < 5916) return 3352 + (r - 5912);
    if (r < 5920) return 3356 + (r - 5916);
    return -1;
}
template <bool REMAP>
__device__ __forceinline__ void transpose_item(const float* __restrict__ W, int K, int N, bf16* __restrict__ WT, LAS float* scr, int k0, int n0, int lane) {
    const int sc = REMAP ? win_srccol(n0 + (lane & 31)) : n0 + (lane & 31);
    float tv[32];
#pragma unroll
    for (int i = 0; i < 32; ++i) { const int kk = 2 * i + (lane >> 5); tv[i] = (sc >= 0) ? W[(size_t)(k0 + kk) * N + sc] : 0.f; }
#pragma unroll
    for (int i = 0; i < 32; ++i) { const int kk = 2 * i + (lane >> 5); scr[kk * 33 + (lane & 31)] = tv[i]; }
    LDS_WAIT();
    const int c = lane & 7;
#pragma unroll
    for (int j = 0; j < 4; ++j) { const int n = (lane >> 3) + 8 * j; const LAS float* s = scr + (8 * c) * 33 + n;
        u32x4 o; o.x = pk2(s[0 * 33], s[1 * 33]); o.y = pk2(s[2 * 33], s[3 * 33]); o.z = pk2(s[4 * 33], s[5 * 33]); o.w = pk2(s[6 * 33], s[7 * 33]);
        *(u32x4*)(WT + (size_t)(n0 + n) * K + k0 + 8 * c) = o; }
    LDS_WAIT();
}
__device__ __forceinline__ void p0_prologue(const Args& a, LAS unsigned char* lds, int tid) {
    const int lane = tid & 63, wave = tid >> 6;
    LAS float* scr = (LAS float*)(lds + wave * 8704);
    const int gw = blockIdx.x * 8 + wave, NGW = gridDim.x * 8;
    unsigned char* ws = a.ws;
    constexpr int I_WIN = 16 * 192, I_W1 = 32 * 8, I_WAB = 8 * 32, I_WSQ = 16 * 32, I_WPLE = 4 * 32;
    constexpr int NITEMS = I_WIN + 2 * I_W1 + 2 * I_WAB + 2 * I_WSQ + I_WPLE;
    for (int it = gw; it < NITEMS; it += NGW) {
        int r = it;
        if (r < I_WIN) { transpose_item<true>(a.in[2], 1024, 5920, (bf16*)(ws + WS_WIN), scr, (r / 192) * 64, (r % 192) * 32, lane); continue; } r -= I_WIN;
        if (r < I_W1) { transpose_item<false>(a.in[5], 2048, 256, (bf16*)(ws + WS_W1K), scr, (r / 8) * 64, (r % 8) * 32, lane); continue; } r -= I_W1;
        if (r < I_W1) { transpose_item<false>(a.in[7], 2048, 256, (bf16*)(ws + WS_W1V), scr, (r / 8) * 64, (r % 8) * 32, lane); continue; } r -= I_W1;
        if (r < I_WAB) { transpose_item<false>(a.in[14], 512, 1024, (bf16*)(ws + WS_WA), scr, (r / 32) * 64, (r % 32) * 32, lane); continue; } r -= I_WAB;
        if (r < I_WAB) { transpose_item<false>(a.in[15], 512, 1024, (bf16*)(ws + WS_WB), scr, (r / 32) * 64, (r % 32) * 32, lane); continue; } r -= I_WAB;
        if (r < I_WSQ) { transpose_item<false>(a.in[16], 1024, 1024, (bf16*)(ws + WS_WOUT), scr, (r / 32) * 64, (r % 32) * 32, lane); continue; } r -= I_WSQ;
        if (r < I_WSQ) { transpose_item<false>(a.in[18], 1024, 1024, (bf16*)(ws + WS_WPG), scr, (r / 32) * 64, (r % 32) * 32, lane); continue; } r -= I_WSQ;
        transpose_item<false>(a.in[17], 256, 1024, (bf16*)(ws + WS_WPLE), scr, (r / 32) * 64, (r % 32) * 32, lane);
    }
    const float* x = a.in[0]; bf16* xb = (bf16*)(ws + WS_XB);
    for (int m0 = gw * 4; m0 < T; m0 += NGW * 4) {
        f32x4 v[4][4];
#pragma unroll
        for (int q = 0; q < 4; ++q)
#pragma unroll
            for (int j = 0; j < 4; ++j) v[q][j] = ((const f32x4*)(x + (size_t)(m0 + q) * 1024) + lane)[64 * j];
#pragma unroll
        for (int q = 0; q < 4; ++q)
#pragma unroll
            for (int j = 0; j < 4; ++j) { u32x2 w; w.x = pk2(v[q][j].x, v[q][j].y); w.y = pk2(v[q][j].z, v[q][j].w); ((u32x2*)(xb + (size_t)(m0 + q) * 1024) + lane)[64 * j] = w; }
    }
    const float* p = a.in[1]; bf16* pb = (bf16*)(ws + WS_PB);
    for (int m0 = gw * 8; m0 < T; m0 += NGW * 8) {
        f32x4 v[8];
#pragma unroll
        for (int q = 0; q < 8; ++q) v[q] = ((const f32x4*)(p + (size_t)(m0 + q) * 256))[lane];
#pragma unroll
        for (int q = 0; q < 8; ++q) { u32x2 w; w.x = pk2(v[q].x, v[q].y); w.y = pk2(v[q].z, v[q].w); ((u32x2*)(pb + (size_t)(m0 + q) * 256))[lane] = w; }
    }
    { const float* rel_bias = a.in[9]; bf16* tbl = (bf16*)(ws + WS_TBL);
      for (int idx = blockIdx.x * 512 + tid; idx < 2 * NDI * 8 * 2 * 2 * 64 * 8; idx += gridDim.x * 512) {
          const int j = idx & 7, ln = (idx >> 3) & 63, half = (idx >> 9) & 1, sx = (idx >> 10) & 1, h = (idx >> 11) & 7, rest = idx >> 14, di = rest % NDI, type = rest / NDI;
          const int kj = 32 * half + (ln & 31), qi = 16 * sx + 8 * (ln >> 5) + j, dist = 32 * di + qi - kj;
          const float v = (dist < 0 || (type == 1 && dist >= 512)) ? -30000.f : rel_bias[rel_bucket(dist) * 8 + h] * 1.4426950408889634f;
          tbl[idx] = (bf16)f2bf(v); } }
    if (blockIdx.x == 0 && tid < 32) ((float*)(ws + WS_DBG))[tid] = 0.f;
    for (int o = blockIdx.x * 512 + tid; o < 2 * 256 * 8; o += gridDim.x * 512) {
        const int which = o >> 11, n = (o >> 3) & 255, part = o & 7; const float* pos = a.in[3 + which]; const float* w1 = a.in[which ? 7 : 5];
        float acc = 0.f;
        for (int e = part * 256; e < part * 256 + 256; ++e) acc = fmaf(pos[e], w1[(size_t)e * 256 + n], acc);
        acc += wshfl_xor(acc, 1, tid); acc += wshfl_xor(acc, 2, tid); acc += wshfl_xor(acc, 4, tid);
        if (part == 0) ((float*)(ws + WS_C1))[which * 256 + n] = acc;
    }
}

struct EpiProj {
    static constexpr bool PERM = true, AFTER_DRAIN = false;
    unsigned char* ws;
    __device__ __forceinline__ void operator()(const pg8::f32x4 (&acc)[2][2][4][2], const pg8::Unit& u, int wr, int wc, int fr, int fq) const {
        const int pn = u.pn; const int row0 = u.pm * 256 + wr * 64 + fr;
        if (pn == 23) {
            if (wc == 0) { float* sm = (float*)(ws + WS_SM);
#pragma unroll
                for (int ai = 0; ai < 2; ++ai)
#pragma unroll
                    for (int m = 0; m < 4; ++m) { float* o = sm + (size_t)(row0 + ai * 128 + m * 16) * 32 + 8 * fq; *(f32x4*)o = acc[ai][0][m][0]; *(f32x4*)(o + 4) = acc[ai][0][m][1]; } }
            return;
        }
        int kind, ldc, colt; size_t boff;
        if (pn < 2) { kind = 1; boff = WS_Q; ldc = 512; colt = pn * 256; }
        else if (pn < 5) { kind = 0; boff = WS_KV; ldc = 768; colt = (pn - 2) * 256; }
        else if (pn < 7) { kind = 2; boff = WS_ZA; ldc = 512; colt = (pn - 5) * 256; }
        else if (pn < 13) { kind = 0; boff = WS_QKVB; ldc = 1536; colt = (pn - 7) * 256; }
        else if (pn < 15) { kind = 2; boff = WS_ZB; ldc = 512; colt = (pn - 13) * 256; }
        else { kind = 3; boff = WS_GM; ldc = 2048; colt = (pn - 15) * 256; }
        bf16* base = (bf16*)(ws + boff); const int col0 = colt + wc * 32 + 8 * fq;
#pragma unroll
        for (int ai = 0; ai < 2; ++ai)
#pragma unroll
            for (int m = 0; m < 4; ++m) { bf16* rowp = base + (size_t)(row0 + ai * 128 + m * 16) * ldc + col0;
#pragma unroll
                for (int bj = 0; bj < 2; ++bj) { float v[8];
#pragma unroll
                    for (int e = 0; e < 4; ++e) { v[e] = acc[ai][bj][m][0][e]; v[4 + e] = acc[ai][bj][m][1][e]; }
                    if (kind == 1) {
#pragma unroll
                        for (int e = 0; e < 8; ++e) v[e] *= 0.18033688011112042f;
                    } else if (kind == 2) {
#pragma unroll
                        for (int e = 0; e < 8; ++e) v[e] = siluf_(v[e]);
                    } else if (kind == 3) {
#pragma unroll
                        for (int e = 0; e < 8; ++e) v[e] = sigm(v[e]);
                    }
                    u32x4 w; w.x = pk2(v[0], v[1]); w.y = pk2(v[2], v[3]); w.z = pk2(v[4], v[5]); w.w = pk2(v[6], v[7]);
                    *(u32x4*)(rowp + bj * 128) = w; } }
    }
};
struct EpiYA {
    static constexpr bool PERM = true, AFTER_DRAIN = false;
    const bf16* gm; bf16* part;
    __device__ __forceinline__ void operator()(const pg8::f32x4 (&acc)[2][2][4][2], const pg8::Unit& u, int wr, int wc, int fr, int fq) const {
        const int row0 = u.pm * 256 + wr * 64 + fr, col0 = u.pn * 256 + wc * 32 + 8 * fq;
#pragma unroll
        for (int ai = 0; ai < 2; ++ai)
#pragma unroll
            for (int m = 0; m < 4; ++m)
#pragma unroll
                for (int bj = 0; bj < 2; ++bj) { const size_t r = row0 + ai * 128 + m * 16; const int c = col0 + bj * 128;
                    const u32x4 g = *(const u32x4*)(gm + r * 2048 + c);
                    u32x4 w;
                    w.x = pk2(acc[ai][bj][m][0].x * bf2f(g.x & 0xffffu), acc[ai][bj][m][0].y * bf2f(g.x >> 16)); w.y = pk2(acc[ai][bj][m][0].z * bf2f(g.y & 0xffffu), acc[ai][bj][m][0].w * bf2f(g.y >> 16));
                    w.z = pk2(acc[ai][bj][m][1].x * bf2f(g.z & 0xffffu), acc[ai][bj][m][1].y * bf2f(g.z >> 16)); w.w = pk2(acc[ai][bj][m][1].z * bf2f(g.w & 0xffffu), acc[ai][bj][m][1].w * bf2f(g.w >> 16));
                    *(u32x4*)(part + r * 1024 + c) = w; }
    }
};
struct EpiYB {
    static constexpr bool PERM = true, AFTER_DRAIN = false;
    const bf16* gm; const bf16* part; bf16* mo;
    __device__ __forceinline__ void operator()(const pg8::f32x4 (&acc)[2][2][4][2], const pg8::Unit& u, int wr, int wc, int fr, int fq) const {
        const int row0 = u.pm * 256 + wr * 64 + fr, col0 = u.pn * 256 + wc * 32 + 8 * fq;
#pragma unroll
        for (int ai = 0; ai < 2; ++ai)
#pragma unroll
            for (int m = 0; m < 4; ++m)
#pragma unroll
                for (int bj = 0; bj < 2; ++bj) { const size_t r = row0 + ai * 128 + m * 16; const int c = col0 + bj * 128;
                    const u32x4 g = *(const u32x4*)(gm + r * 2048 + 1024 + c); const u32x4 pp = *(const u32x4*)(part + r * 1024 + c);
                    u32x4 w;
                    w.x = pk2(bf2f(pp.x & 0xffffu) + acc[ai][bj][m][0].x * bf2f(g.x & 0xffffu), bf2f(pp.x >> 16) + acc[ai][bj][m][0].y * bf2f(g.x >> 16));
                    w.y = pk2(bf2f(pp.y & 0xffffu) + acc[ai][bj][m][0].z * bf2f(g.y & 0xffffu), bf2f(pp.y >> 16) + acc[ai][bj][m][0].w * bf2f(g.y >> 16));
                    w.z = pk2(bf2f(pp.z & 0xffffu) + acc[ai][bj][m][1].x * bf2f(g.z & 0xffffu), bf2f(pp.z >> 16) + acc[ai][bj][m][1].y * bf2f(g.z >> 16));
                    w.w = pk2(bf2f(pp.w & 0xffffu) + acc[ai][bj][m][1].z * bf2f(g.w & 0xffffu), bf2f(pp.w >> 16) + acc[ai][bj][m][1].w * bf2f(g.w >> 16));
                    *(u32x4*)(mo + r * 1024 + c) = w; }
    }
};
struct EpiH {
    static constexpr bool PERM = true, AFTER_DRAIN = false;
    const float* x; float* h; bf16* hb;
    __device__ __forceinline__ void operator()(const pg8::f32x4 (&acc)[2][2][4][2], const pg8::Unit& u, int wr, int wc, int fr, int fq) const {
        const int row0 = u.pm * 256 + wr * 64 + fr, col0 = u.pn * 256 + wc * 32 + 8 * fq;
#pragma unroll
        for (int ai = 0; ai < 2; ++ai)
#pragma unroll
            for (int m = 0; m < 4; ++m)
#pragma unroll
                for (int bj = 0; bj < 2; ++bj) { const size_t off = (size_t)(row0 + ai * 128 + m * 16) * 1024 + col0 + bj * 128;
                    const f32x4 x0 = *(const f32x4*)(x + off), x1 = *(const f32x4*)(x + off + 4);
                    const f32x4 o0 = x0 * ALPHA + acc[ai][bj][m][0], o1 = x1 * ALPHA + acc[ai][bj][m][1];
                    *(f32x4*)(h + off) = o0; *(f32x4*)(h + off + 4) = o1;
                    u32x4 w; w.x = pk2(o0.x, o0.y); w.y = pk2(o0.z, o0.w); w.z = pk2(o1.x, o1.y); w.w = pk2(o1.z, o1.w);
                    *(u32x4*)(hb + off) = w; }
    }
};
struct EpiPE {
    static constexpr bool PERM = true, AFTER_DRAIN = false;
    bf16* pe;
    __device__ __forceinline__ void operator()(const pg8::f32x4 (&acc)[2][2][4][2], const pg8::Unit& u, int wr, int wc, int fr, int fq) const {
        const int row0 = u.pm * 256 + wr * 64 + fr, col0 = u.pn * 256 + wc * 32 + 8 * fq;
#pragma unroll
        for (int ai = 0; ai < 2; ++ai)
#pragma unroll
            for (int m = 0; m < 4; ++m)
#pragma unroll
                for (int bj = 0; bj < 2; ++bj) { const size_t off = (size_t)(row0 + ai * 128 + m * 16) * 1024 + col0 + bj * 128;
                    u32x4 w; w.x = pk2(acc[ai][bj][m][0].x, acc[ai][bj][m][0].y); w.y = pk2(acc[ai][bj][m][0].z, acc[ai][bj][m][0].w); w.z = pk2(acc[ai][bj][m][1].x, acc[ai][bj][m][1].y); w.w = pk2(acc[ai][bj][m][1].z, acc[ai][bj][m][1].w);
                    *(u32x4*)(pe + off) = w; }
    }
};
struct EpiGate {
    static constexpr bool PERM = true, AFTER_DRAIN = false;
    const float* h; const bf16* pe; float* out;
    __device__ __forceinline__ void operator()(const pg8::f32x4 (&acc)[2][2][4][2], const pg8::Unit& u, int wr, int wc, int fr, int fq) const {
        const int row0 = u.pm * 256 + wr * 64 + fr, col0 = u.pn * 256 + wc * 32 + 8 * fq;
#pragma unroll
        for (int ai = 0; ai < 2; ++ai)
#pragma unroll
            for (int m = 0; m < 4; ++m)
#pragma unroll
                for (int bj = 0; bj < 2; ++bj) { const size_t off = (size_t)(row0 + ai * 128 + m * 16) * 1024 + col0 + bj * 128;
                    const f32x4 h0 = *(const f32x4*)(h + off), h1 = *(const f32x4*)(h + off + 4); const u32x4 pv = *(const u32x4*)(pe + off);
                    f32x4 o0, o1;
                    o0.x = h0.x + sigm(acc[ai][bj][m][0].x) * bf2f(pv.x & 0xffffu); o0.y = h0.y + sigm(acc[ai][bj][m][0].y) * bf2f(pv.x >> 16); o0.z = h0.z + sigm(acc[ai][bj][m][0].z) * bf2f(pv.y & 0xffffu); o0.w = h0.w + sigm(acc[ai][bj][m][0].w) * bf2f(pv.y >> 16);
                    o1.x = h1.x + sigm(acc[ai][bj][m][1].x) * bf2f(pv.z & 0xffffu); o1.y = h1.y + sigm(acc[ai][bj][m][1].y) * bf2f(pv.z >> 16); o1.z = h1.z + sigm(acc[ai][bj][m][1].z) * bf2f(pv.w & 0xffffu); o1.w = h1.w + sigm(acc[ai][bj][m][1].w) * bf2f(pv.w >> 16);
                    *(f32x4*)(out + off) = o0; *(f32x4*)(out + off + 4) = o1; }
    }
};

template <class LA, class LB, class ST>
__device__ __forceinline__ void sgemm_tile64(LAS float* As, LAS float* Bs, int K, int tid, LA loadA4, LB loadB4, ST store4) {
    const int tx = tid & 15, ty = (tid >> 4) & 15;
    float acc[4][4];
#pragma unroll
    for (int i = 0; i < 4; ++i)
#pragma unroll
        for (int j = 0; j < 4; ++j) acc[i][j] = 0.f;
    const int arow = (tid >> 2) & 63, akq = (tid & 3) * 4, bk = (tid >> 4) & 15, bnq = (tid & 15) * 4;
    for (int k0 = 0; k0 < K; k0 += 16) {
        if (tid < 256) {
            const f32x4 av = loadA4(arow, k0 + akq), bv = loadB4(k0 + bk, bnq);
            As[(akq + 0) * 68 + arow] = av.x; As[(akq + 1) * 68 + arow] = av.y; As[(akq + 2) * 68 + arow] = av.z; As[(akq + 3) * 68 + arow] = av.w;
            *(LAS f32x4*)&Bs[bk * 68 + bnq] = bv;
        }
        __syncthreads();
        if (tid < 256) {
#pragma unroll
            for (int k = 0; k < 16; ++k) {
                const f32x4 av = *(const LAS f32x4*)&As[k * 68 + ty * 4], bv = *(const LAS f32x4*)&Bs[k * 68 + tx * 4];
#pragma unroll
                for (int i = 0; i < 4; ++i)
#pragma unroll
                    for (int j = 0; j < 4; ++j) acc[i][j] = fmaf(av[i], bv[j], acc[i][j]);
            }
        }
        __syncthreads();
    }
    if (tid < 256) {
#pragma unroll
        for (int i = 0; i < 4; ++i) store4(ty * 4 + i, tx * 4, (f32x4){acc[i][0], acc[i][1], acc[i][2], acc[i][3]});
    }
}

__device__ __forceinline__ void dn_prep_phase(const Args& a, LAS unsigned char* lds, int tid) {
    unsigned char* ws = a.ws;
    const bf16* qkvb = (const bf16*)(ws + WS_QKVB); const float* sm = (const float*)(ws + WS_SM);
    const float* conv_w = a.in[10]; const float* a_log = a.in[11]; const float* dt_bias = a.in[12];
    bf16* qn = (bf16*)a.out; bf16* kn = qn + (size_t)T * 512; bf16* vv = kn + (size_t)T * 512;
    float* gg = (float*)(ws + WS_GG); float* bb = (float*)(ws + WS_BB);
    LAS float* red = (LAS float*)lds;
    const int h = tid >> 7, d = tid & 127, wave = tid >> 6;
    float cw[3][4];
#pragma unroll
    for (int part = 0; part < 3; ++part)
#pragma unroll
        for (int w = 0; w < 4; ++w) cw[part][w] = conv_w[w * 1536 + part * 512 + h * 128 + d];
    for (int t = blockIdx.x; t < T; t += gridDim.x) {
        const int ts = t & (SEQ - 1);
        float val[3];
#pragma unroll
        for (int part = 0; part < 3; ++part) { const int c = part * 512 + h * 128 + d; float acc = 0.f;
#pragma unroll
            for (int w = 0; w < 4; ++w) if (ts + w - 3 >= 0) acc = fmaf(cw[part][w], bf2f(qkvb[(size_t)(t + w - 3) * 1536 + c]), acc);
            val[part] = siluf_(acc); }
        float sq = val[0] * val[0], sk = val[1] * val[1];
#pragma unroll
        for (int o = 32; o > 0; o >>= 1) { sq += wshfl_xor(sq, o, tid); sk += wshfl_xor(sk, o, tid); }
        if ((tid & 63) == 0) { red[wave * 2] = sq; red[wave * 2 + 1] = sk; }
        __syncthreads();
        sq = red[(h * 2) * 2] + red[(h * 2 + 1) * 2]; sk = red[(h * 2) * 2 + 1] + red[(h * 2 + 1) * 2 + 1];
        const size_t o = (size_t)t * 512 + h * 128 + d;
        qn[o] = (bf16)f2bf(val[0] * (1.0f / sqrtf(sq + 1e-6f)));
        kn[o] = (bf16)f2bf(val[1] * (1.0f / sqrtf(sk + 1e-6f)));
        vv[o] = (bf16)f2bf(val[2]);
        if (d == 0) {
            bb[t * 4 + h] = 1.f / (1.f + expf(-sm[(size_t)t * 32 + 24 + h]));
            const float xx = sm[(size_t)t * 32 + 28 + h] + dt_bias[h];
            const float sp = (xx > 20.f) ? xx : log1pf(expf(xx));
            gg[t * 4 + h] = -expf(a_log[h]) * sp;
        }
        __syncthreads();
    }
}

__device__ __forceinline__ void cmp_gemm1_phase(const Args& a, LAS unsigned char* lds, int tid) {
    unsigned char* ws = a.ws; const bf16* kv = (const bf16*)(ws + WS_KV); bf16* hid = (bf16*)(ws + WS_HID);
    LAS float* As = (LAS float*)lds; LAS float* Bs = As + 16 * 68;
    for (int u = blockIdx.x; u < 256; u += gridDim.x) {
        const int which = u >> 7, mt = (u >> 2) & 31, nt = u & 3;
        const float* pos = a.in[3 + which]; const float* w1 = a.in[which ? 7 : 5];
        const int col0 = which * 128;
        auto la = [&](int r, int k) -> f32x4 {
            const int row = mt * 64 + r, g = row & 1, bn = row >> 1, b = bn >> 7, n = bn & 127, j = k >> 6, d = k & 63;
            const u32x2 w = *(const u32x2*)(kv + (size_t)(b * SEQ + 16 * n + j) * 768 + col0 + g * 64 + d);
            const f32x4 pv = *(const f32x4*)(pos + j * 64 + d);
            return (f32x4){bf2f(w.x & 0xffffu) + pv.x, bf2f(w.x >> 16) + pv.y, bf2f(w.y & 0xffffu) + pv.z, bf2f(w.y >> 16) + pv.w};
        };
        auto lb = [&](int k, int c) -> f32x4 { return *(const f32x4*)(w1 + (size_t)k * 256 + nt * 64 + c); };
        auto st = [&](int r, int c, f32x4 v) {
            float o[4];
#pragma unroll
            for (int e = 0; e < 4; ++e) { const float x = v[e]; o[e] = 0.5f * x * (1.f + tanhf(0.7978845608028654f * (x + 0.044715f * x * x * x))); }
            u32x2 w; w.x = pk2(o[0], o[1]); w.y = pk2(o[2], o[3]);
            *(u32x2*)(hid + ((size_t)which * 2048 + mt * 64 + r) * 256 + nt * 64 + c) = w;
        };
        sgemm_tile64(As, Bs, 2048, tid, la, lb, st);
    }
}
constexpr int CG_RS = 272;
__device__ __forceinline__ void cmp_gemm1_mfma_phase(const Args& a, LAS unsigned char* lds, int tid) {
    unsigned char* ws = a.ws; const bf16* kv = (const bf16*)(ws + WS_KV); bf16* hid = (bf16*)(ws + WS_HID);
    const int lane = tid & 63, w = __builtin_amdgcn_readfirstlane(tid >> 6), r32 = lane & 31, hk = lane >> 5;
    const int wm = w & 1, wn = (w >> 1) & 1, wk = w >> 2;
    for (int u = blockIdx.x; u < 256; u += gridDim.x) {
        const int which = u >> 7, mt = (u >> 2) & 31, nt = u & 3;
        const bf16* w1t = (const bf16*)(ws + (which ? WS_W1V : WS_W1K));
        const unsigned char* asrc[2]; const unsigned char* bsrc[2]; int dsto[2];
#pragma unroll
        for (int i = 0; i < 2; ++i) { const int p = tid + 512 * i, row = p >> 4, ch = p & 15;
            const int r = mt * 64 + row, g = r & 1, bn = r >> 1, b = bn >> 7, nb = bn & 127;
            asrc[i] = (const unsigned char*)(kv + (size_t)(b * SEQ + 16 * nb + (ch >> 3)) * 768 + which * 128 + g * 64 + (ch & 7) * 8);
            bsrc[i] = (const unsigned char*)(w1t + (size_t)(nt * 64 + row) * 2048 + ch * 8);
            dsto[i] = row * CG_RS + ch * 16; }
        u32x4 ar[2], br[2];
#pragma unroll
        for (int i = 0; i < 2; ++i) { ar[i] = *(const u32x4*)(asrc[i]); br[i] = *(const u32x4*)(bsrc[i]); }
#pragma unroll
        for (int i = 0; i < 2; ++i) { *(LAS u32x4*)(lds + dsto[i]) = ar[i]; *(LAS u32x4*)(lds + 2 * 64 * CG_RS + dsto[i]) = br[i]; }
        __syncthreads();
        f32x16 acc;
#pragma unroll
        for (int r = 0; r < 16; ++r) acc[r] = 0.f;
        for (int t = 0; t < 16; ++t) {
            const int cur = t & 1;
            if (t < 15) {
#pragma unroll
                for (int i = 0; i < 2; ++i) { ar[i] = *(const u32x4*)(asrc[i] + (size_t)(t + 1) * 3072); br[i] = *(const u32x4*)(bsrc[i] + (size_t)(t + 1) * 256); } }
            const LAS unsigned char* ab = lds + cur * 64 * CG_RS + (wm * 32 + r32) * CG_RS + (wk * 64 + hk * 8) * 2;
            const LAS unsigned char* bb = lds + (2 + cur) * 64 * CG_RS + (wn * 32 + r32) * CG_RS + (wk * 64 + hk * 8) * 2;
#pragma unroll
            for (int ks = 0; ks < 4; ++ks) acc = __builtin_amdgcn_mfma_f32_32x32x16_bf16(*(const LAS bf16x8*)(ab + ks * 32), *(const LAS bf16x8*)(bb + ks * 32), acc, 0, 0, 0);
            if (t < 15) {
#pragma unroll
                for (int i = 0; i < 2; ++i) { *(LAS u32x4*)(lds + (cur ^ 1) * 64 * CG_RS + dsto[i]) = ar[i]; *(LAS u32x4*)(lds + (2 + (cur ^ 1)) * 64 * CG_RS + dsto[i]) = br[i]; } }
            __syncthreads();
        }
        LAS float* red = (LAS float*)lds + (wm * 2 + wn) * 1024;
        if (wk == 1) {
#pragma unroll
            for (int r = 0; r < 16; ++r) red[r * 64 + lane] = acc[r]; }
        __syncthreads();
        if (wk == 0) {
            const int n = nt * 64 + wn * 32 + r32; const float c1 = ((const float*)(ws + WS_C1))[which * 256 + n];
#pragma unroll
            for (int r = 0; r < 16; ++r) { const float x = acc[r] + red[r * 64 + lane] + c1;
                const float y = 0.5f * x * (1.f + tanhf(0.7978845608028654f * (x + 0.044715f * x * x * x)));
                hid[((size_t)which * 2048 + mt * 64 + wm * 32 + crow(r, hk)) * 256 + n] = (bf16)f2bf(y); }
        }
        __syncthreads();
    }
}
__device__ __forceinline__ void cmp_gemm2_phase(const Args& a, LAS unsigned char* lds, int tid) {
    unsigned char* ws = a.ws; const bf16* hid = (const bf16*)(ws + WS_HID);
    LAS float* As = (LAS float*)lds; LAS float* Bs = As + 16 * 68;
    for (int u = blockIdx.x; u < 64; u += gridDim.x) {
        const int which = u >> 5, mt = u & 31;
        const float* w2 = a.in[which ? 8 : 6]; float* outp = (float*)(ws + (which ? WS_VC : WS_KC));
        auto la = [&](int r, int k) -> f32x4 { const u32x2 w = *(const u32x2*)(hid + ((size_t)which * 2048 + mt * 64 + r) * 256 + k);
            return (f32x4){bf2f(w.x & 0xffffu), bf2f(w.x >> 16), bf2f(w.y & 0xffffu), bf2f(w.y >> 16)}; };
        auto lb = [&](int k, int c) -> f32x4 { return *(const f32x4*)(w2 + (size_t)k * 64 + c); };
        bf16* outb = (bf16*)(ws + (which ? WS_VCB : WS_KCB));
        auto st = [&](int r, int c, f32x4 v) { *(f32x4*)(outp + (size_t)(mt * 64 + r) * 64 + c) = v;
            const int row = mt * 64 + r, gg_ = row & 1, bn = row >> 1, bb_ = bn >> 7, n = bn & 127;
            u32x2 wv; wv.x = (n == 127) ? 0u : pk2(v.x, v.y); wv.y = (n == 127) ? 0u : pk2(v.z, v.w);
            *(u32x2*)(outb + ((size_t)((bb_ * 2 + gg_) * 128 + n)) * 64 + c) = wv; };
        sgemm_tile64(As, Bs, 256, tid, la, lb, st);
    }
}

template <int MODE>
__device__ __forceinline__ void attn_simple_phase(const Args& a, LAS unsigned char* lds, int tid) {
    constexpr int NK = (MODE == 0) ? 127 : 512;
    unsigned char* ws = a.ws;
    const bf16* Q = (const bf16*)(ws + WS_Q); const bf16* KV = (const bf16*)(ws + WS_KV); const float* sm = (const float*)(ws + WS_SM);
    const float* kc = (const float*)(ws + WS_KC); const float* vc = (const float*)(ws + WS_VC);
    const float* rel_bias = a.in[9];
    float* oacc = (float*)(ws + WS_OACC); u32* sel = (u32*)(ws + WS_SEL);
    const bf16* za = (const bf16*)(ws + WS_ZA); bf16* oa = (bf16*)(ws + WS_OA);
    const int sb = tid >> 8, stid = tid & 255;
    LAS float* qs = (LAS float*)(lds + sb * 12288);
    LAS float* sc = qs + 256;
    LAS int* blk = (LAS int*)(sc + 2048);
    LAS float* imp = (LAS float*)(blk + 8);
    const int NU = T * 2, G2 = gridDim.x * 2;
    for (int u0 = 0; u0 < NU; u0 += G2) {
        const int u = u0 + blockIdx.x * 2 + sb; const bool act = u < NU;
        const int t = act ? (u >> 1) : 0, g = u & 1, ts = t & (SEQ - 1), tb = t - ts;
        qs[stid] = bf2f(Q[(size_t)t * 512 + (g * 4 + (stid >> 6)) * 64 + (stid & 63)]);
        if (MODE == 1 && stid == 0) { u32 mk = sel[t * 2 + g]; int k = 0; for (int j = 0; j < 32; ++j) if ((mk >> j) & 1u) { if (k < 8) blk[k] = j; ++k; } for (; k < 8; ++k) blk[k] = 0; }
        __syncthreads();
        for (int i = stid; i < NK; i += 256) {
            int dist, kpos; bool valid; const bf16* kb = nullptr; const float* kf = nullptr;
            if (MODE == 0) { dist = ts - (16 * i + 31); valid = dist >= 0; kf = kc + (size_t)((((tb >> 11) * 128) + i) * 2 + g) * 64; }
            else if (MODE == 1) { kpos = blk[i >> 6] * 64 + (i & 63); dist = ts - kpos; valid = dist >= 0; kb = KV + (size_t)(tb + kpos) * 768 + 256 + g * 64; }
            else { kpos = ts - 511 + i; dist = 511 - i; valid = kpos >= 0; kb = KV + (size_t)(tb + (kpos < 0 ? 0 : kpos)) * 768 + 512 + g * 64; }
            float s0 = 0.f, s1 = 0.f, s2 = 0.f, s3 = 0.f;
            if (valid) {
#pragma unroll 2
                for (int d = 0; d < 64; d += 8) {
                    float kk[8];
                    if (MODE == 0) { const f32x4 k0 = *(const f32x4*)(kf + d), k1 = *(const f32x4*)(kf + d + 4); kk[0] = k0.x; kk[1] = k0.y; kk[2] = k0.z; kk[3] = k0.w; kk[4] = k1.x; kk[5] = k1.y; kk[6] = k1.z; kk[7] = k1.w; }
                    else { const u32x4 w = *(const u32x4*)(kb + d); kk[0] = bf2f(w.x & 0xffffu); kk[1] = bf2f(w.x >> 16); kk[2] = bf2f(w.y & 0xffffu); kk[3] = bf2f(w.y >> 16); kk[4] = bf2f(w.z & 0xffffu); kk[5] = bf2f(w.z >> 16); kk[6] = bf2f(w.w & 0xffffu); kk[7] = bf2f(w.w >> 16); }
#pragma unroll
                    for (int e = 0; e < 8; ++e) { s0 = fmaf(kk[e], qs[d + e], s0); s1 = fmaf(kk[e], qs[64 + d + e], s1); s2 = fmaf(kk[e], qs[128 + d + e], s2); s3 = fmaf(kk[e], qs[192 + d + e], s3); }
                }
                const float* rb = rel_bias + rel_bucket(dist) * 8 + g * 4;
                s0 += rb[0] * 1.4426950408889634f; s1 += rb[1] * 1.4426950408889634f; s2 += rb[2] * 1.4426950408889634f; s3 += rb[3] * 1.4426950408889634f;
            } else { s0 = s1 = s2 = s3 = -1e30f; }
            sc[i] = s0; sc[512 + i] = s1; sc[1024 + i] = s2; sc[1536 + i] = s3;
        }
        __syncthreads();
        {
            const int w = stid >> 6, lane = stid & 63; LAS float* row = sc + w * 512;
            float mx = -1e30f;
            for (int i = lane; i < NK; i += 64) mx = fmaxf(mx, row[i]);
#pragma unroll
            for (int o = 32; o > 0; o >>= 1) mx = fmaxf(mx, wshfl_xor(mx, o, tid));
            float sum = 0.f;
            for (int i = lane; i < NK; i += 64) { const float s = row[i]; const float e = (s > -1e29f) ? exp2f(s - mx) : 0.f; row[i] = e; sum += e; }
#pragma unroll
            for (int o = 32; o > 0; o >>= 1) sum += wshfl_xor(sum, o, tid);
            const float inv = (sum > 0.f) ? 1.f / sum : 0.f;
            for (int i = lane; i < NK; i += 64) row[i] *= inv;
        }
        __syncthreads();
        {
            const int hg = stid >> 6, d = stid & 63; const LAS float* row = sc + hg * 512;
            float acc = 0.f;
            for (int i = 0; i < NK; ++i) {
                const float p = row[i];
                if (p != 0.f) {
                    float v;
                    if (MODE == 0) v = vc[(size_t)((((tb >> 11) * 128) + i) * 2 + g) * 64 + d];
                    else if (MODE == 1) v = bf2f(KV[(size_t)(tb + blk[i >> 6] * 64 + (i & 63)) * 768 + 384 + g * 64 + d]);
                    else v = bf2f(KV[(size_t)(tb + ts - 511 + i) * 768 + 640 + g * 64 + d]);
                    acc = fmaf(p, v, acc);
                }
            }
            if (act) {
                const int h = g * 4 + hg; const size_t o = (size_t)t * 512 + h * 64 + d;
                const float gate = 1.f / (1.f + expf(-sm[(size_t)t * 32 + (MODE == 0 ? 0 : MODE == 1 ? 8 : 16) + h]));
                if (MODE == 2) oacc[o] = gate * acc;
                else if (MODE == 0) oacc[o] += gate * acc;
                else oa[o] = (bf16)f2bf((oacc[o] + gate * acc) * bf2f(za[o]));
            }
        }
        if (MODE == 0) {
            if (stid < 32) {
                const int j = stid; float s = 0.f;
                for (int n = 4 * j - 1; n <= 4 * j + 3; ++n) if (n >= 0 && n < 127) s += (sc[n] + sc[512 + n]) + (sc[1024 + n] + sc[1536 + n]);
                const int cur = ts >> 6;
                if (j == 0 || j == cur || j == cur - 1) s = 1e6f; else if (j > cur) s = -1e6f;
                imp[j] = s;
            }
            __syncthreads();
            if (stid == 0 && act) {
                u32 taken = 0u;
                for (int k = 0; k < 8; ++k) { int best = -1; float bv = 0.f;
                    for (int j = 0; j < 32; ++j) if (!((taken >> j) & 1u)) { const float x = imp[j]; if (best < 0 || x > bv) { best = j; bv = x; } }
                    taken |= 1u << best; }
                sel[t * 2 + g] = taken;
            }
        }
        __syncthreads();
    }
}

__device__ __forceinline__ unsigned cvtpk(float lo, float hi) { typedef float f2 __attribute__((ext_vector_type(2))); typedef __bf16 b2 __attribute__((ext_vector_type(2))); f2 v = {lo, hi}; b2 b = __builtin_convertvector(v, b2); return __builtin_bit_cast(unsigned, b); }
__device__ __forceinline__ float max3f(float a, float b, float c) { float r; asm("v_max3_f32 %0, %1, %2, %3" : "=v"(r) : "v"(a), "v"(b), "v"(c)); return r; }
__device__ __forceinline__ float max2f(float a, float b) { float r; asm("v_max_f32_e32 %0, %1, %2" : "=v"(r) : "v"(a), "v"(b)); return r; }
__device__ __forceinline__ float hswap_max(float v) { auto rr = __builtin_amdgcn_permlane32_swap(__float_as_uint(v), __float_as_uint(v), false, false); return max2f(__uint_as_float(rr[0]), __uint_as_float(rr[1])); }
__device__ __forceinline__ float hswap_sum(float v) { auto rr = __builtin_amdgcn_permlane32_swap(__float_as_uint(v), __float_as_uint(v), false, false); return __uint_as_float(rr[0]) + __uint_as_float(rr[1]); }
template <int MODE, bool PROBE>
__device__ __forceinline__ void attn_mfma_unit(const Args& a, LAS unsigned char* lds, int tid, int b, int g, int qt) {
    typedef short v4i16_t __attribute__((ext_vector_type(4)));
    unsigned char* ws = a.ws;
    const int lane = tid & 63, w = __builtin_amdgcn_readfirstlane(tid >> 6), r32 = lane & 31, hi = lane >> 5;
    const int hg = w >> 1, tsub = w & 1, h = g * 4 + hg;
    const int tb = b * SEQ, t0 = qt * 64, tq = t0 + tsub * 32 + r32;
    const bf16* Q = (const bf16*)(ws + WS_Q); const bf16* KV = (const bf16*)(ws + WS_KV);
    const int kcol = (MODE == 1 ? 256 : 512) + g * 64, vcol = kcol + 128;
    bf16x8 qr[4];
#pragma unroll
    for (int d0 = 0; d0 < 4; ++d0) qr[d0] = *(const bf16x8*)(Q + (size_t)(tb + tq) * 512 + h * 64 + d0 * 16 + hi * 8);
    bf16x8 oh[2];
#pragma unroll
    for (int sx = 0; sx < 2; ++sx)
#pragma unroll
        for (int j = 0; j < 8; ++j) oh[sx][j] = (16 * sx + 8 * hi + j == r32) ? (short)0x3F80 : (short)0;
    const int j0 = (MODE == 2) ? (qt > 8 ? qt - 8 : 0) : 0, j1 = qt;
    const bf16* ksrc = KV + (size_t)(tb + lane) * 768 + kcol + w * 8;
    const bf16* vsrc = KV + (size_t)(tb + 16 * (w & 3) + (lane >> 2)) * 768 + vcol + (w >> 2) * 32 + (lane & 3) * 8;
    LAS unsigned char* Kb = lds; LAS unsigned char* Vb = lds + 16384; LAS float* wsf = (LAS float*)(lds + 32768) + w * 64;
    const unsigned char* tblb = ws + WS_TBL + (size_t)((MODE == 2 ? NDI : 0) * 8 + h) * 4096 + lane * 16;
    u32 mk = 0xffffffffu; if (MODE == 1) mk = ((const u32*)(ws + WS_SEL))[(tb + tq) * 2 + g];
    u32x4 kreg = *(const u32x4*)(ksrc + (size_t)j0 * 64 * 768), vreg = *(const u32x4*)(vsrc + (size_t)j0 * 64 * 768);
    *(LAS u32x4*)(Kb + w * 1024 + lane * 16) = kreg; *(LAS u32x4*)(Vb + w * 1024 + lane * 16) = vreg;
    __syncthreads();
    float m = -1e30f, l = 0.f; f32x16 o[2];
#pragma unroll
    for (int r = 0; r < 16; ++r) { o[0][r] = 0.f; o[1][r] = 0.f; }
    const LAS unsigned char* vrd0 = Vb + ((lane >> 4) & 1) * 32 + (lane & 3) * 8 + (4 * hi + ((lane & 15) >> 2)) * 64;
    for (int jt = j0; jt <= j1; ++jt) {
        const int cur = (jt - j0) & 1;
        if (jt < j1) { kreg = *(const u32x4*)(ksrc + (size_t)(jt + 1) * 64 * 768); vreg = *(const u32x4*)(vsrc + (size_t)(jt + 1) * 64 * 768); }
        int di = 2 * (qt - jt) + tsub; if (di > NDI - 1) di = NDI - 1;
        const unsigned char* tp = tblb + (size_t)di * 32768;
        const bf16x8 tf00 = *(const bf16x8*)(tp), tf01 = *(const bf16x8*)(tp + 1024), tf10 = *(const bf16x8*)(tp + 2048), tf11 = *(const bf16x8*)(tp + 3072);
        const float cinit = (MODE == 1 && !((mk >> jt) & 1u)) ? -30000.f : 0.f;
        f32x16 p0, p1;
#pragma unroll
        for (int r = 0; r < 16; ++r) p0[r] = cinit;
        p1 = __builtin_amdgcn_mfma_f32_32x32x16_bf16(tf01, oh[0], p0, 0, 0, 0);
        p0 = __builtin_amdgcn_mfma_f32_32x32x16_bf16(tf00, oh[0], p0, 0, 0, 0);
        p0 = __builtin_amdgcn_mfma_f32_32x32x16_bf16(tf10, oh[1], p0, 0, 0, 0);
        p1 = __builtin_amdgcn_mfma_f32_32x32x16_bf16(tf11, oh[1], p1, 0, 0, 0);
        const LAS unsigned char* kb = Kb + cur * 8192 + hi * 1024 + r32 * 16;
#pragma unroll
        for (int d0 = 0; d0 < 4; ++d0) {
            const bf16x8 k0 = *(const LAS bf16x8*)(kb + d0 * 2048), k1 = *(const LAS bf16x8*)(kb + d0 * 2048 + 512);
            p0 = __builtin_amdgcn_mfma_f32_32x32x16_bf16(k0, qr[d0], p0, 0, 0, 0);
            p1 = __builtin_amdgcn_mfma_f32_32x32x16_bf16(k1, qr[d0], p1, 0, 0, 0);
        }
        float rm = fmaxf(p0[0], p1[0]);
#pragma unroll
        for (int r = 1; r < 16; ++r) rm = fmaxf(rm, fmaxf(p0[r], p1[r]));
        rm = hswap_max(rm);
        const float mn = fmaxf(m, rm);
        if (__any(mn > m)) {
            const float sc = __builtin_amdgcn_exp2f(m - mn); l *= sc; m = mn;
            if (hi == 0) wsf[r32] = sc;
            LDS_WAIT();
#pragma unroll
            for (int r = 0; r < 16; ++r) { const float f = wsf[crow(r, hi)]; o[0][r] *= f; o[1][r] *= f; }
            LDS_WAIT();
        }
        float sacc = 0.f;
#pragma unroll
        for (int r = 0; r < 16; ++r) { p0[r] = __builtin_amdgcn_exp2f(p0[r] - m); p1[r] = __builtin_amdgcn_exp2f(p1[r] - m); sacc += p0[r] + p1[r]; }
        l += sacc;
        u32x4 pw[4];
#pragma unroll
        for (int e = 0; e < 4; ++e) { pw[0][e] = cvtpk(p0[2 * e], p0[2 * e + 1]); pw[1][e] = cvtpk(p0[8 + 2 * e], p0[8 + 2 * e + 1]); pw[2][e] = cvtpk(p1[2 * e], p1[2 * e + 1]); pw[3][e] = cvtpk(p1[8 + 2 * e], p1[8 + 2 * e + 1]); }
        const LAS unsigned char* vrd = vrd0 + cur * 8192;
#pragma unroll
        for (int d0 = 0; d0 < 2; ++d0)
#pragma unroll
            for (int ks = 0; ks < 4; ++ks) {
                const s16x4 lo = __builtin_bit_cast(s16x4, __builtin_amdgcn_ds_read_tr16_b64_v4i16((LAS v4i16_t*)(vrd + d0 * 4096 + ks * 1024)));
                const s16x4 hh = __builtin_bit_cast(s16x4, __builtin_amdgcn_ds_read_tr16_b64_v4i16((LAS v4i16_t*)(vrd + d0 * 4096 + ks * 1024 + 512)));
                const bf16x8 vf = (bf16x8){lo[0], lo[1], lo[2], lo[3], hh[0], hh[1], hh[2], hh[3]};
                o[d0] = __builtin_amdgcn_mfma_f32_32x32x16_bf16(__builtin_bit_cast(bf16x8, pw[ks]), vf, o[d0], 0, 0, 0);
            }
        if (jt < j1) { *(LAS u32x4*)(Kb + (cur ^ 1) * 8192 + w * 1024 + lane * 16) = kreg; *(LAS u32x4*)(Vb + (cur ^ 1) * 8192 + w * 1024 + lane * 16) = vreg; }
        __syncthreads();
    }
    l = hswap_sum(l);
    if (hi == 0) wsf[32 + r32] = l;
    LDS_WAIT();
    const float* sm = (const float*)(ws + WS_SM); float* oacc = (float*)(ws + WS_OACC);
    const bf16* za = (const bf16*)(ws + WS_ZA); bf16* oa = (bf16*)(ws + WS_OA);
    float dmax = 0.f;
#pragma unroll
    for (int r = 0; r < 16; ++r) {
        const int qi = crow(r, hi); const size_t row = (size_t)(tb + t0 + tsub * 32 + qi);
        const float rl = __builtin_amdgcn_rcpf(wsf[32 + qi]);
        const float gate = sigm(sm[row * 32 + (MODE == 1 ? 8 : 16) + h]);
#pragma unroll
        for (int d0 = 0; d0 < 2; ++d0) { const size_t oo = row * 512 + h * 64 + d0 * 32 + r32; const float val = gate * o[d0][r] * rl;
            if (PROBE) dmax = fmaxf(dmax, (MODE == 2) ? fabsf(val - oacc[oo]) : fabsf((oacc[oo] + val) * bf2f(za[oo]) - bf2f(oa[oo])));
            else if (MODE == 2) oacc[oo] = val;
            else oa[oo] = (bf16)f2bf((oacc[oo] + val) * bf2f(za[oo])); }
    }
    LDS_WAIT();
    if (PROBE) atomicMax((unsigned*)(ws + WS_DBG), __float_as_uint(dmax));
}
template <int MODE, bool PROBE>
__device__ __forceinline__ void attn_mfma_phase(const Args& a, LAS unsigned char* lds, int tid) {
    for (int i = blockIdx.x; i < 256; i += gridDim.x) {
        const int bg = i >> 4, s = i & 15;
        attn_mfma_unit<MODE, PROBE>(a, lds, tid, bg >> 1, bg & 1, s);
        attn_mfma_unit<MODE, PROBE>(a, lds, tid, bg >> 1, bg & 1, 31 - s);
    }
}

constexpr int FA_KB = 0, FA_VB = 32768, FA_WSF = 65536, FA_SELM = 69632, FA_BS = 69888, FA_BN = 2176, FA_OST = FA_BS + 4 * FA_BN * 4, FA_END = FA_OST + 32768;
static_assert(FA_END <= LDS_BYTES, "fused attention LDS map");
__device__ __forceinline__ void glds16(const void* gsrc, unsigned lds_dst) { unsigned keep;
    asm volatile("s_mov_b32 %0, m0\n\ts_mov_b32 m0, %2\n\ts_nop 0\n\tglobal_load_lds_dwordx4 %1, off\n\ts_mov_b32 m0, %0" : "=&s"(keep) : "v"(gsrc), "s"(lds_dst) : "memory"); }
template <int MODE>
__device__ __forceinline__ void fa_branch(const unsigned char* ws, LAS unsigned char* lds, int tid, int tb, int g, int qt, int h, u32 mk, const float* smg, f32x16 (&osum)[2]) {
    typedef short v4i16_t __attribute__((ext_vector_type(4)));
    const int lane = tid & 63, w = __builtin_amdgcn_readfirstlane(tid >> 6), r32 = lane & 31, hi = lane >> 5, tsub = w & 1, hg = h & 3;
    const bf16* KV = (const bf16*)(ws + WS_KV);
    const int kcol = (MODE == 1 ? 256 : 512) + g * 64, vcol = kcol + 128;
    const int j0 = (MODE == 2) ? (qt > 8 ? qt - 8 : 0) : 0, j1 = qt;
    const bf16* ksrc = KV + (size_t)(tb + lane) * 768 + kcol + w * 8;
    const bf16* vsrc = KV + (size_t)(tb + 16 * (w & 3) + (lane >> 2)) * 768 + vcol + (w >> 2) * 32 + (lane & 3) * 8;
    const unsigned ldsb = (unsigned)(uintptr_t)lds;
    const unsigned kdst = ldsb + FA_KB + w * 1024, vdst = ldsb + FA_VB + w * 1024;
#define FA_DMA(jt_) do { const unsigned so_ = (unsigned)(((jt_) - j0) & 3) * 8192u; glds16(ksrc + (size_t)(jt_) * 64 * 768, (unsigned)__builtin_amdgcn_readfirstlane(kdst + so_)); glds16(vsrc + (size_t)(jt_) * 64 * 768, (unsigned)__builtin_amdgcn_readfirstlane(vdst + so_)); } while (0)
    FA_DMA(j0); if (j0 + 1 <= j1) FA_DMA(j0 + 1); if (j0 + 2 <= j1) FA_DMA(j0 + 2);
    LAS unsigned char* Kb = lds + FA_KB; LAS unsigned char* Vb = lds + FA_VB; LAS float* wsf = (LAS float*)(lds + FA_WSF) + w * 128;
    bf16x8 qr[4];
    { const bf16* Q = (const bf16*)(ws + WS_Q) + (size_t)(tb + qt * 64 + tsub * 32 + r32) * 512 + h * 64 + hi * 8;
#pragma unroll
      for (int d0 = 0; d0 < 4; ++d0) qr[d0] = *(const bf16x8*)(Q + d0 * 16); }
    const LAS unsigned char* btab = lds + FA_BS + hg * FA_BN * 4;
    const LAS unsigned char* bb = btab + (qt * 64 + tsub * 32 + r32 + 65) * 4;
    const LAS unsigned char* bmask = btab + 32 * 4;
    float m = -1e30f, l = 0.f; f32x16 o[2];
#pragma unroll
    for (int r = 0; r < 16; ++r) { o[0][r] = 0.f; o[1][r] = 0.f; }
    const LAS unsigned char* vrd0 = Vb + ((lane >> 4) & 1) * 32 + (lane & 3) * 8 + (4 * hi + ((lane & 15) >> 2)) * 64;
    for (int jt = j0; jt <= j1; ++jt) {
        const int slot = (jt - j0) & 3;
        { const int ahead = j1 - jt;
          if (ahead >= 2) asm volatile("s_waitcnt vmcnt(4) lgkmcnt(0)\n\ts_barrier" ::: "memory");
          else if (ahead == 1) asm volatile("s_waitcnt vmcnt(2) lgkmcnt(0)\n\ts_barrier" ::: "memory");
          else asm volatile("s_waitcnt vmcnt(0) lgkmcnt(0)\n\ts_barrier" ::: "memory"); }
        if (jt + 3 <= j1) FA_DMA(jt + 3);
        f32x16 p0, p1;
        { const LAS unsigned char* bp = (MODE == 1 && !((mk >> jt) & 1u)) ? bmask : bb - 256 * jt;
#pragma unroll
          for (int r = 0; r < 16; ++r) { p0[r] = *(const LAS float*)(bp + (63 - crow(r, hi)) * 4); p1[r] = *(const LAS float*)(bp + (31 - crow(r, hi)) * 4); } }
        if (MODE == 2 && jt == qt - 8) {
            const int d0_ = qt * 64 + tsub * 32 + r32 - 64 * jt;
#pragma unroll
            for (int r = 0; r < 16; ++r) { if (d0_ - crow(r, hi) >= 512) p0[r] = -30000.f; if (d0_ - crow(r, hi) - 32 >= 512) p1[r] = -30000.f; } }
        const LAS unsigned char* kb = Kb + slot * 8192 + hi * 1024 + r32 * 16;
#pragma unroll
        for (int d0 = 0; d0 < 4; ++d0) {
            const bf16x8 k0 = *(const LAS bf16x8*)(kb + d0 * 2048), k1 = *(const LAS bf16x8*)(kb + d0 * 2048 + 512);
            p0 = __builtin_amdgcn_mfma_f32_32x32x16_bf16(k0, qr[d0], p0, 0, 0, 0);
            p1 = __builtin_amdgcn_mfma_f32_32x32x16_bf16(k1, qr[d0], p1, 0, 0, 0);
        }
        float rm = max3f(p0[0], p0[1], p1[0]), rm2 = max3f(p0[2], p0[3], p1[1]); rm = max3f(rm, p1[2], p1[3]);
#pragma unroll
        for (int r = 4; r < 16; r += 4) { rm = max3f(rm, p0[r], p0[r + 1]); rm2 = max3f(rm2, p0[r + 2], p0[r + 3]); rm = max3f(rm, p1[r], p1[r + 1]); rm2 = max3f(rm2, p1[r + 2], p1[r + 3]); }
        rm = hswap_max(max2f(rm, rm2));
        if (__any(rm > m + 8.f)) {
            const float mn = max2f(m, rm);
            const float sc = __builtin_amdgcn_exp2f(m - mn); l *= sc; m = mn;
            if (hi == 0) wsf[r32] = sc;
            LDS_WAIT();
#pragma unroll
            for (int r = 0; r < 16; ++r) { const float f = wsf[crow(r, hi)]; o[0][r] *= f; o[1][r] *= f; }
            LDS_WAIT();
        }
        float sacc = 0.f;
#pragma unroll
        for (int r = 0; r < 16; ++r) { p0[r] = __builtin_amdgcn_exp2f(p0[r] - m); p1[r] = __builtin_amdgcn_exp2f(p1[r] - m); sacc += p0[r] + p1[r]; }
        l += sacc;
        u32x4 pw[4];
#pragma unroll
        for (int e = 0; e < 4; ++e) { pw[0][e] = cvtpk(p0[2 * e], p0[2 * e + 1]); pw[1][e] = cvtpk(p0[8 + 2 * e], p0[8 + 2 * e + 1]); pw[2][e] = cvtpk(p1[2 * e], p1[2 * e + 1]); pw[3][e] = cvtpk(p1[8 + 2 * e], p1[8 + 2 * e + 1]); }
        const LAS unsigned char* vrd = vrd0 + slot * 8192;
#pragma unroll
        for (int d0 = 0; d0 < 2; ++d0)
#pragma unroll
            for (int ks = 0; ks < 4; ++ks) {
                const s16x4 lo = __builtin_bit_cast(s16x4, __builtin_amdgcn_ds_read_tr16_b64_v4i16((LAS v4i16_t*)(vrd + d0 * 4096 + ks * 1024)));
                const s16x4 hh = __builtin_bit_cast(s16x4, __builtin_amdgcn_ds_read_tr16_b64_v4i16((LAS v4i16_t*)(vrd + d0 * 4096 + ks * 1024 + 512)));
                const bf16x8 vf = (bf16x8){lo[0], lo[1], lo[2], lo[3], hh[0], hh[1], hh[2], hh[3]};
                o[d0] = __builtin_amdgcn_mfma_f32_32x32x16_bf16(__builtin_bit_cast(bf16x8, pw[ks]), vf, o[d0], 0, 0, 0);
            }
    }
#undef FA_DMA
    l = hswap_sum(l);
    if (hi == 0) wsf[32 + r32] = sigm(smg[(size_t)r32 * 32]) * __builtin_amdgcn_rcpf(l);
    LDS_WAIT();
#pragma unroll
    for (int r = 0; r < 16; ++r) { const float f = wsf[32 + crow(r, hi)]; osum[0][r] = fmaf(f, o[0][r], osum[0][r]); osum[1][r] = fmaf(f, o[1][r], osum[1][r]); }
    LDS_WAIT();
    __syncthreads();
}
#ifdef PROBE_SEC
#define SEC_T0() unsigned long long sec_t = __builtin_amdgcn_s_memrealtime()
#define SEC(k_) do { const unsigned long long t_ = __builtin_amdgcn_s_memrealtime(); if (blockIdx.x == PROBE_BLK && threadIdx.x == 0) ((float*)(ws + WS_DBG))[8 + (k_)] += (float)(t_ - sec_t); sec_t = t_; } while (0)
#else
#define SEC_T0() do {} while (0)
#define SEC(k_) do {} while (0)
#endif
template <int PROBE>
__device__ __forceinline__ void fused_attn_unit(const Args& a, LAS unsigned char* lds, int tid, int b, int g, int qt) {
    typedef short v4i16_t __attribute__((ext_vector_type(4)));
    unsigned char* ws = a.ws; SEC_T0();
    const int lane = tid & 63, w = __builtin_amdgcn_readfirstlane(tid >> 6), r32 = lane & 31, hi = lane >> 5;
    const int hg = w >> 1, tsub = w & 1, h = g * 4 + hg;
    const int tb = b * SEQ, t0 = qt * 64, tq = t0 + tsub * 32 + r32;
    const bf16* Q = (const bf16*)(ws + WS_Q); const float* sm = (const float*)(ws + WS_SM);
    LAS unsigned char* Kb = lds + FA_KB; LAS unsigned char* Vb = lds + FA_VB; LAS float* wsf = (LAS float*)(lds + FA_WSF) + w * 128;
    LAS u32* selm = (LAS u32*)(lds + FA_SELM); const LAS float* biasL = (const LAS float*)(lds + FA_BS) + hg * FA_BN + 128;
#define FA_IMPB(hg_) ((LAS float*)(lds + (((hg_) & 2) ? FA_VB : FA_KB) + 16384 + ((hg_) & 1) * 8192))
    f32x16 osum[2];
    {
        bf16x8 qr[4];
#pragma unroll
        for (int d0 = 0; d0 < 4; ++d0) qr[d0] = *(const bf16x8*)(Q + (size_t)(tb + tq) * 512 + h * 64 + d0 * 16 + hi * 8);
        const bf16* kcb = (const bf16*)(ws + WS_KCB) + (size_t)(b * 2 + g) * 128 * 64; const bf16* vcb = (const bf16*)(ws + WS_VCB) + (size_t)(b * 2 + g) * 128 * 64;
#pragma unroll
        for (int jt = 0; jt < 2; ++jt) {
            *(LAS u32x4*)(Kb + jt * 8192 + w * 1024 + lane * 16) = *(const u32x4*)(kcb + (size_t)(jt * 64 + lane) * 64 + w * 8);
            *(LAS u32x4*)(Vb + jt * 8192 + w * 1024 + lane * 16) = *(const u32x4*)(vcb + (size_t)(jt * 64 + 16 * (w & 3) + (lane >> 2)) * 64 + (w >> 2) * 32 + (lane & 3) * 8);
        }
        __syncthreads();
        f32x16 p[4];
#pragma unroll
        for (int t = 0; t < 4; ++t)
#pragma unroll
            for (int r = 0; r < 16; ++r) p[t][r] = 0.f;
#pragma unroll
        for (int jt = 0; jt < 2; ++jt) {
            const LAS unsigned char* kb = Kb + jt * 8192 + hi * 1024 + r32 * 16;
#pragma unroll
            for (int d0 = 0; d0 < 4; ++d0) {
                const bf16x8 k0 = *(const LAS bf16x8*)(kb + d0 * 2048), k1 = *(const LAS bf16x8*)(kb + d0 * 2048 + 512);
                p[2 * jt] = __builtin_amdgcn_mfma_f32_32x32x16_bf16(k0, qr[d0], p[2 * jt], 0, 0, 0);
                p[2 * jt + 1] = __builtin_amdgcn_mfma_f32_32x32x16_bf16(k1, qr[d0], p[2 * jt + 1], 0, 0, 0);
            }
        }
        float mx = -30000.f;
#pragma unroll
        for (int t = 0; t < 4; ++t)
#pragma unroll
            for (int r = 0; r < 16; ++r) { const int n = 32 * t + crow(r, hi); const int dist = tq - 16 * n - 31;
                const float v = (dist >= 0) ? p[t][r] + biasL[dist < 0 ? 0 : dist] : -30000.f; p[t][r] = v; mx = fmaxf(mx, v); }
        mx = fmaxf(hswap_max(mx), -10000.f);
        float l = 0.f;
#pragma unroll
        for (int t = 0; t < 4; ++t)
#pragma unroll
            for (int r = 0; r < 16; ++r) { p[t][r] = __builtin_amdgcn_exp2f(p[t][r] - mx); l += p[t][r]; }
        l = hswap_sum(l);
        const float inv = (l > 0.f) ? 1.f / l : 0.f;
#pragma unroll
        for (int t = 0; t < 4; ++t)
#pragma unroll
            for (int r = 0; r < 16; ++r) p[t][r] *= inv;
        float plast[16];
#pragma unroll
        for (int cg = 0; cg < 16; ++cg) { const float lastv = p[cg >> 2][4 * (cg & 3) + 3];
            auto rr = __builtin_amdgcn_permlane32_swap(__float_as_uint(lastv), __float_as_uint(lastv), false, false); plast[cg] = __uint_as_float(hi ? rr[0] : rr[1]); }
        LAS float* myimp = FA_IMPB(hg) + (size_t)(tsub * 32 + r32) * 32 + hi;
#pragma unroll
        for (int cg = 0; cg < 16; ++cg) { const int t = cg >> 2, c = cg & 3;
            const float s4 = (p[t][4 * c] + p[t][4 * c + 1]) + (p[t][4 * c + 2] + p[t][4 * c + 3]);
            const float extra = hi ? plast[cg] : (cg > 0 ? plast[cg > 0 ? cg - 1 : 0] : 0.f);
            myimp[2 * cg] = s4 + extra; }
        f32x16 o[2];
#pragma unroll
        for (int r = 0; r < 16; ++r) { o[0][r] = 0.f; o[1][r] = 0.f; }
        const LAS unsigned char* vrd0 = Vb + ((lane >> 4) & 1) * 32 + (lane & 3) * 8 + (4 * hi + ((lane & 15) >> 2)) * 64;
#pragma unroll
        for (int jt = 0; jt < 2; ++jt) {
            u32x4 pw[4];
#pragma unroll
            for (int e = 0; e < 4; ++e) { pw[0][e] = cvtpk(p[2 * jt][2 * e], p[2 * jt][2 * e + 1]); pw[1][e] = cvtpk(p[2 * jt][8 + 2 * e], p[2 * jt][8 + 2 * e + 1]);
                pw[2][e] = cvtpk(p[2 * jt + 1][2 * e], p[2 * jt + 1][2 * e + 1]); pw[3][e] = cvtpk(p[2 * jt + 1][8 + 2 * e], p[2 * jt + 1][8 + 2 * e + 1]); }
#pragma unroll
            for (int d0 = 0; d0 < 2; ++d0)
#pragma unroll
                for (int ks = 0; ks < 4; ++ks) {
                    const s16x4 lo = __builtin_bit_cast(s16x4, __builtin_amdgcn_ds_read_tr16_b64_v4i16((LAS v4i16_t*)(vrd0 + jt * 8192 + d0 * 4096 + ks * 1024)));
                    const s16x4 hh = __builtin_bit_cast(s16x4, __builtin_amdgcn_ds_read_tr16_b64_v4i16((LAS v4i16_t*)(vrd0 + jt * 8192 + d0 * 4096 + ks * 1024 + 512)));
                    const bf16x8 vf = (bf16x8){lo[0], lo[1], lo[2], lo[3], hh[0], hh[1], hh[2], hh[3]};
                    o[d0] = __builtin_amdgcn_mfma_f32_32x32x16_bf16(__builtin_bit_cast(bf16x8, pw[ks]), vf, o[d0], 0, 0, 0);
                }
        }
        if (hi == 0) wsf[64 + r32] = sigm(sm[(size_t)(tb + tq) * 32 + h]);
        LDS_WAIT();
#pragma unroll
        for (int r = 0; r < 16; ++r) { const float gt = wsf[64 + crow(r, hi)]; osum[0][r] = gt * o[0][r]; osum[1][r] = gt * o[1][r]; }
        __syncthreads();
#pragma unroll 1
        for (int it = 0; it < 4; ++it) {
            const int tok = w * 8 + it * 2 + hi, j = r32;
            float v = (FA_IMPB(0)[tok * 32 + j] + FA_IMPB(1)[tok * 32 + j]) + (FA_IMPB(2)[tok * 32 + j] + FA_IMPB(3)[tok * 32 + j]);
            if (j == 0 || j == qt || j == qt - 1) v = 1e6f; else if (j > qt) v = -1e6f;
            wsf[lane] = v;
            LDS_WAIT();
            int cnt = 0;
#pragma unroll
            for (int i = 0; i < 32; ++i) { const float vi = wsf[hi * 32 + i]; cnt += ((vi > v) || (vi == v && i < j)) ? 1 : 0; }
            const unsigned long long bal = __ballot(cnt < 8);
            if (r32 == 0) selm[tok] = (u32)(bal >> (hi * 32));
            LDS_WAIT();
        }
        __syncthreads();
    }
    SEC(0);
    u32 mk = selm[tsub * 32 + r32];
    if (PROBE != 0) { const u32 ref = ((const u32*)(ws + WS_SEL))[(tb + tq) * 2 + g];
        if (PROBE == 2 && hg == 0 && hi == 0 && ref != mk) atomicAdd((float*)(ws + WS_DBG), 100.f / 32768.f);
        mk = ref; }
    const float* smrow = sm + (size_t)(tb + t0 + tsub * 32) * 32 + h;
    { int t2 = tid; asm volatile("" : "+v"(t2)); fa_branch<2>(ws, lds, t2, tb, g, qt, h, 0xffffffffu, smrow + 16, osum); }
    SEC(1);
    LAS bf16* ost = (LAS bf16*)(lds + FA_OST + w * 4096);
#pragma unroll
    for (int r = 0; r < 16; ++r)
#pragma unroll
        for (int d0 = 0; d0 < 2; ++d0) { ost[crow(r, hi) * 64 + d0 * 32 + r32] = (bf16)f2bf(osum[d0][r]); osum[d0][r] = 0.f; }
    { int t2 = tid; asm volatile("" : "+v"(t2)); fa_branch<1>(ws, lds, t2, tb, g, qt, h, mk, smrow + 8, osum); }
    SEC(2);
    { LAS bf16* stg = (LAS bf16*)(lds + w * 4096);
#pragma unroll
      for (int r = 0; r < 16; ++r)
#pragma unroll
          for (int d0 = 0; d0 < 2; ++d0) stg[crow(r, hi) * 64 + d0 * 32 + r32] = (bf16)f2bf(osum[d0][r]);
      LDS_WAIT();
      const bf16* za = (const bf16*)(ws + WS_ZA) + (size_t)(tb + t0 + tsub * 32 + (lane >> 3)) * 512 + h * 64 + (lane & 7) * 8;
      bf16* oa = (bf16*)(ws + WS_OA) + (size_t)(tb + t0 + tsub * 32 + (lane >> 3)) * 512 + h * 64 + (lane & 7) * 8;
      float dmax = 0.f;
#pragma unroll
      for (int i = 0; i < 4; ++i) {
          const u32x4 ov = *(const LAS u32x4*)(stg + (i * 8 + (lane >> 3)) * 64 + (lane & 7) * 8);
          const u32x4 pv = *(const LAS u32x4*)(ost + (i * 8 + (lane >> 3)) * 64 + (lane & 7) * 8);
          const u32x4 zv = *(const u32x4*)(za + (size_t)i * 8 * 512);
          u32x4 rv;
#pragma unroll
          for (int e = 0; e < 4; ++e) rv[e] = pk2((bf2f(ov[e] & 0xffffu) + bf2f(pv[e] & 0xffffu)) * bf2f(zv[e] & 0xffffu), (bf2f(ov[e] >> 16) + bf2f(pv[e] >> 16)) * bf2f(zv[e] >> 16));
          if (PROBE == 0) *(u32x4*)(oa + (size_t)i * 8 * 512) = rv;
          else { const u32x4 old_ = *(const u32x4*)(oa + (size_t)i * 8 * 512);
#pragma unroll
              for (int e = 0; e < 4; ++e) { dmax = fmaxf(dmax, fabsf(bf2f(rv[e] & 0xffffu) - bf2f(old_[e] & 0xffffu))); dmax = fmaxf(dmax, fabsf(bf2f(rv[e] >> 16) - bf2f(old_[e] >> 16))); } }
      }
      if (PROBE == 1) atomicMax((unsigned*)(ws + WS_DBG), __float_as_uint(dmax));
      LDS_WAIT();
    }
    __syncthreads();
    SEC(3);
#undef FA_IMPB
}
template <int PROBE>
__device__ __forceinline__ void fused_attn_phase(const Args& a, LAS unsigned char* lds, int tid) {
    for (int i = blockIdx.x; i < 256; i += gridDim.x) {
        const int bg = i >> 4, s = i & 15, g = bg & 1;
        { LAS float* bS = (LAS float*)(lds + FA_BS);
          for (int idx = tid; idx < 4 * FA_BN; idx += 512) { const int hh = idx / FA_BN, dist = idx - hh * FA_BN - 128; bS[idx] = (dist < 0) ? -30000.f : a.in[9][rel_bucket(dist) * 8 + g * 4 + hh] * 1.4426950408889634f; } }
        __syncthreads();
#pragma unroll 1
        for (int uu = 0; uu < 2; ++uu) { int t2 = tid; asm volatile("" : "+v"(t2)); fused_attn_unit<PROBE>(a, lds, t2, bg >> 1, g, uu ? 31 - s : s); }
        __syncthreads();
    }
}

constexpr size_t DN_WN = 0, DN_QT = 16 * MiB, DN_KTT = 32 * MiB, DN_AQK = 48 * MiB;
constexpr size_t WS_UT = WS_XB, WS_GL = WS_GG;
constexpr int DA_RS = 132;
constexpr int DA_Q = 0, DA_K = 64 * DA_RS * 4, DA_V = 2 * 64 * DA_RS * 4, DA_L = 3 * 64 * DA_RS * 4, DA_GC = DA_L + 64 * 64 * 4, DA_BE = DA_GC + 256, DA_END = DA_BE + 256;
__device__ __forceinline__ void dn_stage_a_unit(const Args& a, LAS unsigned char* lds, int tid, int b, int h, int ci) {
    unsigned char* ws = a.ws;
    const int lane = tid & 63, w = tid >> 6;
    const int tb = b * SEQ, ts0 = ci * 64; const int chunk = (b * 4 + h) * 32 + ci;
    const bf16* qkvb = (const bf16*)(ws + WS_QKVB); const float* sm = (const float*)(ws + WS_SM);
    LAS float* qs = (LAS float*)(lds + DA_Q); LAS float* ks = (LAS float*)(lds + DA_K); LAS float* vs = (LAS float*)(lds + DA_V);
    LAS float* Ls = (LAS float*)(lds + DA_L); LAS float* gcs = (LAS float*)(lds + DA_GC); LAS float* bes = (LAS float*)(lds + DA_BE);
    {
        const float* conv_w = a.in[10];
#pragma unroll
        for (int part = 0; part < 3; ++part) {
            const int ch = part * 512 + h * 128 + 2 * lane;
            float cw0[4], cw1[4];
#pragma unroll
            for (int x = 0; x < 4; ++x) { cw0[x] = conv_w[x * 1536 + ch]; cw1[x] = conv_w[x * 1536 + ch + 1]; }
            float r0[11], r1[11];
#pragma unroll
            for (int i = 0; i < 11; ++i) { const int ts = ts0 + 8 * w - 3 + i;
                unsigned raw = 0u; if (ts >= 0) raw = *(const unsigned*)(qkvb + (size_t)(tb + ts) * 1536 + ch);
                r0[i] = bf2f(raw & 0xffffu); r1[i] = bf2f(raw >> 16); }
            LAS float* dst = (part == 0) ? qs : (part == 1) ? ks : vs;
#pragma unroll
            for (int i = 0; i < 8; ++i) {
                float a0 = 0.f, a1 = 0.f;
#pragma unroll
                for (int x = 0; x < 4; ++x) { a0 = fmaf(cw0[x], r0[i + x], a0); a1 = fmaf(cw1[x], r1[i + x], a1); }
                a0 = siluf_(a0); a1 = siluf_(a1);
                if (part < 2) { float ss = a0 * a0 + a1 * a1;
#pragma unroll
                    for (int o = 32; o > 0; o >>= 1) ss += wshfl_xor(ss, o, tid);
                    const float rn = 1.0f / sqrtf(ss + 1e-6f); a0 *= rn; a1 *= rn; }
                dst[(8 * w + i) * DA_RS + 2 * lane] = a0; dst[(8 * w + i) * DA_RS + 2 * lane + 1] = a1;
            }
        }
        if (w == 0) {
            const size_t row = (size_t)(tb + ts0 + lane);
            const float be = 1.f / (1.f + expf(-sm[row * 32 + 24 + h]));
            const float xx = sm[row * 32 + 28 + h] + a.in[12][h];
            const float sp = (xx > 20.f) ? xx : log1pf(expf(xx));
            float gc = -expf(a.in[11][h]) * sp;
#pragma unroll
            for (int o = 1; o < 64; o <<= 1) { const float up = __int_as_float(__builtin_amdgcn_ds_bpermute(((lane - o) & 63) << 2, __float_as_int(gc))); if (lane >= o) gc += up; }
            gcs[lane] = gc; bes[lane] = be;
            if (lane == 63) ((float*)(ws + WS_GL))[chunk] = expf(gc);
        }
    }
    __syncthreads();
    {
        const int n = lane & 15, kq = lane >> 4, ti = w >> 1;
        bf16x8 ak[4], aq[4];
#pragma unroll
        for (int sx = 0; sx < 4; ++sx) {
            const LAS float* kp = ks + (16 * ti + n) * DA_RS + 32 * sx + 8 * kq; const LAS float* qp = qs + (16 * ti + n) * DA_RS + 32 * sx + 8 * kq;
            const f32x4 k0 = *(const LAS f32x4*)kp, k1 = *(const LAS f32x4*)(kp + 4), q0 = *(const LAS f32x4*)qp, q1 = *(const LAS f32x4*)(qp + 4);
            u32x4 kw, qw; kw.x = cvtpk(k0.x, k0.y); kw.y = cvtpk(k0.z, k0.w); kw.z = cvtpk(k1.x, k1.y); kw.w = cvtpk(k1.z, k1.w);
            qw.x = cvtpk(q0.x, q0.y); qw.y = cvtpk(q0.z, q0.w); qw.z = cvtpk(q1.x, q1.y); qw.w = cvtpk(q1.z, q1.w);
            ak[sx] = __builtin_bit_cast(bf16x8, kw); aq[sx] = __builtin_bit_cast(bf16x8, qw); }
        bf16* aqk = (bf16*)((unsigned char*)a.out + DN_AQK) + (size_t)chunk * 4096;
#pragma unroll
        for (int tt = 0; tt < 2; ++tt) {
            const int tj = 2 * (w & 1) + tt;
            f32x4 kk = (f32x4){0.f, 0.f, 0.f, 0.f}, qk = kk;
            if (tj <= ti) {
#pragma unroll
                for (int sx = 0; sx < 4; ++sx) {
                    const LAS float* bp = ks + (16 * tj + n) * DA_RS + 32 * sx + 8 * kq;
                    const f32x4 b0 = *(const LAS f32x4*)bp, b1 = *(const LAS f32x4*)(bp + 4);
                    u32x4 bw; bw.x = cvtpk(b0.x, b0.y); bw.y = cvtpk(b0.z, b0.w); bw.z = cvtpk(b1.x, b1.y); bw.w = cvtpk(b1.z, b1.w);
                    const bf16x8 bf = __builtin_bit_cast(bf16x8, bw);
                    kk = __builtin_amdgcn_mfma_f32_16x16x32_bf16(ak[sx], bf, kk, 0, 0, 0);
                    qk = __builtin_amdgcn_mfma_f32_16x16x32_bf16(aq[sx], bf, qk, 0, 0, 0);
                }
            }
            const int jc = 16 * tj + n; const float gj = gcs[jc];
#pragma unroll
            for (int e = 0; e < 4; ++e) { const int c = 16 * ti + 4 * kq + e; const float dec = (jc <= c) ? expf(gcs[c] - gj) : 0.f;
                Ls[c * 64 + jc] = (jc < c) ? bes[c] * kk[e] * dec : 0.f;
                aqk[c * 64 + jc] = (bf16)f2bf(qk[e] * dec * 0.08838834764831845f); }
        }
    }
    {
        { const int c = tid >> 3, k0 = (tid & 7) * 16; const float f = 0.08838834764831845f * expf(gcs[c]);
          bf16* qt = (bf16*)((unsigned char*)a.out + DN_QT) + (size_t)chunk * 8192 + c * 128 + k0;
#pragma unroll
          for (int k = 0; k < 16; k += 8) { const f32x4 x0 = *(const LAS f32x4*)(qs + c * DA_RS + k0 + k), x1 = *(const LAS f32x4*)(qs + c * DA_RS + k0 + k + 4);
              u32x4 o; o.x = pk2(x0.x * f, x0.y * f); o.y = pk2(x0.z * f, x0.w * f); o.z = pk2(x1.x * f, x1.y * f); o.w = pk2(x1.z * f, x1.w * f); *(u32x4*)(qt + k) = o; } }
        { const int k = tid >> 2, c0 = (tid & 3) * 16; const float gl = gcs[63];
          bf16* ktt = (bf16*)((unsigned char*)a.out + DN_KTT) + (size_t)chunk * 8192 + k * 64 + c0;
#pragma unroll
          for (int c = 0; c < 16; c += 8) { float v[8];
#pragma unroll
              for (int e = 0; e < 8; ++e) v[e] = ks[(c0 + c + e) * DA_RS + k] * expf(gl - gcs[c0 + c + e]);
              u32x4 o; o.x = pk2(v[0], v[1]); o.y = pk2(v[2], v[3]); o.z = pk2(v[4], v[5]); o.w = pk2(v[6], v[7]); *(u32x4*)(ktt + c) = o; } }
    }
    __syncthreads();
    LAS float* Tm = (LAS float*)(lds + DA_END);
    LAS unsigned char* XT = lds + DA_Q;
    {
#pragma unroll
        for (int i = 0; i < 4; ++i) *(LAS u32x4*)(XT + (tid + 512 * i) * 16) = (u32x4){0u, 0u, 0u, 0u};
        if (w == 0) {
            const int blk = lane >> 4, col = lane & 15; const LAS float* Lb = Ls + (16 * blk) * 64 + 16 * blk;
            float x[16];
#pragma unroll
            for (int r = 0; r < 16; ++r) {
                float acc = (r == col) ? 1.f : 0.f;
#pragma unroll
                for (int s4 = 0; s4 < r; s4 += 4) { const f32x4 lv = *(const LAS f32x4*)(Lb + r * 64 + s4);
                    acc = fmaf(-lv.x, x[s4], acc); if (s4 + 1 < r) acc = fmaf(-lv.y, x[s4 + 1], acc); if (s4 + 2 < r) acc = fmaf(-lv.z, x[s4 + 2], acc); if (s4 + 3 < r) acc = fmaf(-lv.w, x[s4 + 3], acc); }
                x[r] = acc;
                Tm[(blk * 16 + r) * 16 + col] = acc - ((r == col) ? 1.f : 0.f);
            }
        }
    }
    __syncthreads();
    {
        const int n = lane & 15, kq = lane >> 4; const bool isv = w >= 4;
        const LAS float* src = isv ? vs : ks;
#pragma unroll
        for (int nt = 0; nt < 2; ++nt) {
            const int col = 32 * w + 16 * nt + n, colk = col & 127;
            LAS unsigned char* xt = XT + col * 128;
#pragma unroll
            for (int i = 0; i < 4; ++i) {
                f32x4 acc;
#pragma unroll
                for (int e = 0; e < 4; ++e) { const int c = 16 * i + 4 * kq + e; float r = bes[c] * src[c * DA_RS + colk]; if (!isv) r *= expf(gcs[c]); acc[e] = r; }
#pragma unroll
                for (int kb = 0; kb < 16 * i; kb += 32) {
                    const bool live = (kb + 8 * kq) < 16 * i;
                    const LAS float* lp = Ls + (16 * i + n) * 64 + kb + 8 * kq;
                    const f32x4 l0 = *(const LAS f32x4*)lp, l1 = *(const LAS f32x4*)(lp + 4);
                    u32x4 aw; aw.x = cvtpk(-l0.x, -l0.y); aw.y = cvtpk(-l0.z, -l0.w); aw.z = cvtpk(-l1.x, -l1.y); aw.w = cvtpk(-l1.z, -l1.w);
                    if (!live) aw = (u32x4){0u, 0u, 0u, 0u};
                    const bf16x8 bfr = *(const LAS bf16x8*)(xt + (kb + 8 * kq) * 2);
                    acc = __builtin_amdgcn_mfma_f32_16x16x32_bf16(__builtin_bit_cast(bf16x8, aw), bfr, acc, 0, 0, 0);
                }
                { const f32x4 tv = *(const LAS f32x4*)(Tm + (i * 16 + n) * 16 + 4 * kq);
                  u32x4 aw; aw.x = cvtpk(tv.x, tv.y); aw.y = cvtpk(tv.z, tv.w); aw.z = 0u; aw.w = 0u;
                  u32x4 bw; bw.x = cvtpk(acc[0], acc[1]); bw.y = cvtpk(acc[2], acc[3]); bw.z = 0u; bw.w = 0u;
                  acc = __builtin_amdgcn_mfma_f32_16x16x32_bf16(__builtin_bit_cast(bf16x8, aw), __builtin_bit_cast(bf16x8, bw), acc, 0, 0, 0); }
                if (i < 3) { u32x2 xw; xw.x = cvtpk(acc[0], acc[1]); xw.y = cvtpk(acc[2], acc[3]); *(LAS u32x2*)(xt + (16 * i + 4 * kq) * 2) = xw; LDS_WAIT(); }
                if (!isv) { bf16* wn = (bf16*)((unsigned char*)a.out + DN_WN) + (size_t)chunk * 8192 + (16 * i + 4 * kq) * 128 + colk;
#pragma unroll
                    for (int e = 0; e < 4; ++e) wn[e * 128] = (bf16)f2bf(-acc[e]); }
                else { float* ut = (float*)(ws + WS_UT) + (size_t)chunk * 8192 + colk * 64 + 16 * i + 4 * kq; *(f32x4*)ut = acc; }
            }
        }
    }
    __syncthreads();
}
__device__ __forceinline__ void dn_stage_a_phase(const Args& a, LAS unsigned char* lds, int tid) {
    for (int u = blockIdx.x; u < 1024; u += gridDim.x) { int t2 = tid; asm volatile("" : "+v"(t2)); dn_stage_a_unit(a, lds, t2, u >> 7, (u >> 5) & 3, u & 31); }
}
typedef float f32x4v __attribute__((ext_vector_type(4)));
constexpr int DB_ST = 0, DB_VN = 4352, DB_SRS = 272, DB_VRS = 144;
__device__ __forceinline__ void dn_scan_mfma_phase(const Args& a, LAS unsigned char* lds, int tid) {
    unsigned char* ws = a.ws;
    const int lane = tid & 63, w = __builtin_amdgcn_readfirstlane(tid >> 6), n = lane & 15, kq = lane >> 4;
    for (int u0 = blockIdx.x; u0 < 256; u0 += gridDim.x) {
        const int xcd = u0 & 7, idx = u0 >> 3, bh = xcd * 4 + (idx >> 3), sl = idx & 7, b = bh >> 2, h = bh & 3;
        const size_t chunk0 = (size_t)bh * 32;
        const bf16* WN = (const bf16*)((const unsigned char*)a.out + DN_WN) + chunk0 * 8192;
        const bf16* QT = (const bf16*)((const unsigned char*)a.out + DN_QT) + chunk0 * 8192;
        const bf16* KTT = (const bf16*)((const unsigned char*)a.out + DN_KTT) + chunk0 * 8192;
        const bf16* AQK = (const bf16*)((const unsigned char*)a.out + DN_AQK) + chunk0 * 4096;
        const float* UT = (const float*)(ws + WS_UT) + chunk0 * 8192 + (size_t)(sl * 16) * 64;
        const float* GL = (const float*)(ws + WS_GL) + chunk0;
        float* od = (float*)(ws + WS_OD) + (size_t)(b * SEQ) * 512 + h * 128 + sl * 16;
        for (int i = tid; i < (4352 + 2304) / 4; i += 512) ((LAS unsigned*)(lds + DB_ST))[i] = 0u;
        __syncthreads();
        f32x4v sacc[2]; sacc[0] = (f32x4v){0.f, 0.f, 0.f, 0.f}; sacc[1] = sacc[0];
        const int i = w & 3;
        const bf16* wnp = WN + (16 * i + n) * 128 + kq * 8; const bf16* qtp = QT + (16 * i + n) * 128 + kq * 8;
        const bf16* aqp = AQK + (16 * i + n) * 64 + kq * 8; const bf16* ktp = KTT + (32 * i + n) * 64 + kq * 8;
        const float* utp = UT + n * 64 + 16 * i + 4 * kq;
        bf16x8 wfS[2][4], qfS[2][4], aqS[2][2], ktS[2][4]; f32x4v utS[2]; float glS[2];
#define DN_LOAD(S_, c_) do { _Pragma("unroll") for (int ks = 0; ks < 4; ++ks) { wfS[S_][ks] = *(const bf16x8*)(wnp + (size_t)(c_) * 8192 + ks * 32); qfS[S_][ks] = *(const bf16x8*)(qtp + (size_t)(c_) * 8192 + ks * 32); } \
        _Pragma("unroll") for (int k2 = 0; k2 < 2; ++k2) { aqS[S_][k2] = *(const bf16x8*)(aqp + (size_t)(c_) * 4096 + k2 * 32); ktS[S_][k2] = *(const bf16x8*)(ktp + (size_t)(c_) * 8192 + k2 * 32); ktS[S_][2 + k2] = *(const bf16x8*)(ktp + (size_t)(c_) * 8192 + 16 * 64 + k2 * 32); } \
        utS[S_] = *(const f32x4v*)(utp + (size_t)(c_) * 8192); glS[S_] = GL[c_]; } while (0)
#define DN_STEP(S_, N_, c_) do { \
            if (w < 4) { \
                if ((c_) < 31) DN_LOAD(N_, (c_) + 1); \
                bf16x8 sf[4]; \
                _Pragma("unroll") for (int ks = 0; ks < 4; ++ks) sf[ks] = *(const LAS bf16x8*)(lds + DB_ST + n * DB_SRS + ks * 64 + kq * 16); \
                f32x4v vacc = utS[S_]; f32x4v oacc = (f32x4v){0.f, 0.f, 0.f, 0.f}; \
                _Pragma("unroll") for (int ks = 0; ks < 4; ++ks) { vacc = __builtin_amdgcn_mfma_f32_16x16x32_bf16(wfS[S_][ks], sf[ks], vacc, 0, 0, 0); oacc = __builtin_amdgcn_mfma_f32_16x16x32_bf16(qfS[S_][ks], sf[ks], oacc, 0, 0, 0); } \
                u32x2 pv; pv.x = cvtpk(vacc[0], vacc[1]); pv.y = cvtpk(vacc[2], vacc[3]); \
                *(LAS u32x2*)(lds + DB_VN + n * DB_VRS + (16 * i + 4 * kq) * 2) = pv; \
                LDS_WAIT(); \
                __builtin_amdgcn_s_barrier(); \
                bf16x8 vf[2]; \
                _Pragma("unroll") for (int k2 = 0; k2 < 2; ++k2) vf[k2] = *(const LAS bf16x8*)(lds + DB_VN + n * DB_VRS + k2 * 64 + kq * 16); \
                _Pragma("unroll") for (int k2 = 0; k2 < 2; ++k2) oacc = __builtin_amdgcn_mfma_f32_16x16x32_bf16(aqS[S_][k2], vf[k2], oacc, 0, 0, 0); \
                float* op = od + (size_t)((c_) * 64 + 16 * i + 4 * kq) * 512 + n; \
                _Pragma("unroll") for (int e = 0; e < 4; ++e) op[(size_t)e * 512] = oacc[e]; \
                _Pragma("unroll") for (int mt = 0; mt < 2; ++mt) { const int m = 2 * i + mt; \
                    sacc[mt] = sacc[mt] * glS[S_]; \
                    _Pragma("unroll") for (int k2 = 0; k2 < 2; ++k2) sacc[mt] = __builtin_amdgcn_mfma_f32_16x16x32_bf16(ktS[S_][2 * mt + k2], vf[k2], sacc[mt], 0, 0, 0); \
                    u32x2 ps; ps.x = cvtpk(sacc[mt][0], sacc[mt][1]); ps.y = cvtpk(sacc[mt][2], sacc[mt][3]); \
                    *(LAS u32x2*)(lds + DB_ST + n * DB_SRS + (16 * m + 4 * kq) * 2) = ps; } \
                LDS_WAIT(); \
                __builtin_amdgcn_s_barrier(); \
            } else { __builtin_amdgcn_s_barrier(); __builtin_amdgcn_s_barrier(); } } while (0)
        if (w < 4) DN_LOAD(0, 0);
        for (int c = 0; c < 32; c += 2) { DN_STEP(0, 1, c); DN_STEP(1, 0, c + 1); }
#undef DN_STEP
#undef DN_LOAD
    }
}

__device__ __forceinline__ void dn_scan_phase(const Args& a, LAS unsigned char* lds, int tid) {
    if (tid >= 64) return;
    unsigned char* ws = a.ws; const int lane = tid, kq = lane >> 4, vc = lane & 15;
    const bf16* qn = (const bf16*)a.out; const bf16* kn = qn + (size_t)T * 512; const bf16* vv = kn + (size_t)T * 512;
    const float* gg = (const float*)(ws + WS_GG); const float* bb = (const float*)(ws + WS_BB);
    float* od = (float*)(ws + WS_OD);
    LAS unsigned char* kbuf = lds; LAS unsigned char* qbuf = lds + 16384; LAS unsigned char* vbuf = lds + 32768;
    for (int u = blockIdx.x; u < 256; u += gridDim.x) {
        const int b = u >> 5, h = (u >> 3) & 3, vb = u & 7;
        float S[32];
#pragma unroll
        for (int k = 0; k < 32; ++k) S[k] = 0.f;
        for (int c = 0; c < 32; ++c) {
            const int t0 = b * SEQ + c * 64;
#pragma unroll 4
            for (int i = 0; i < 16; ++i) { const int p = i * 64 + lane, row = p >> 4, ch = p & 15;
                *(LAS u32x4*)(kbuf + row * 256 + ch * 16) = *(const u32x4*)(kn + (size_t)(t0 + row) * 512 + h * 128 + ch * 8);
                *(LAS u32x4*)(qbuf + row * 256 + ch * 16) = *(const u32x4*)(qn + (size_t)(t0 + row) * 512 + h * 128 + ch * 8); }
#pragma unroll
            for (int i = 0; i < 2; ++i) { const int p = i * 64 + lane, row = p >> 1, ch = p & 1;
                *(LAS u32x4*)(vbuf + row * 32 + ch * 16) = *(const u32x4*)(vv + (size_t)(t0 + row) * 512 + h * 128 + vb * 16 + ch * 8); }
            const float gl = gg[(t0 + lane) * 4 + h], bl = bb[(t0 + lane) * 4 + h];
            LDS_WAIT();
            for (int s = 0; s < 64; ++s) {
                const float alpha = expf(__int_as_float(__builtin_amdgcn_readlane(__float_as_int(gl), s)));
                const float beta = __int_as_float(__builtin_amdgcn_readlane(__float_as_int(bl), s));
                const float v = bf2f(*(const LAS bf16*)(vbuf + s * 32 + vc * 2));
                float kk[32];
#pragma unroll
                for (int k8 = 0; k8 < 4; ++k8) { const u32x4 w = *(const LAS u32x4*)(kbuf + s * 256 + kq * 64 + k8 * 16);
                    kk[k8 * 8 + 0] = bf2f(w.x & 0xffffu); kk[k8 * 8 + 1] = bf2f(w.x >> 16); kk[k8 * 8 + 2] = bf2f(w.y & 0xffffu); kk[k8 * 8 + 3] = bf2f(w.y >> 16);
                    kk[k8 * 8 + 4] = bf2f(w.z & 0xffffu); kk[k8 * 8 + 5] = bf2f(w.z >> 16); kk[k8 * 8 + 6] = bf2f(w.w & 0xffffu); kk[k8 * 8 + 7] = bf2f(w.w >> 16); }
                float kS = 0.f;
#pragma unroll
                for (int k = 0; k < 32; ++k) { S[k] *= alpha; kS = fmaf(kk[k], S[k], kS); }
                kS += wshfl_xor(kS, 16, tid); kS += wshfl_xor(kS, 32, tid);
                const float vn = beta * (v - kS);
                float o = 0.f;
#pragma unroll
                for (int k8 = 0; k8 < 4; ++k8) { const u32x4 wq = *(const LAS u32x4*)(qbuf + s * 256 + kq * 64 + k8 * 16);
                    const float qq[8] = {bf2f(wq.x & 0xffffu), bf2f(wq.x >> 16), bf2f(wq.y & 0xffffu), bf2f(wq.y >> 16), bf2f(wq.z & 0xffffu), bf2f(wq.z >> 16), bf2f(wq.w & 0xffffu), bf2f(wq.w >> 16)};
#pragma unroll
                    for (int e = 0; e < 8; ++e) { S[k8 * 8 + e] = fmaf(kk[k8 * 8 + e], vn, S[k8 * 8 + e]); o = fmaf(qq[e], S[k8 * 8 + e], o); } }
                o += wshfl_xor(o, 16, tid); o += wshfl_xor(o, 32, tid);
                if (kq == 0) od[(size_t)(t0 + s) * 512 + h * 128 + vb * 16 + vc] = o * 0.08838834764831845f;
            }
            LDS_WAIT();
        }
    }
}

__device__ __forceinline__ void dn_out_phase(const Args& a, LAS unsigned char* lds, int tid) {
    unsigned char* ws = a.ws; const float* od = (const float*)(ws + WS_OD); const float* norm_w = a.in[13];
    bf16* zb = (bf16*)(ws + WS_ZB);
    const int lane = tid & 63, wave = tid >> 6; const int gw = blockIdx.x * 8 + wave, NGW = gridDim.x * 8;
    const float nw0 = norm_w[2 * lane], nw1 = norm_w[2 * lane + 1];
    for (int r0 = gw * 4; r0 < T * 4; r0 += NGW * 4) {
        float v0[4], v1[4]; unsigned zz[4];
#pragma unroll
        for (int q = 0; q < 4; ++q) { const size_t o = (size_t)(r0 + q) * 128 + 2 * lane; const float2 x = *(const float2*)(od + o); v0[q] = x.x; v1[q] = x.y; zz[q] = *(const unsigned*)(zb + o); }
#pragma unroll
        for (int q = 0; q < 4; ++q) { float ssq = v0[q] * v0[q] + v1[q] * v1[q];
#pragma unroll
            for (int o = 32; o > 0; o >>= 1) ssq += wshfl_xor(ssq, o, tid);
            const float rn = 1.0f / sqrtf(ssq * (1.f / 128.f) + 1e-6f);
            *(unsigned*)(zb + (size_t)(r0 + q) * 128 + 2 * lane) = pk2(v0[q] * rn * nw0 * bf2f(zz[q] & 0xffffu), v1[q] * rn * nw1 * bf2f(zz[q] >> 16)); }
    }
}

__device__ __forceinline__ void final_ln_phase(const Args& a, int tid) {
    const int lane = tid & 63, wave = tid >> 6; const int gw = blockIdx.x * 8 + wave, NGW = gridDim.x * 8;
    const float* ln_g = a.in[19]; const float* ln_b = a.in[20];
    f32x4 gv[4], bv[4];
#pragma unroll
    for (int j = 0; j < 4; ++j) { gv[j] = ((const f32x4*)ln_g)[lane + 64 * j]; bv[j] = ((const f32x4*)ln_b)[lane + 64 * j]; }
    for (int m = gw; m < T; m += NGW) {
        f32x4* xr = (f32x4*)(a.out + (size_t)m * 1024) + lane;
        f32x4 v[4]; float s = 0.f;
#pragma unroll
        for (int j = 0; j < 4; ++j) { v[j] = xr[64 * j]; s += (v[j].x + v[j].y) + (v[j].z + v[j].w); }
#pragma unroll
        for (int o = 1; o < 64; o <<= 1) s += wshfl_xor(s, o, tid);
        const float mean = s * (1.f / 1024.f); float s2 = 0.f;
#pragma unroll
        for (int j = 0; j < 4; ++j) { v[j] = v[j] - mean; s2 += (v[j].x * v[j].x + v[j].y * v[j].y) + (v[j].z * v[j].z + v[j].w * v[j].w); }
#pragma unroll
        for (int o = 1; o < 64; o <<= 1) s2 += wshfl_xor(s2, o, tid);
        const float rstd = 1.0f / sqrtf(s2 * (1.f / 1024.f) + 1e-5f);
#pragma unroll
        for (int j = 0; j < 4; ++j) xr[64 * j] = v[j] * rstd * gv[j] + bv[j];
    }
}

__global__ void __launch_bounds__(512, 2) mega_fwd(Args a) {
    extern __shared__ __attribute__((aligned(16))) unsigned char lds_raw[];
    LAS unsigned char* lds = (LAS unsigned char*)lds_raw;
    cg::grid_group grid = cg::this_grid();
    int tid = threadIdx.x; const int G = gridDim.x;
    unsigned char* ws = a.ws;
#ifdef PROBE_TS
    unsigned long long ts_prev = __builtin_amdgcn_s_memrealtime(); int ts_n = 0; float ts_val = 0.f;
#define STAMP() do { const unsigned long long t_ = __builtin_amdgcn_s_memrealtime(); if (ts_n == PROBE_TS) ts_val = (float)(t_ - ts_prev) * 1e-3f; ts_prev = t_; ++ts_n; } while (0)
#else
#define STAMP() do {} while (0)
#endif
#define FRESH_TID() do { tid = threadIdx.x; asm volatile("" : "+v"(tid)); } while (0)

    FRESH_TID();
    p0_prologue(a, lds, tid);
    grid.sync(); STAMP();
    { pg8::Gemm g{(const pg8::bf16_t*)(ws + WS_XB), (const pg8::bf16_t*)(ws + WS_WIN), T, 6144, 1024}; pg8::StaticOrder S; S.init(T, 6144, G, (int)blockIdx.x);
      EpiProj E{ws}; pg8::gemm_phase<EpiProj, pg8::StaticOrder, true, true>(lds, g, S, E); }
    grid.sync(); STAMP();
#if !defined(PROBE_FUSED)
#ifdef DN_SEQ
    FRESH_TID(); dn_prep_phase(a, lds, tid);
#else
    FRESH_TID(); dn_stage_a_phase(a, lds, tid);
#endif
    __syncthreads();
#ifdef SIMPLE_G1
    FRESH_TID(); cmp_gemm1_phase(a, lds, tid);
#else
    FRESH_TID(); cmp_gemm1_mfma_phase(a, lds, tid);
#endif
    grid.sync(); STAMP();
    FRESH_TID(); cmp_gemm2_phase(a, lds, tid);
    __syncthreads();
#ifdef PROBE_SPLIT3
    STAMP();
#endif
#ifdef DN_SEQ
    FRESH_TID(); dn_scan_phase(a, lds, tid);
#else
    FRESH_TID(); dn_scan_mfma_phase(a, lds, tid);
#endif
    grid.sync(); STAMP();
    FRESH_TID(); fused_attn_phase<0>(a, lds, tid);
    __syncthreads();
#ifdef PROBE_SPLIT3
    STAMP();
#endif
    FRESH_TID(); dn_out_phase(a, lds, tid);
    grid.sync(); STAMP();
#else
    FRESH_TID(); dn_prep_phase(a, lds, tid);
    __syncthreads();
    FRESH_TID(); cmp_gemm1_phase(a, lds, tid);
    __syncthreads();
    FRESH_TID(); attn_mfma_phase<2, false>(a, lds, tid);
    grid.sync();
    FRESH_TID(); cmp_gemm2_phase(a, lds, tid);
    __syncthreads();
    FRESH_TID(); dn_scan_phase(a, lds, tid);
    grid.sync();
    FRESH_TID(); attn_simple_phase<0>(a, lds, tid);
    grid.sync();
    FRESH_TID(); attn_mfma_phase<1, false>(a, lds, tid);
    grid.sync();
    FRESH_TID(); fused_attn_phase<PROBE_FUSED>(a, lds, tid);
    __syncthreads();
    FRESH_TID(); dn_out_phase(a, lds, tid);
    grid.sync();
#endif
    { pg8::Gemm g{(const pg8::bf16_t*)(ws + WS_OA), (const pg8::bf16_t*)(ws + WS_WA), T, 1024, 512}; pg8::StaticOrder S; S.init(T, 1024, G, (int)blockIdx.x);
      EpiYA E{(const bf16*)(ws + WS_GM), (bf16*)(ws + WS_PARTA)}; pg8::gemm_phase<EpiYA, pg8::StaticOrder, true, true>(lds, g, S, E); }
    { pg8::Gemm g{(const pg8::bf16_t*)(ws + WS_ZB), (const pg8::bf16_t*)(ws + WS_WB), T, 1024, 512}; pg8::StaticOrder S; S.init(T, 1024, G, (int)blockIdx.x);
      EpiYB E{(const bf16*)(ws + WS_GM), (const bf16*)(ws + WS_PARTA), (bf16*)(ws + WS_M)}; pg8::gemm_phase<EpiYB, pg8::StaticOrder, true, true>(lds, g, S, E); }
    grid.sync(); STAMP();
    { pg8::Gemm g{(const pg8::bf16_t*)(ws + WS_M), (const pg8::bf16_t*)(ws + WS_WOUT), T, 1024, 1024}; pg8::StaticOrder S; S.init(T, 1024, G, (int)blockIdx.x);
      EpiH E{a.in[0], (float*)(ws + WS_H), (bf16*)(ws + WS_HB)}; pg8::gemm_phase<EpiH, pg8::StaticOrder, true, true>(lds, g, S, E); }
    { pg8::Gemm g{(const pg8::bf16_t*)(ws + WS_PB), (const pg8::bf16_t*)(ws + WS_WPLE), T, 1024, 256}; pg8::StaticOrder S; S.init(T, 1024, G, (int)blockIdx.x);
      EpiPE E{(bf16*)(ws + WS_PE)}; pg8::gemm_phase<EpiPE, pg8::StaticOrder, true, true>(lds, g, S, E); }
    grid.sync(); STAMP();
    { pg8::Gemm g{(const pg8::bf16_t*)(ws + WS_HB), (const pg8::bf16_t*)(ws + WS_WPG), T, 1024, 1024}; pg8::StaticOrder S; S.init(T, 1024, G, (int)blockIdx.x);
      EpiGate E{(const float*)(ws + WS_H), (const bf16*)(ws + WS_PE), a.out}; pg8::gemm_phase<EpiGate, pg8::StaticOrder, true, true>(lds, g, S, E); }
    grid.sync(); STAMP();
#ifdef PROBE_SYNC
    for (int q_ = 0; q_ < 10; ++q_) grid.sync();
    STAMP();
#endif
    FRESH_TID(); final_ln_phase(a, tid);
#if defined(PROBE_WIN) || defined(PROBE_SEL) || defined(PROBE_FUSED)
    if (blockIdx.x == 0 && threadIdx.x == 0) a.out[0] += *(const float*)(ws + WS_DBG) * (PROBE_SCALE);
#endif
#ifdef PROBE_TS
    STAMP();
    if (blockIdx.x == 0 && threadIdx.x == 0) a.out[0] += ts_val;
#endif
#ifdef PROBE_SEC
    if (blockIdx.x == 0 && threadIdx.x == 0) a.out[0] += ((const float*)(ws + WS_DBG))[8 + PROBE_SEC] * 1e-3f;
#endif
}

extern "C" void kernel_launch(void* const* d_in, const int* in_sizes, int n_in, void* d_out, int out_size, void* d_ws, size_t ws_size, hipStream_t stream) {
    static int grid = 0;
    if (grid == 0) {
        if (n_in != 21 || out_size != T * DM || ws_size < WS_END) { fprintf(stderr, "kernel_launch: unexpected shapes (n_in %d out %d ws %zu)\n", n_in, out_size, ws_size); grid = -1; return; }
        int dev = 0, cus = 0, per_cu = 0;
        hipGetDevice(&dev); hipDeviceGetAttribute(&cus, hipDeviceAttributeMultiprocessorCount, dev);
        hipFuncSetAttribute((const void*)mega_fwd, hipFuncAttributeMaxDynamicSharedMemorySize, LDS_BYTES);
        hipOccupancyMaxActiveBlocksPerMultiprocessor(&per_cu, (const void*)mega_fwd, 512, LDS_BYTES);
        if (per_cu < 1) { fprintf(stderr, "kernel_launch: occupancy query says %d blocks/CU\n", per_cu); per_cu = 1; }
        grid = cus;
        (void)hipGetLastError();
    }
    if (grid < 0) return;
    Args a{};
    for (int i = 0; i < 21; ++i) a.in[i] = (const float*)d_in[i];
    a.out = (float*)d_out; a.ws = (unsigned char*)d_ws;
    void* args[] = {&a};
    hipError_t e = hipLaunchCooperativeKernel((const void*)mega_fwd, dim3(grid), dim3(512), args, LDS_BYTES, stream);
    if (e != hipSuccess) fprintf(stderr, "cooperative launch failed: %s (grid %d)\n", hipGetErrorString(e), grid);
}
```
